# Optimizing an MI355X kernel written in HIP

```python
import math, functools
import jax, jax.numpy as jnp
from jax import lax
import numpy as np

D_MODEL = 1024
BATCH = 8
SEQ = 2048
DEPTH = 2
DEC_BATCH = 128
DEC_SEQ = 1
PAST_LEN = 16384
PAGE_SIZE = 128

N_EVEN = (DEPTH + 1) // 2
N_ODD = DEPTH // 2
NORM_EPS = 1e-5
CHUNK = 128
CONV_W = 4
SSD_D_INNER = D_MODEL
SSD_HEAD_DIM = 64
SSD_HEADS = SSD_D_INNER // SSD_HEAD_DIM
SSD_GROUPS = 2
SSD_D_STATE = 128
MLSTM_D_INNER = D_MODEL
MLSTM_HEADS = 4
MLSTM_HEAD_DIM = MLSTM_D_INNER // MLSTM_HEADS
QKV_BLOCK = 4
CONV_DIM = SSD_D_INNER + 2 * SSD_GROUPS * SSD_D_STATE + MLSTM_D_INNER
IN0_DIM = SSD_D_INNER + CONV_DIM + SSD_HEADS + MLSTM_D_INNER + 2 * MLSTM_HEADS
MIX0_DIM = SSD_D_INNER + MLSTM_D_INNER
RWKV_HEAD_DIM = 64
RWKV_HEADS = D_MODEL // RWKV_HEAD_DIM
DECAY_LORA = 64
AAA_LORA = 64
GATE_LORA = 160
RWKV_LN_EPS = 64e-5
D_FF = -(-8 * D_MODEL // (3 * 256)) * 256

kernel_name = 'hybrid_ssd_mlstm_rwkv7_decode_step'


def _rms(x, g):
    xf = x.astype(jnp.float32)
    y = xf * lax.rsqrt(jnp.mean(xf * xf, axis=-1, keepdims=True) + NORM_EPS)
    return y.astype(x.dtype) * g


def _group_rms(x, groups, g):
    shp = x.shape
    xf = x.astype(jnp.float32).reshape(shp[:-1] + (groups, shp[-1] // groups))
    y = xf * lax.rsqrt(jnp.mean(xf * xf, axis=-1, keepdims=True) + NORM_EPS)
    return y.reshape(shp).astype(x.dtype) * g


def _chunk_len(t):
    return CHUNK if t % CHUNK == 0 else t


def _to_chunks(a, length):
    b, t = a.shape[:2]
    a = a.astype(jnp.float32).reshape((b, t // length, length) + a.shape[2:])
    return jnp.moveaxis(a, 1, 0)


def _from_chunks(a):
    a = jnp.moveaxis(a, 0, 1)
    return a.reshape((a.shape[0], a.shape[1] * a.shape[2]) + a.shape[3:])


def _causal_conv(u, buf, w, bias):
    t = u.shape[1]
    ext = jnp.concatenate([buf.astype(u.dtype), u], axis=1)
    out = bias
    for j in range(CONV_W):
        out = out + ext[:, j:j + t] * w[j]
    return out, ext[:, t:]


def _blockdiag(x, w):
    shp = x.shape
    xb = x.reshape(shp[:-1] + (shp[-1] // QKV_BLOCK, QKV_BLOCK))
    return jnp.einsum('btnc,ncd->btnd', xb, w).reshape(shp)


def _ssd_scan(x, dt, a_neg, bm, cm, h0):
    b, t, h, p = x.shape
    g, n = bm.shape[2], bm.shape[3]
    hg = h // g
    length = _chunk_len(t)
    mask = jnp.tril(jnp.ones((length, length), dtype=bool))[None, :, :, None, None]
    a_g = a_neg.astype(jnp.float32).reshape(g, hg)

    def step(state, inp):
        xc, dtc, bc, cc = inp
        acum = jnp.cumsum(dtc * a_g, axis=1)
        seg = jnp.where(mask, acum[:, :, None] - acum[:, None], -jnp.inf)
        cb = jnp.einsum('btgn,bsgn->btsg', cc, bc)
        wts = jnp.exp(seg) * cb[..., None] * dtc[:, None]
        y = jnp.einsum('btsgh,bsghp->btghp', wts, xc)
        y = y + jnp.exp(acum)[..., None] * jnp.einsum('btgn,bghpn->btghp', cc, state)
        w_end = jnp.exp(acum[:, -1:] - acum) * dtc
        state = (jnp.exp(acum[:, -1])[..., None, None] * state
                 + jnp.einsum('bsghp,bsgn->bghpn', w_end[..., None] * xc, bc))
        return state, y

    xs = _to_chunks(x.reshape(b, t, g, hg, p), length)
    dts = _to_chunks(dt.reshape(b, t, g, hg), length)
    bs = _to_chunks(bm, length)
    cs = _to_chunks(cm, length)
    state, ys = lax.scan(step, h0.astype(jnp.float32).reshape(b, g, hg, p, n), (xs, dts, bs, cs))
    return _from_chunks(ys).reshape(b, t, h, p), state.reshape(b, h, p, n)


def _mlstm_scan(q, k, v, logi, logf, c0, n0, m0):
    b, t = q.shape[:2]
    length = _chunk_len(t)
    mask = jnp.tril(jnp.ones((length, length), dtype=bool))[None, :, :, None]

    def step(carry, inp):
        c, n, m = carry
        qc, kc, vc, lic, lfc = inp
        bcum = jnp.cumsum(lfc, axis=1)
        dlog = jnp.where(mask, bcum[:, :, None] - bcum[:, None] + lic[:, None], -jnp.inf)
        inter = bcum + m[:, None]
        m_t = jnp.maximum(inter, jnp.max(dlog, axis=2))
        s = jnp.einsum('bthd,bshd->btsh', qc, kc) * jnp.exp(dlog - m_t[:, :, None])
        w_inter = jnp.exp(inter - m_t)
        num = (jnp.einsum('btsh,bshv->bthv', s, vc)
               + w_inter[..., None] * jnp.einsum('bthd,bhdv->bthv', qc, c))
        den = jnp.sum(s, axis=2) + w_inter * jnp.einsum('bthd,bhd->bth', qc, n)
        h = num / jnp.maximum(jnp.abs(den), jnp.exp(-m_t))[..., None]
        b_end = bcum[:, -1]
        wlog = b_end[:, None] - bcum + lic
        m_new = jnp.maximum(b_end + m, jnp.max(wlog, axis=1))
        ws = jnp.exp(wlog - m_new[:, None])
        dc = jnp.exp(b_end + m - m_new)
        c = dc[..., None, None] * c + jnp.einsum('bshd,bshv->bhdv', ws[..., None] * kc, vc)
        n = dc[..., None] * n + jnp.einsum('bsh,bshd->bhd', ws, kc)
        return (c, n, m_new), h

    seq = (_to_chunks(q, length), _to_chunks(k, length), _to_chunks(v, length),
           _to_chunks(logi, length), _to_chunks(logf, length))
    init = (c0.astype(jnp.float32), n0.astype(jnp.float32), m0.astype(jnp.float32))
    (c, n, m), hs = lax.scan(step, init, seq)
    return _from_chunks(hs), (c, n, m)


def _rwkv7_scan(r, decay, k, v, kk, a, s0):
    def step(s, inp):
        r_t, w_t, k_t, v_t, kk_t, a_t = inp
        sa = jnp.einsum('bhvk,bhk->bhv', s, -kk_t)
        s = (s * w_t[:, :, None, :] + sa[..., None] * (kk_t * a_t)[:, :, None, :]
             + v_t[..., None] * k_t[:, :, None, :])
        return s, jnp.einsum('bhvk,bhk->bhv', s, r_t)

    seq = tuple(jnp.moveaxis(z.astype(jnp.float32), 1, 0) for z in (r, decay, k, v, kk, a))
    s, ys = lax.scan(step, s0.astype(jnp.float32), seq)
    return jnp.moveaxis(ys, 0, 1), s


def _ssd_mlstm_mixer(xn, conv_buf, ssm_h, mc, mn, mm, p, i):
    b, t, _ = xn.shape
    dty = xn.dtype
    proj = xn @ p['w_in0'][i]
    s1 = SSD_D_INNER
    s2 = s1 + CONV_DIM
    s3 = s2 + SSD_HEADS
    s4 = s3 + MLSTM_D_INNER
    s5 = s4 + MLSTM_HEADS
    z_ssd, conv_in, dt_pre, o_pre, i_pre, f_pre = jnp.split(proj, [s1, s2, s3, s4, s5], axis=-1)
    conv_out, new_conv = _causal_conv(conv_in, conv_buf, p['conv_w'][i], p['conv_b'][i])
    conv_act = jax.nn.silu(conv_out)
    gn = SSD_GROUPS * SSD_D_STATE
    xs, bm, cm, xm_act = jnp.split(conv_act, [SSD_D_INNER, SSD_D_INNER + gn, SSD_D_INNER + 2 * gn], axis=-1)
    xm_raw = conv_in[..., SSD_D_INNER + 2 * gn:]
    dt = jax.nn.softplus((dt_pre + p['ssd_dt_bias'][i]).astype(jnp.float32))
    a_neg = -jnp.exp(p['ssd_a_log'][i].astype(jnp.float32))
    xh = xs.reshape(b, t, SSD_HEADS, SSD_HEAD_DIM)
    y, new_h = _ssd_scan(xh, dt, a_neg, bm.reshape(b, t, SSD_GROUPS, SSD_D_STATE),
                         cm.reshape(b, t, SSD_GROUPS, SSD_D_STATE), ssm_h)
    y = y.astype(dty) + p['ssd_d'][i][:, None] * xh
    y = _group_rms(y.reshape(b, t, SSD_D_INNER) * jax.nn.silu(z_ssd), SSD_GROUPS, p['ssd_norm'][i])
    hs = (b, t, MLSTM_HEADS, MLSTM_HEAD_DIM)
    q = _blockdiag(xm_act, p['ml_wq'][i]).reshape(hs)
    k = _blockdiag(xm_act, p['ml_wk'][i]).reshape(hs) * (MLSTM_HEAD_DIM ** -0.5)
    v = _blockdiag(xm_raw, p['ml_wv'][i]).reshape(hs)
    logi = (i_pre + p['ml_i_bias'][i]).astype(jnp.float32)
    logf = jax.nn.log_sigmoid((f_pre + p['ml_f_bias'][i]).astype(jnp.float32))
    hm, (new_c, new_n, new_m) = _mlstm_scan(q, k, v, logi, logf, mc, mn, mm)
    hm = _group_rms(hm.astype(dty).reshape(b, t, MLSTM_D_INNER), MLSTM_HEADS, p['ml_norm'][i])
    hm = (hm + p['ml_skip'][i] * xm_act) * jax.nn.sigmoid(o_pre)
    out = jnp.concatenate([y, hm], axis=-1) @ p['w_out0'][i]
    return out, (new_conv, new_h, new_c, new_n, new_m)


def _rwkv7_mixer(xn, shift, wkv, p, j):
    b, t, d = xn.shape
    hs = (b, t, RWKV_HEADS, RWKV_HEAD_DIM)
    x_prev = jnp.concatenate([shift[:, None].astype(xn.dtype), xn[:, :-1]], axis=1)
    xx = x_prev - xn
    mu = p['rw_mu'][j]
    xr, xw, xk, xv, xa, xg = (xn + xx * mu[c] for c in range(6))
    r = xr @ p['rw_wr'][j]
    w = -jax.nn.softplus(-(p['rw_w0'][j] + jnp.tanh(xw @ p['rw_w1'][j]) @ p['rw_w2'][j])) - 0.5
    k = xk @ p['rw_wk'][j]
    v = xv @ p['rw_wv'][j]
    a = jax.nn.sigmoid(p['rw_a0'][j] + (xa @ p['rw_a1'][j]) @ p['rw_a2'][j])
    g = jax.nn.sigmoid(xg @ p['rw_g1'][j]) @ p['rw_g2'][j]
    kk = (k * p['rw_k_k'][j]).reshape(hs).astype(jnp.float32)
    kk = kk / jnp.maximum(jnp.sqrt(jnp.sum(kk * kk, axis=-1, keepdims=True)), 1e-12)
    k = k * (1 + (a - 1) * p['rw_k_a'][j])
    decay = jnp.exp(-jnp.exp(w.astype(jnp.float32)))
    y, new_s = _rwkv7_scan(r.reshape(hs), decay.reshape(hs), k.reshape(hs), v.reshape(hs),
                           kk, a.reshape(hs), wkv)
    mean = jnp.mean(y, axis=-1, keepdims=True)
    var = jnp.mean(jnp.square(y - mean), axis=-1, keepdims=True)
    y = ((y - mean) * lax.rsqrt(var + RWKV_LN_EPS)).reshape(b, t, d).astype(xn.dtype)
    y = y * p['rw_ln_w'][j] + p['rw_ln_b'][j]
    bonus = jnp.sum(r.reshape(hs) * k.reshape(hs) * p['rw_r_k'][j].reshape(RWKV_HEADS, RWKV_HEAD_DIM),
                    axis=-1, keepdims=True) * v.reshape(hs)
    y = (y + bonus.reshape(b, t, d)) * g
    return y @ p['rw_wo'][j], (xn[:, -1], new_s)


def _swiglu(x, w_gu, w_down):
    gate, up = jnp.split(x @ w_gu, 2, axis=-1)
    return (jax.nn.silu(gate) * up) @ w_down


def _trunk(x, conv, ssm, mc, mn, mm, shift, wkv, p):
    even_names = ('conv', 'ssm', 'mc', 'mn', 'mm')
    odd_names = ('shift', 'wkv')
    outs = {name: [] for name in even_names + odd_names}
    for layer in range(DEPTH):
        xn = _rms(x, p['norm_mix'][layer])
        if layer % 2 == 0:
            i = layer // 2
            mix, st = _ssd_mlstm_mixer(xn, conv[i], ssm[i], mc[i], mn[i], mm[i], p, i)
            for name, s in zip(even_names, st):
                outs[name].append(s)
        else:
            j = layer // 2
            mix, st = _rwkv7_mixer(xn, shift[j], wkv[j], p, j)
            for name, s in zip(odd_names, st):
                outs[name].append(s)
        x = x + mix.astype(x.dtype)
        x = x + _swiglu(_rms(x, p['norm_ffn'][layer]), p['ffn_w_gate_up'][layer], p['ffn_w_down'][layer])
    y = _rms(x, p['norm_final'])
    return y, tuple(jnp.stack(outs[name]) for name in even_names + odd_names)


def setup_inputs(seed: int = 0) -> dict:
    key = jax.random.key(seed)
    ks = iter(jax.random.split(key, 64))

    def nrm(shape, scale):
        return scale * jax.random.normal(next(ks), shape, jnp.float32)

    d = D_MODEL
    x_prompt = nrm((BATCH, SEQ, d), 1.0)
    x_sample = nrm((DEC_BATCH, DEC_SEQ, d), 1.0)
    state_conv = nrm((N_EVEN, DEC_BATCH, CONV_W - 1, CONV_DIM), 1.0)
    state_ssm = nrm((N_EVEN, DEC_BATCH, SSD_HEADS, SSD_HEAD_DIM, SSD_D_STATE), 0.1)
    state_mlstm_c = nrm((N_EVEN, DEC_BATCH, MLSTM_HEADS, MLSTM_HEAD_DIM, MLSTM_HEAD_DIM), 0.1)
    state_mlstm_n = nrm((N_EVEN, DEC_BATCH, MLSTM_HEADS, MLSTM_HEAD_DIM), 0.1)
    state_mlstm_m = nrm((N_EVEN, DEC_BATCH, MLSTM_HEADS), 1.0)
    state_shift = nrm((N_ODD, DEC_BATCH, d), 1.0)
    state_wkv = nrm((N_ODD, DEC_BATCH, RWKV_HEADS, RWKV_HEAD_DIM, RWKV_HEAD_DIM), 0.1)

    norm_mix = 1.0 + nrm((DEPTH, d), 0.02)
    norm_ffn = 1.0 + nrm((DEPTH, d), 0.02)
    norm_final = 1.0 + nrm((d,), 0.02)
    w_in0 = nrm((N_EVEN, d, IN0_DIM), d ** -0.5)
    conv_w = nrm((N_EVEN, CONV_W, CONV_DIM), 0.5)
    conv_b = nrm((N_EVEN, CONV_DIM), 0.02)
    dt0 = jnp.exp(jax.random.uniform(next(ks), (N_EVEN, SSD_HEADS), jnp.float32,
                                     minval=math.log(1e-3), maxval=math.log(1e-1)))
    ssd_dt_bias = dt0 + jnp.log(-jnp.expm1(-dt0))
    ssd_a_log = jnp.log(jax.random.uniform(next(ks), (N_EVEN, SSD_HEADS), jnp.float32, minval=1.0, maxval=16.0))
    ssd_d = 1.0 + nrm((N_EVEN, SSD_HEADS), 0.1)
    ssd_norm = 1.0 + nrm((N_EVEN, SSD_D_INNER), 0.02)
    nb = MLSTM_D_INNER // QKV_BLOCK
    ml_wq = nrm((N_EVEN, nb, QKV_BLOCK, QKV_BLOCK), QKV_BLOCK ** -0.5)
    ml_wk = nrm((N_EVEN, nb, QKV_BLOCK, QKV_BLOCK), QKV_BLOCK ** -0.5)
    ml_wv = nrm((N_EVEN, nb, QKV_BLOCK, QKV_BLOCK), QKV_BLOCK ** -0.5)
    ml_i_bias = nrm((N_EVEN, MLSTM_HEADS), 0.1)
    ml_f_bias = jnp.linspace(3.0, 6.0, MLSTM_HEADS)[None, :] + nrm((N_EVEN, MLSTM_HEADS), 0.1)
    ml_norm = 1.0 + nrm((N_EVEN, MLSTM_D_INNER), 0.02)
    ml_skip = 1.0 + nrm((N_EVEN, MLSTM_D_INNER), 0.02)
    w_out0 = nrm((N_EVEN, MIX0_DIM, d), MIX0_DIM ** -0.5)

    rw_mu = jax.random.uniform(next(ks), (N_ODD, 6, d), jnp.float32)
    rw_wr = nrm((N_ODD, d, d), d ** -0.5)
    rw_wk = nrm((N_ODD, d, d), d ** -0.5)
    rw_wv = nrm((N_ODD, d, d), d ** -0.5)
    rw_wo = nrm((N_ODD, d, d), d ** -0.5)
    rw_w0 = jnp.linspace(-6.0, 1.0, d)[None, :] + nrm((N_ODD, d), 0.1)
    rw_w1 = nrm((N_ODD, d, DECAY_LORA), d ** -0.5)
    rw_w2 = nrm((N_ODD, DECAY_LORA, d), 0.1 * DECAY_LORA ** -0.5)
    rw_a0 = nrm((N_ODD, d), 0.1)
    rw_a1 = nrm((N_ODD, d, AAA_LORA), d ** -0.5)
    rw_a2 = nrm((N_ODD, AAA_LORA, d), 0.1 * AAA_LORA ** -0.5)
    rw_g1 = nrm((N_ODD, d, GATE_LORA), d ** -0.5)
    rw_g2 = nrm((N_ODD, GATE_LORA, d), GATE_LORA ** -0.5)
    rw_k_k = 0.85 + nrm((N_ODD, d), 0.02)
    rw_k_a = 1.0 + nrm((N_ODD, d), 0.02)
    rw_r_k = nrm((N_ODD, d), 0.1)
    rw_ln_w = 1.0 + nrm((N_ODD, d), 0.02)
    rw_ln_b = nrm((N_ODD, d), 0.02)
    ffn_w_gate_up = nrm((DEPTH, d, 2 * D_FF), d ** -0.5)
    ffn_w_down = nrm((DEPTH, D_FF, d), D_FF ** -0.5)
    return {'x_prompt': x_prompt, 'x_sample': x_sample,
            'state_conv': state_conv, 'state_ssm': state_ssm, 'state_mlstm_c': state_mlstm_c,
            'state_mlstm_n': state_mlstm_n, 'state_mlstm_m': state_mlstm_m,
            'state_shift': state_shift, 'state_wkv': state_wkv,
            'norm_mix': norm_mix, 'norm_ffn': norm_ffn, 'norm_final': norm_final,
            'w_in0': w_in0, 'conv_w': conv_w, 'conv_b': conv_b, 'ssd_dt_bias': ssd_dt_bias,
            'ssd_a_log': ssd_a_log, 'ssd_d': ssd_d, 'ssd_norm': ssd_norm,
            'ml_wq': ml_wq, 'ml_wk': ml_wk, 'ml_wv': ml_wv, 'ml_i_bias': ml_i_bias, 'ml_f_bias': ml_f_bias,
            'ml_norm': ml_norm, 'ml_skip': ml_skip, 'w_out0': w_out0,
            'rw_mu': rw_mu, 'rw_wr': rw_wr, 'rw_wk': rw_wk, 'rw_wv': rw_wv, 'rw_wo': rw_wo,
            'rw_w0': rw_w0, 'rw_w1': rw_w1, 'rw_w2': rw_w2, 'rw_a0': rw_a0, 'rw_a1': rw_a1, 'rw_a2': rw_a2,
            'rw_g1': rw_g1, 'rw_g2': rw_g2, 'rw_k_k': rw_k_k, 'rw_k_a': rw_k_a, 'rw_r_k': rw_r_k,
            'rw_ln_w': rw_ln_w, 'rw_ln_b': rw_ln_b,
            'ffn_w_gate_up': ffn_w_gate_up, 'ffn_w_down': ffn_w_down}


def reference(x_prompt, x_sample, state_conv, state_ssm, state_mlstm_c, state_mlstm_n, state_mlstm_m,
              state_shift, state_wkv, norm_mix, norm_ffn, norm_final, w_in0, conv_w, conv_b,
              ssd_dt_bias, ssd_a_log, ssd_d, ssd_norm, ml_wq, ml_wk, ml_wv, ml_i_bias, ml_f_bias,
              ml_norm, ml_skip, w_out0, rw_mu, rw_wr, rw_wk, rw_wv, rw_wo, rw_w0, rw_w1, rw_w2,
              rw_a0, rw_a1, rw_a2, rw_g1, rw_g2, rw_k_k, rw_k_a, rw_r_k, rw_ln_w, rw_ln_b,
              ffn_w_gate_up, ffn_w_down):
    p = dict(norm_mix=norm_mix, norm_ffn=norm_ffn, norm_final=norm_final, w_in0=w_in0,
             conv_w=conv_w, conv_b=conv_b, ssd_dt_bias=ssd_dt_bias, ssd_a_log=ssd_a_log,
             ssd_d=ssd_d, ssd_norm=ssd_norm, ml_wq=ml_wq, ml_wk=ml_wk, ml_wv=ml_wv,
             ml_i_bias=ml_i_bias, ml_f_bias=ml_f_bias, ml_norm=ml_norm, ml_skip=ml_skip,
             w_out0=w_out0, rw_mu=rw_mu, rw_wr=rw_wr, rw_wk=rw_wk, rw_wv=rw_wv, rw_wo=rw_wo,
             rw_w0=rw_w0, rw_w1=rw_w1, rw_w2=rw_w2, rw_a0=rw_a0, rw_a1=rw_a1, rw_a2=rw_a2,
             rw_g1=rw_g1, rw_g2=rw_g2, rw_k_k=rw_k_k, rw_k_a=rw_k_a, rw_r_k=rw_r_k,
             rw_ln_w=rw_ln_w, rw_ln_b=rw_ln_b, ffn_w_gate_up=ffn_w_gate_up, ffn_w_down=ffn_w_down)
    bp = x_prompt.shape[0]
    zeros = functools.partial(jnp.zeros, dtype=x_prompt.dtype)
    y_prompt, (conv_p, ssm_p, mlstm_c_p, mlstm_n_p, mlstm_m_p, shift_p, wkv_p) = _trunk(
        x_prompt,
        zeros((N_EVEN, bp) + state_conv.shape[2:]),
        zeros((N_EVEN, bp) + state_ssm.shape[2:]),
        zeros((N_EVEN, bp) + state_mlstm_c.shape[2:]),
        zeros((N_EVEN, bp) + state_mlstm_n.shape[2:]),
        zeros((N_EVEN, bp) + state_mlstm_m.shape[2:]),
        zeros((N_ODD, bp) + state_shift.shape[2:]),
        zeros((N_ODD, bp) + state_wkv.shape[2:]),
        p)
    y_sample, (conv_s, ssm_s, mlstm_c_s, mlstm_n_s, mlstm_m_s, shift_s, wkv_s) = _trunk(
        x_sample, state_conv, state_ssm, state_mlstm_c, state_mlstm_n, state_mlstm_m,
        state_shift, state_wkv, p)
    return (y_prompt, y_sample, conv_p, conv_s, ssm_p, ssm_s, mlstm_c_p, mlstm_c_s,
            mlstm_n_p, mlstm_n_s, mlstm_m_p, mlstm_m_s, shift_p, shift_s, wkv_p, wkv_s)
```

```cpp
#include <hip/hip_runtime.h>
#include <hip/hip_cooperative_groups.h>
#include <cstdio>
namespace cg = cooperative_groups;

#ifndef DBG_DPN
#define DBG_DPN 4
#endif
#ifndef DBG_NORM_IT
#define DBG_NORM_IT 16
#endif
#ifndef MK_MULTI
#define MK_MULTI 0
#endif
#ifdef ONLY_PH
#define PHEN(n) ((n) == ONLY_PH)
#else
#define PHEN(n) true
#endif

typedef unsigned short u16;
typedef __attribute__((ext_vector_type(8))) short bf16x8;
typedef __attribute__((ext_vector_type(16))) float f32x16;

constexpr int TP = 16384, TS = 128, TT = 16512, DM = 1024;
constexpr int PJ = 4608;
constexpr int NPH = 20;
constexpr float EPS = 1e-5f;

enum { I_XP = 0, I_XS, I_SCONV, I_SSSM, I_SMC, I_SMN, I_SMM, I_SSHIFT, I_SWKV, I_NMIX, I_NFFN, I_NFIN, I_WIN0,
       I_CONVW, I_CONVB, I_DTB, I_ALOG, I_SSDD, I_SSDN, I_WQ, I_WK, I_WV, I_IB, I_FB, I_MLN, I_MLS, I_WOUT0,
       I_MU, I_WR, I_WKK, I_WVV, I_WO, I_W0, I_W1, I_W2, I_A0, I_A1, I_A2, I_G1, I_G2, I_KK, I_KA, I_RK,
       I_LNW, I_LNB, I_GU, I_DN, N_IN };

constexpr size_t O_Y = 0;
constexpr size_t O_CONVP = O_Y + (size_t)TT * 1024;
constexpr size_t O_CONVS = O_CONVP + 8 * 3 * 2560;
constexpr size_t O_SSMP = O_CONVS + 128 * 3 * 2560;
constexpr size_t O_SSMS = O_SSMP + 8ull * 16 * 64 * 128;
constexpr size_t O_MCP = O_SSMS + 128ull * 16 * 64 * 128;
constexpr size_t O_MCS = O_MCP + 8ull * 4 * 256 * 256;
constexpr size_t O_MNP = O_MCS + 128ull * 4 * 256 * 256;
constexpr size_t O_MNS = O_MNP + 8 * 4 * 256;
constexpr size_t O_MMP = O_MNS + 128 * 4 * 256;
constexpr size_t O_MMS = O_MMP + 32;
constexpr size_t O_SHP = O_MMS + 512;
constexpr size_t O_SHS = O_SHP + 8 * 1024;
constexpr size_t O_WKVP = O_SHS + 128 * 1024;
constexpr size_t O_WKVS = O_WKVP + 8ull * 16 * 64 * 64;

constexpr size_t U = 33ull << 20;
constexpr size_t W_IN0 = 0;
constexpr size_t W_OUT0 = W_IN0 + 4736ull * 1024 * 2;
constexpr size_t W_GU = W_OUT0 + 1024ull * 2048 * 2;
constexpr size_t W_DN = W_GU + 2ull * 5632 * 1024 * 2;
constexpr size_t W_R = W_DN + 2ull * 1024 * 2816 * 2;
constexpr size_t W_K = W_R + 1024ull * 1024 * 2;
constexpr size_t W_V = W_K + 1024ull * 1024 * 2;
constexpr size_t W_O = W_V + 1024ull * 1024 * 2;
constexpr size_t W_W1 = W_O + 1024ull * 1024 * 2;
constexpr size_t W_A1 = W_W1 + 128ull * 1024 * 2;
constexpr size_t W_G1 = W_A1 + 128ull * 1024 * 2;
constexpr size_t W_W2 = W_G1 + 256ull * 1024 * 2;
constexpr size_t W_A2 = W_W2 + 1024ull * 64 * 2;
constexpr size_t W_G2 = W_A2 + 1024ull * 64 * 2;
constexpr size_t W_END = W_G2 + 1024ull * 192 * 2;
static_assert(W_END <= 2 * U, "weights");
constexpr size_t B_A = 2 * U;
constexpr size_t B_PROJ = 3 * U;
constexpr size_t B_SMALL = 8 * U;
constexpr size_t B_BM = B_SMALL + (size_t)TT * 32 * 4;
constexpr size_t B_CM = B_BM + (size_t)TT * 256 * 2;
constexpr size_t B_XM = 9 * U;
constexpr size_t B_SSDST = 10 * U;
constexpr size_t B_MLST = 11 * U;
constexpr size_t B_MIX = 13 * U;
constexpr size_t B_MISC = 15 * U;
constexpr size_t M_GSUM = B_MISC;
constexpr size_t M_BCUM = M_GSUM + 8 * 4 * 16 * 2 * 4;
constexpr size_t M_LI = M_BCUM + (size_t)TT * 4 * 4;
constexpr size_t M_DT = M_LI + (size_t)TT * 4 * 4;
constexpr size_t M_ACUM = M_DT + (size_t)TT * 16 * 4;
constexpr size_t M_MLN = M_ACUM + (size_t)TT * 16 * 4;
constexpr size_t M_END = M_MLN + 8ull * 4 * 16 * 256 * 4;
constexpr size_t WS_NEED = 15 * U + (8ull << 20);
static_assert(M_END <= WS_NEED, "misc");
static_assert(B_CM + (size_t)TT * 256 * 2 <= 9 * U, "bm/cm");
constexpr size_t B_X1 = 3 * U, B_HB = 5 * U, B_X2 = 8 * U;
constexpr size_t B_RB = 10 * U, B_KB = 11 * U, B_VB = 12 * U;
constexpr size_t B_LW = 13 * U, B_LA = B_LW + (size_t)TT * 64 * 2, B_LG = B_LA + (size_t)TT * 64 * 2;
constexpr size_t B_DEC = 3 * U, B_AB = 5 * U, B_GB = 6 * U, B_YB = 7 * U;
constexpr size_t B_YRAW = 13 * U;
constexpr size_t B_X3 = 3 * U, B_X4 = 8 * U;

constexpr int LDS_BYTES = 65536 + 10240;

struct P {
  const float* in[N_IN];
  float* out;
  char* ws;
};

__device__ __forceinline__ u16 f2bf(float f) {
  unsigned u = __float_as_uint(f);
  u += 0x7fffu + ((u >> 16) & 1u);
  return (u16)(u >> 16);
}
__device__ __forceinline__ float bf2f(u16 h) { return __uint_as_float(((unsigned)h) << 16); }
__device__ __forceinline__ unsigned pk2(float a, float b) { return (unsigned)f2bf(a) | ((unsigned)f2bf(b) << 16); }
__device__ __forceinline__ float lo2f(unsigned u) { return __uint_as_float(u << 16); }
__device__ __forceinline__ float hi2f(unsigned u) { return __uint_as_float(u & 0xffff0000u); }
__device__ __forceinline__ void unpack8(const uint4& q, float* f) {
  f[0] = lo2f(q.x); f[1] = hi2f(q.x); f[2] = lo2f(q.y); f[3] = hi2f(q.y);
  f[4] = lo2f(q.z); f[5] = hi2f(q.z); f[6] = lo2f(q.w); f[7] = hi2f(q.w);
}
__device__ __forceinline__ uint4 pack8(const float* f) {
  uint4 q; q.x = pk2(f[0], f[1]); q.y = pk2(f[2], f[3]); q.z = pk2(f[4], f[5]); q.w = pk2(f[6], f[7]);
  return q;
}
__device__ __forceinline__ float softplusf(float x) { return x > 20.f ? x : log1pf(__expf(x)); }
__device__ __forceinline__ float sigmoidf(float x) { return 1.f / (1.f + __expf(-x)); }
__device__ __forceinline__ float wsum(float v) {
#pragma unroll
  for (int m = 32; m >= 1; m >>= 1) v += __shfl_xor(v, m);
  return v;
}
__device__ __forceinline__ float wmax(float v) {
#pragma unroll
  for (int m = 32; m >= 1; m >>= 1) v = fmaxf(v, __shfl_xor(v, m));
  return v;
}
__device__ __forceinline__ float wscan(float v, int lane) {
#pragma unroll
  for (int o = 1; o < 64; o <<= 1) {
    float t = __shfl_up(v, o);
    if (lane >= o) v += t;
  }
  return v;
}
__device__ __forceinline__ float bsum(float v, float* scr) {
  v = wsum(v);
  __syncthreads();
  if ((threadIdx.x & 63) == 0) scr[threadIdx.x >> 6] = v;
  __syncthreads();
  return scr[0] + scr[1] + scr[2] + scr[3];
}
__device__ __forceinline__ float dpp_f(float v, const int ctrl);
#define DPPF(v, ctrl) __int_as_float(__builtin_amdgcn_update_dpp(0, __float_as_int(v), ctrl, 0xF, 0xF, true))

__device__ __forceinline__ int img_off(int row, int kk  ) {
  return row * 128 + ((((kk >> 3) ^ ((row >> 1) & 7))) << 4) + ((kk & 7) << 1);
}

template <int MI, int NI>
__device__ __forceinline__ void mma_panel(f32x16 (&acc)[MI][NI], const char* Ap, int ar0, const char* Bp, int br0, int lane) {
  const int r = lane & 31, h = lane >> 5;
#pragma unroll
  for (int ks = 0; ks < 4; ++ks) {
    const int ch = ks * 2 + h;
    bf16x8 a[MI], b[NI];
#pragma unroll
    for (int mi = 0; mi < MI; ++mi) {
      int row = ar0 + mi * 32 + r;
      a[mi] = *(const bf16x8*)(Ap + row * 128 + ((ch ^ ((row >> 1) & 7)) << 4));
    }
#pragma unroll
    for (int ni = 0; ni < NI; ++ni) {
      int row = br0 + ni * 32 + r;
      b[ni] = *(const bf16x8*)(Bp + row * 128 + ((ch ^ ((row >> 1) & 7)) << 4));
    }
#pragma unroll
    for (int mi = 0; mi < MI; ++mi)
#pragma unroll
      for (int ni = 0; ni < NI; ++ni)
        acc[mi][ni] = __builtin_amdgcn_mfma_f32_32x32x16_bf16(a[mi], b[ni], acc[mi][ni], 0, 0, 0);
  }
}
template <int MI, int NI>
__device__ __forceinline__ void zero_acc(f32x16 (&acc)[MI][NI]) {
#pragma unroll
  for (int mi = 0; mi < MI; ++mi)
#pragma unroll
    for (int ni = 0; ni < NI; ++ni)
#pragma unroll
      for (int i = 0; i < 16; ++i) acc[mi][ni][i] = 0.f;
}
#define SB() __builtin_amdgcn_sched_barrier(0)
#define FRESH_TID(tid) int tid = threadIdx.x; asm volatile("" : "+v"(tid))
__device__ __forceinline__ int zof(int w) { int z; asm("s_mov_b32 %0, 0" : "=s"(z) : "s"(w)); return z; }
#define ACC_ROW(i, lane) (((i) & 3) + 8 * ((i) >> 2) + 4 * ((lane) >> 5))

template <class Epi>
__device__ __forceinline__ void gemm_tile(const u16* __restrict__ A, int lda, const u16* __restrict__ B, int ldb, int K,
                                          int m0, int n0, char* lds, const Epi& epi) {
  FRESH_TID(tid);
  const int lane = tid & 63, wid = tid >> 6, wr = wid & 1, wc = wid >> 1;
  f32x16 acc[2][2];
  zero_acc<2, 2>(acc);
  const int lrow = tid >> 3, lch = tid & 7;
  const u16* Ap = A + (size_t)(m0 + lrow) * lda + lch * 8;
  const u16* Bp = B + (size_t)(n0 + lrow) * ldb + lch * 8;
  const int soff = lrow * 128 + ((lch ^ ((lrow >> 1) & 7)) << 4);
  uint4 ra[4], rb[4];
  const int nk = K >> 6;
#pragma unroll
  for (int i = 0; i < 4; ++i) {
    ra[i] = *(const uint4*)(Ap + (size_t)(32 * i) * lda);
    rb[i] = *(const uint4*)(Bp + (size_t)(32 * i) * ldb);
  }
#pragma unroll
  for (int i = 0; i < 4; ++i) {
    *(uint4*)(lds + soff + i * 4096) = ra[i];
    *(uint4*)(lds + 16384 + soff + i * 4096) = rb[i];
  }
  __syncthreads();
  for (int kt = 0; kt < nk; ++kt) {
    const int cur = kt & 1;
    const bool more = (kt + 1) < nk;
    if (more) {
#pragma unroll
      for (int i = 0; i < 4; ++i) {
        ra[i] = *(const uint4*)(Ap + (size_t)(32 * i) * lda + (kt + 1) * 64);
        rb[i] = *(const uint4*)(Bp + (size_t)(32 * i) * ldb + (kt + 1) * 64);
      }
    }
    mma_panel<2, 2>(acc, lds + cur * 32768, wr * 64, lds + cur * 32768 + 16384, wc * 64, lane);
    if (more) {
      char* d = lds + (cur ^ 1) * 32768;
#pragma unroll
      for (int i = 0; i < 4; ++i) {
        *(uint4*)(d + soff + i * 4096) = ra[i];
        *(uint4*)(d + 16384 + soff + i * 4096) = rb[i];
      }
    }
    __syncthreads();
  }
  epi(acc, m0 + wr * 64, n0 + wc * 64, lane);
}

struct TDesc { const float* src; u16* dst; int K, N, lds, Kp, Np, mode; };
__device__ __forceinline__ TDesc get_tdesc(const P& p, int i, int zz) {
  TDesc d;
  d.mode = 0;
  char* ws = p.ws;
  switch (i) {
    case 0: d = {p.in[zz + I_WIN0], (u16*)(ws + W_IN0), 1024, 4632, 4632, 1024, 4736, 1}; break;
    case 1: d = {p.in[zz + I_WOUT0], (u16*)(ws + W_OUT0), 2048, 1024, 1024, 2048, 1024, 0}; break;
    case 2: d = {p.in[zz + I_GU], (u16*)(ws + W_GU), 1024, 5632, 5632, 1024, 5632, 2}; break;
    case 3: d = {p.in[zz + I_GU] + 1024ull * 5632, (u16*)(ws + W_GU + 5632ull * 1024 * 2), 1024, 5632, 5632, 1024, 5632, 2}; break;
    case 4: d = {p.in[zz + I_DN], (u16*)(ws + W_DN), 2816, 1024, 1024, 2816, 1024, 0}; break;
    case 5: d = {p.in[zz + I_DN] + 2816ull * 1024, (u16*)(ws + W_DN + 1024ull * 2816 * 2), 2816, 1024, 1024, 2816, 1024, 0}; break;
    case 6: d = {p.in[zz + I_WR], (u16*)(ws + W_R), 1024, 1024, 1024, 1024, 1024, 0}; break;
    case 7: d = {p.in[zz + I_WKK], (u16*)(ws + W_K), 1024, 1024, 1024, 1024, 1024, 0}; break;
    case 8: d = {p.in[zz + I_WVV], (u16*)(ws + W_V), 1024, 1024, 1024, 1024, 1024, 0}; break;
    case 9: d = {p.in[zz + I_WO], (u16*)(ws + W_O), 1024, 1024, 1024, 1024, 1024, 0}; break;
    case 10: d = {p.in[zz + I_W1], (u16*)(ws + W_W1), 1024, 64, 64, 1024, 128, 0}; break;
    case 11: d = {p.in[zz + I_A1], (u16*)(ws + W_A1), 1024, 64, 64, 1024, 128, 0}; break;
    case 12: d = {p.in[zz + I_G1], (u16*)(ws + W_G1), 1024, 160, 160, 1024, 256, 0}; break;
    case 13: d = {p.in[zz + I_W2], (u16*)(ws + W_W2), 64, 1024, 1024, 64, 1024, 0}; break;
    case 14: d = {p.in[zz + I_A2], (u16*)(ws + W_A2), 64, 1024, 1024, 64, 1024, 0}; break;
    default: d = {p.in[zz + I_G2], (u16*)(ws + W_G2), 160, 1024, 1024, 192, 1024, 0}; break;
  }
  return d;
}
__device__ __forceinline__ int tdesc_tiles(int i) {
  switch (i) {
    case 0: return 16 * 74;
    case 1: return 32 * 16;
    case 2: case 3: return 16 * 88;
    case 4: case 5: return 44 * 16;
    case 6: case 7: case 8: case 9: return 16 * 16;
    case 10: case 11: return 16 * 2;
    case 12: return 16 * 4;
    case 13: case 14: return 1 * 16;
    default: return 3 * 16;
  }
}
constexpr int PREP_TILES = 16 * 74 + 32 * 16 + 2 * 16 * 88 + 2 * 44 * 16 + 4 * 256 + 2 * 32 + 64 + 2 * 16 + 48;

__device__ __forceinline__ void rms_rows_bf16(const float* src_row, const float* g, u16* dst_row, int lane) {
  float4 v[4];
  float ss = 0.f;
#pragma unroll
  for (int i = 0; i < 4; ++i) {
    v[i] = ((const float4*)src_row)[lane + 64 * i];
    ss += v[i].x * v[i].x + v[i].y * v[i].y + v[i].z * v[i].z + v[i].w * v[i].w;
  }
  ss = wsum(ss);
  float rinv = rsqrtf(ss * (1.f / 1024.f) + EPS);
#pragma unroll
  for (int i = 0; i < 4; ++i) {
    float4 g4 = ((const float4*)g)[lane + 64 * i];
    uint2 o;
    o.x = pk2(v[i].x * rinv * g4.x, v[i].y * rinv * g4.y);
    o.y = pk2(v[i].z * rinv * g4.z, v[i].w * rinv * g4.w);
    ((uint2*)dst_row)[lane + 64 * i] = o;
  }
}

__device__ __forceinline__ void phase_prep(const P& p, char* lds, int bid, int G) {
  float* tile = (float*)lds;
  const int total = PREP_TILES + TT / 4;
  for (int w = bid; w < total; w += G) {
    FRESH_TID(tid);
    const int zz = zof(w);
    const int lane = tid & 63, wid = tid >> 6;
    if (w < PREP_TILES) {
      int t = w, di = 0;
      for (; di < 16; ++di) {
        int n = tdesc_tiles(di);
        if (t < n) break;
        t -= n;
      }
      TDesc d = get_tdesc(p, di, zz);
      const int nkt = d.Kp >> 6;
      const int kt = t % nkt, nt = t / nkt;
      const int k0 = kt * 64, n0 = nt * 64;
#pragma unroll 4
      for (int i = 0; i < 16; ++i) {
        int kk = i * 4 + (tid >> 6), nn = tid & 63;
        int n = n0 + nn, k = k0 + kk, sc;
        if (d.mode == 0) sc = (n < d.N) ? n : -1;
        else if (d.mode == 1) sc = n < 3584 ? n : (n < 4608 ? 3600 + (n - 3584) : (n < 4624 ? 3584 + (n - 4608) : (n < 4632 ? n : -1)));
        else { int q = n >> 6, j = n & 63; sc = j < 32 ? q * 32 + j : 2816 + q * 32 + (j - 32); }
        float v = 0.f;
        if (sc >= 0 && k < d.K) v = d.src[(size_t)k * d.lds + sc];
        tile[kk * 65 + nn] = v;
      }
      __syncthreads();
#pragma unroll 4
      for (int i = 0; i < 16; ++i) {
        int nn = i * 4 + (tid >> 6), kk = tid & 63;
        d.dst[(size_t)(n0 + nn) * d.Kp + k0 + kk] = f2bf(tile[kk * 65 + nn]);
      }
      __syncthreads();
    } else {
      int row = (w - PREP_TILES) * 4 + wid;
      const float* src = row < TP ? p.in[zz + I_XP] + (size_t)row * 1024 : p.in[zz + I_XS] + (size_t)(row - TP) * 1024;
      rms_rows_bf16(src, p.in[zz + I_NMIX], (u16*)(p.ws + B_A) + (size_t)row * 1024, lane);
    }
  }
}

template <class Epi>
__device__ __forceinline__ void gemm_phase(const u16* A, int lda, const u16* B, int ldb, int K, int MT, int NT, char* lds, int bid, int G, const Epi& epi) {
  const int total = MT * NT;
  for (int t = bid; t < total; t += G) {
    int mt = t % MT, nt = t / MT;
    gemm_tile(A, lda, B, ldb, K, mt * 128, nt * 128, lds, epi);
  }
}

struct EpiProj {
  u16* proj; float* small;
  __device__ __forceinline__ void operator()(f32x16 (&acc)[2][2], int r0, int c0, int lane) const {
#pragma unroll
    for (int mi = 0; mi < 2; ++mi)
#pragma unroll
      for (int ni = 0; ni < 2; ++ni) {
        int col = c0 + ni * 32 + (lane & 31);
#pragma unroll
        for (int i = 0; i < 16; ++i) {
          int row = r0 + mi * 32 + ACC_ROW(i, lane);
          float v = acc[mi][ni][i];
          if (col < PJ) proj[(size_t)row * PJ + col] = f2bf(v);
          else if (col < PJ + 32) small[(size_t)row * 32 + (col - PJ)] = v;
        }
      }
  }
};
struct EpiRes {
  const float* res; const float* res2; float* out;
  __device__ __forceinline__ void operator()(f32x16 (&acc)[2][2], int r0, int c0, int lane) const {
#pragma unroll
    for (int mi = 0; mi < 2; ++mi)
#pragma unroll
      for (int ni = 0; ni < 2; ++ni) {
        int col = c0 + ni * 32 + (lane & 31);
#pragma unroll
        for (int i = 0; i < 16; ++i) {
          int row = r0 + mi * 32 + ACC_ROW(i, lane);
          float rv = row < TP ? res[(size_t)row * 1024 + col] : res2[(size_t)(row - TP) * 1024 + col];
          out[(size_t)row * 1024 + col] = rv + acc[mi][ni][i];
        }
      }
  }
};
struct EpiSwiglu {
  u16* hb;
  __device__ __forceinline__ void operator()(f32x16 (&acc)[2][2], int r0, int c0, int lane) const {
    int col = (c0 >> 1) + (lane & 31);
#pragma unroll
    for (int mi = 0; mi < 2; ++mi)
#pragma unroll
      for (int i = 0; i < 16; ++i) {
        int row = r0 + mi * 32 + ACC_ROW(i, lane);
        float g = acc[mi][0][i], u = acc[mi][1][i];
        hb[(size_t)row * 2816 + col] = f2bf(g * sigmoidf(g) * u);
      }
  }
};
struct EpiAct {
  u16* out; int ldo; int nvalid; int nstore; int act;
  __device__ __forceinline__ void operator()(f32x16 (&acc)[2][2], int r0, int c0, int lane) const {
#pragma unroll
    for (int mi = 0; mi < 2; ++mi)
#pragma unroll
      for (int ni = 0; ni < 2; ++ni) {
        int col = c0 + ni * 32 + (lane & 31);
        if (col >= nstore) continue;
#pragma unroll
        for (int i = 0; i < 16; ++i) {
          int row = r0 + mi * 32 + ACC_ROW(i, lane);
          float v = acc[mi][ni][i];
          if (act == 1) v = tanhf(v);
          else if (act == 2) v = sigmoidf(v);
          if (col >= nvalid) v = 0.f;
          out[(size_t)row * ldo + col] = f2bf(v);
        }
      }
  }
};
struct EpiLora2 {
  int which; const float* bias; float* outf; u16* outb;
  __device__ __forceinline__ void operator()(f32x16 (&acc)[2][2], int r0, int c0, int lane) const {
#pragma unroll
    for (int mi = 0; mi < 2; ++mi)
#pragma unroll
      for (int ni = 0; ni < 2; ++ni) {
        int col = c0 + ni * 32 + (lane & 31);
        float bv = which < 2 ? bias[col] : 0.f;
#pragma unroll
        for (int i = 0; i < 16; ++i) {
          int row = r0 + mi * 32 + ACC_ROW(i, lane);
          float v = acc[mi][ni][i] + bv;
          if (which == 0) {
            float w = -softplusf(-v) - 0.5f;
            outf[(size_t)row * 1024 + col] = __expf(-__expf(w));
          } else if (which == 1) {
            outb[(size_t)row * 1024 + col] = f2bf(sigmoidf(v));
          } else {
            outb[(size_t)row * 1024 + col] = f2bf(v);
          }
        }
      }
  }
};

__device__ __forceinline__ void phase_conv(const P& p, char* lds, int bid, int G) {
  const u16* proj = (const u16*)(p.ws + B_PROJ);
  const float* small = (const float*)(p.ws + B_SMALL);
  u16* xs = (u16*)(p.ws + B_A);
  u16* Bm = (u16*)(p.ws + B_BM);
  u16* Cm = (u16*)(p.ws + B_CM);
  u16* xm = (u16*)(p.ws + B_XM);
  const int zz0 = zof(bid);
  const float* cw = p.in[zz0 + I_CONVW];
  const float* cb = p.in[zz0 + I_CONVB];
  const int n_conv = TT / 4;
  const int n_gate = (512 + 2048) / 4;
  for (int w = bid; w < n_conv + n_gate; w += G) {
    FRESH_TID(tid);
    const int zz = zof(w);
    const int lane = tid & 63, wid = tid >> 6;
    if (w < n_conv) {
      for (int i = tid; i < 1280; i += 256) {
        int r4 = i / 320, cgp = i % 320;
        int row = w * 4 + r4, c0 = cgp * 8;
        float u[4][8];
        if (row < TP) {
          int t = row & 2047;
#pragma unroll
          for (int j = 0; j < 4; ++j) {
            int tt = t - 3 + j;
            if (tt >= 0) {
              uint4 q = *(const uint4*)(proj + (size_t)(row - 3 + j) * PJ + 1024 + c0);
              unpack8(q, u[j]);
            } else {
#pragma unroll
              for (int e = 0; e < 8; ++e) u[j][e] = 0.f;
            }
          }
          if (t >= 2045) {
            int b = row >> 11;
            float* o = p.out + O_CONVP + ((size_t)(b * 3 + (t - 2045)) * 2560 + c0);
#pragma unroll
            for (int e = 0; e < 8; ++e) o[e] = u[3][e];
          }
        } else {
          int bs = row - TP;
#pragma unroll
          for (int j = 0; j < 3; ++j) {
            const float* s = p.in[zz + I_SCONV] + ((size_t)(bs * 3 + j) * 2560 + c0);
#pragma unroll
            for (int e = 0; e < 8; ++e) u[j][e] = s[e];
          }
          uint4 q = *(const uint4*)(proj + (size_t)row * PJ + 1024 + c0);
          unpack8(q, u[3]);
          float* o = p.out + O_CONVS + ((size_t)(bs * 3) * 2560 + c0);
#pragma unroll
          for (int e = 0; e < 8; ++e) { o[e] = u[1][e]; o[2560 + e] = u[2][e]; o[5120 + e] = u[3][e]; }
        }
        float a[8];
#pragma unroll
        for (int e = 0; e < 8; ++e) {
          float v = cb[c0 + e];
#pragma unroll
          for (int j = 0; j < 4; ++j) v += u[j][e] * cw[j * 2560 + c0 + e];
          a[e] = v * sigmoidf(v);
        }
        uint4 o = pack8(a);
        u16* dst;
        if (c0 < 1024) dst = xs + (size_t)row * 1024 + c0;
        else if (c0 < 1280) dst = Bm + (size_t)row * 256 + (c0 - 1024);
        else if (c0 < 1536) dst = Cm + (size_t)row * 256 + (c0 - 1280);
        else dst = xm + (size_t)row * 1024 + (c0 - 1536);
        *(uint4*)dst = o;
      }
    } else {
      int wi = (w - n_conv) * 4 + wid;
      int t0 = 2 * lane;
      if (wi < 512) {
        int c = wi & 15, h = (wi >> 4) & 3, b = wi >> 6;
        int row0 = b * 2048 + c * 128;
        float fb = p.in[zz + I_FB][h], ib = p.in[zz + I_IB][h];
        float f0 = small[(size_t)(row0 + t0) * 32 + 20 + h] + fb, f1 = small[(size_t)(row0 + t0 + 1) * 32 + 20 + h] + fb;
        float i0 = small[(size_t)(row0 + t0) * 32 + 16 + h] + ib, i1 = small[(size_t)(row0 + t0 + 1) * 32 + 16 + h] + ib;
        float lf0 = -softplusf(-f0), lf1 = -softplusf(-f1);
        float inc = wscan(lf0 + lf1, lane);
        float bc1 = inc, bc0 = inc - lf1;
        float uu = wmax(fmaxf(i0 - bc0, i1 - bc1));
        float bend = __shfl(inc, 63);
        float* bcum = (float*)(p.ws + M_BCUM);
        float* li = (float*)(p.ws + M_LI);
        bcum[(size_t)(row0 + t0) * 4 + h] = bc0; bcum[(size_t)(row0 + t0 + 1) * 4 + h] = bc1;
        li[(size_t)(row0 + t0) * 4 + h] = i0; li[(size_t)(row0 + t0 + 1) * 4 + h] = i1;
        if (lane == 0) {
          float* gs = (float*)(p.ws + M_GSUM) + (size_t)((b * 4 + h) * 16 + c) * 2;
          gs[0] = bend; gs[1] = uu;
        }
      } else {
        int x = wi - 512;
        int h = x & 15, c = (x >> 4) & 15, b = x >> 8;
        int row0 = b * 2048 + c * 128;
        float db = p.in[zz + I_DTB][h], an = -__expf(p.in[zz + I_ALOG][h]);
        float d0 = softplusf(small[(size_t)(row0 + t0) * 32 + h] + db), d1 = softplusf(small[(size_t)(row0 + t0 + 1) * 32 + h] + db);
        float inc = wscan((d0 + d1) * an, lane);
        float* dt = (float*)(p.ws + M_DT);
        float* ac = (float*)(p.ws + M_ACUM);
        dt[(size_t)(row0 + t0) * 16 + h] = d0; dt[(size_t)(row0 + t0 + 1) * 16 + h] = d1;
        ac[(size_t)(row0 + t0) * 16 + h] = inc - d1 * an; ac[(size_t)(row0 + t0 + 1) * 16 + h] = inc;
      }
    }
  }
}

__device__ __forceinline__ void blockdiag8(const float* x, const float* __restrict__ w, int ch0, float scale, float* o) {
  const float4* w4 = (const float4*)(w + (size_t)(ch0 >> 2) * 16);
#pragma unroll
  for (int blk = 0; blk < 2; ++blk) {
    float4 r0 = w4[blk * 4 + 0], r1 = w4[blk * 4 + 1], r2 = w4[blk * 4 + 2], r3 = w4[blk * 4 + 3];
    const float* xx = x + blk * 4;
    o[blk * 4 + 0] = (xx[0] * r0.x + xx[1] * r1.x + xx[2] * r2.x + xx[3] * r3.x) * scale;
    o[blk * 4 + 1] = (xx[0] * r0.y + xx[1] * r1.y + xx[2] * r2.y + xx[3] * r3.y) * scale;
    o[blk * 4 + 2] = (xx[0] * r0.z + xx[1] * r1.z + xx[2] * r2.z + xx[3] * r3.z) * scale;
    o[blk * 4 + 3] = (xx[0] * r0.w + xx[1] * r1.w + xx[2] * r2.w + xx[3] * r3.w) * scale;
  }
}
__device__ __forceinline__ void mchain(const float* gs  , int c, float& mc, float& mn, float& bend) {
  float m = 0.f;
  for (int j = 0; j < c; ++j) m = gs[j * 2] + fmaxf(m, gs[j * 2 + 1]);
  mc = m;
  bend = gs[c * 2];
  mn = bend + fmaxf(m, gs[c * 2 + 1]);
}

__device__ __forceinline__ void img_put_t(char* img, int R, int j0, int s, const float* v) {
  char* pb = img + (s >> 6) * (R * 128);
#pragma unroll
  for (int e = 0; e < 8; ++e) *(u16*)(pb + img_off(j0 + e, s & 63)) = f2bf(v[e]);
}

__device__ __forceinline__ void phase_chunkstate(const P& p, char* lds, int bid, int G) {
  const u16* proj = (const u16*)(p.ws + B_PROJ);
  const float* small = (const float*)(p.ws + B_SMALL);
  const u16* xs = (const u16*)(p.ws + B_A);
  const u16* Bm = (const u16*)(p.ws + B_BM);
  const u16* Cm = (const u16*)(p.ws + B_CM);
  const u16* xm = (const u16*)(p.ws + B_XM);
  u16* mix = (u16*)(p.ws + B_MIX);
  char* R0 = lds;
  char* R1 = lds + 32768;
  float* ex = (float*)(lds + 65536);
  for (int w = bid; w < 2048; w += G) {
    FRESH_TID(tid);
    const int zz = zof(w);
    const int lane = tid & 63, wid = tid >> 6;
    if (w < 512) {
      const int bs = w >> 2, h = w & 3, row = TP + bs;
      float* sq = ex; float* sk = ex + 256; float* sv = ex + 512; float* scr = ex + 768;
      {
        int d = tid, cb4 = d & ~3, ci = d & 3;
        int nb = (h * 256 + cb4) >> 2;
        float q = 0.f, k = 0.f, v = 0.f;
#pragma unroll
        for (int c = 0; c < 4; ++c) {
          float xa = bf2f(xm[(size_t)row * 1024 + h * 256 + cb4 + c]);
          float xr = bf2f(proj[(size_t)row * PJ + 2560 + h * 256 + cb4 + c]);
          q += xa * p.in[zz + I_WQ][nb * 16 + c * 4 + ci];
          k += xa * p.in[zz + I_WK][nb * 16 + c * 4 + ci];
          v += xr * p.in[zz + I_WV][nb * 16 + c * 4 + ci];
        }
        sq[d] = q; sk[d] = k * 0.0625f; sv[d] = v;
      }
      float lf = -softplusf(-(small[(size_t)row * 32 + 20 + h] + p.in[zz + I_FB][h]));
      float li = small[(size_t)row * 32 + 16 + h] + p.in[zz + I_IB][h];
      float m = p.in[zz + I_SMM][bs * 4 + h];
      float mnew = fmaxf(lf + m, li);
      float wsc = __expf(li - mnew), dc = __expf(lf + m - mnew);
      __syncthreads();
      float nn = dc * p.in[zz + I_SMN][(size_t)(bs * 4 + h) * 256 + tid] + wsc * sk[tid];
      p.out[O_MNS + (size_t)(bs * 4 + h) * 256 + tid] = nn;
      float den = bsum(sq[tid] * nn, scr);
      const float* C = p.in[zz + I_SMC] + (size_t)(bs * 4 + h) * 65536 + tid;
      float* Co = p.out + O_MCS + (size_t)(bs * 4 + h) * 65536 + tid;
      float vv = sv[tid] * wsc, num = 0.f;
      for (int d0 = 0; d0 < 256; d0 += 8) {
        float c[8];
#pragma unroll
        for (int e = 0; e < 8; ++e) c[e] = C[(size_t)(d0 + e) * 256];
#pragma unroll
        for (int e = 0; e < 8; ++e) {
          float cn = dc * c[e] + sk[d0 + e] * vv;
          num += sq[d0 + e] * cn;
          Co[(size_t)(d0 + e) * 256] = cn;
        }
      }
      float hv = num / fmaxf(fabsf(den), __expf(-mnew));
      float ss = bsum(hv * hv, scr);
      float rinv = rsqrtf(ss * (1.f / 256.f) + EPS);
      int ch = h * 256 + tid;
      float xa = bf2f(xm[(size_t)row * 1024 + ch]);
      float op = bf2f(proj[(size_t)row * PJ + 3584 + ch]);
      float hm = (hv * rinv * p.in[zz + I_MLN][ch] + p.in[zz + I_MLS][ch] * xa) * sigmoidf(op);
      mix[(size_t)row * 2048 + 1024 + ch] = f2bf(hm);
      if (tid == 0) p.out[O_MMS + bs * 4 + h] = mnew;
      __syncthreads();
    } else if (w < 768) {
      const int x = w - 512, bs = x >> 1, g = x & 1, row = TP + bs;
      float* yz = ex; float* scr = ex + 512;
      const int pp = tid >> 2, nq = tid & 3, n0 = nq * 32;
      _Pragma("unroll 1")
      for (int h8 = 0; h8 < 8; ++h8) {
        int h = g * 8 + h8;
        float dtv = softplusf(small[(size_t)row * 32 + h] + p.in[zz + I_DTB][h]);
        float dec = __expf(-dtv * __expf(p.in[zz + I_ALOG][h]));
        float xv = bf2f(xs[(size_t)row * 1024 + h * 64 + pp]);
        const float* st = p.in[zz + I_SSSM] + ((size_t)((bs * 16 + h) * 64 + pp)) * 128 + n0;
        float* so = p.out + O_SSMS + ((size_t)((bs * 16 + h) * 64 + pp)) * 128 + n0;
        float ys = 0.f, dx = dtv * xv;
#pragma unroll
        for (int j = 0; j < 8; ++j) {
          float4 s4 = *(const float4*)(st + j * 4);
          uint2 b2 = *(const uint2*)(Bm + (size_t)row * 256 + g * 128 + n0 + j * 4);
          uint2 c2 = *(const uint2*)(Cm + (size_t)row * 256 + g * 128 + n0 + j * 4);
          float4 o;
          o.x = dec * s4.x + dx * lo2f(b2.x); o.y = dec * s4.y + dx * hi2f(b2.x);
          o.z = dec * s4.z + dx * lo2f(b2.y); o.w = dec * s4.w + dx * hi2f(b2.y);
          ys += o.x * lo2f(c2.x) + o.y * hi2f(c2.x) + o.z * lo2f(c2.y) + o.w * hi2f(c2.y);
          *(float4*)(so + j * 4) = o;
        }
        ys += __shfl_xor(ys, 1);
        ys += __shfl_xor(ys, 2);
        if (nq == 0) {
          float z = bf2f(proj[(size_t)row * PJ + h * 64 + pp]);
          yz[h8 * 64 + pp] = (ys + p.in[zz + I_SSDD][h] * xv) * z * sigmoidf(z);
        }
      }
      __syncthreads();
      float a0 = yz[tid], a1 = yz[tid + 256];
      float ss = bsum(a0 * a0 + a1 * a1, scr);
      float rinv = rsqrtf(ss * (1.f / 512.f) + EPS);
      mix[(size_t)row * 2048 + g * 512 + tid] = f2bf(a0 * rinv * p.in[zz + I_SSDN][g * 512 + tid]);
      mix[(size_t)row * 2048 + g * 512 + tid + 256] = f2bf(a1 * rinv * p.in[zz + I_SSDN][g * 512 + tid + 256]);
      __syncthreads();
    } else if (w < 1024) {
      const int x = w - 768, g = x & 1, c = (x >> 1) & 15, b = x >> 5;
      const int rowbase = b * 2048 + c * 128;
      const float* dt = (const float*)(p.ws + M_DT);
      const float* ac = (const float*)(p.ws + M_ACUM);
      float* sWe = ex;
      for (int i = tid; i < 1024; i += 256) {
        int h8 = i >> 7, s = i & 127, h = g * 8 + h8;
        float al = ac[(size_t)(rowbase + 127) * 16 + h];
        sWe[i] = __expf(al - ac[(size_t)(rowbase + s) * 16 + h]) * dt[(size_t)(rowbase + s) * 16 + h];
      }
      _Pragma("unroll 1")
      for (int i = tid; i < 128 * 16; i += 256) {
        int jc = i & 15, s = i >> 4;
        uint4 q = *(const uint4*)(Bm + (size_t)(rowbase + s) * 256 + g * 128 + jc * 8);
        float v[8]; unpack8(q, v);
        img_put_t(R0, 128, jc * 8, s, v);
      }
      __syncthreads();
      _Pragma("unroll 1")
      for (int h8 = 0; h8 < 8; ++h8) {
        int h = g * 8 + h8;
        _Pragma("unroll 1")
        for (int i = tid; i < 128 * 8; i += 256) {
          int jc = i & 7, s = i >> 3;
          uint4 q = *(const uint4*)(xs + (size_t)(rowbase + s) * 1024 + h * 64 + jc * 8);
          float v[8]; unpack8(q, v);
          float sc = sWe[h8 * 128 + s];
#pragma unroll
          for (int e = 0; e < 8; ++e) v[e] *= sc;
          img_put_t(R1, 64, jc * 8, s, v);
        }
        __syncthreads();
        f32x16 acc[1][2];
        zero_acc<1, 2>(acc);
#pragma unroll
        for (int pn = 0; pn < 2; ++pn) mma_panel<1, 2>(acc, R1 + pn * 8192, (wid & 1) * 32, R0 + pn * 16384, (wid >> 1) * 64, lane);
        u16* dst = (u16*)(p.ws + B_SSDST) + ((size_t)((b * 16 + c) * 16 + h)) * 8192;
#pragma unroll
        for (int ni = 0; ni < 2; ++ni)
#pragma unroll
          for (int i = 0; i < 16; ++i) {
            int pr = (wid & 1) * 32 + ACC_ROW(i, lane), n = (wid >> 1) * 64 + ni * 32 + (lane & 31);
            dst[pr * 128 + n] = f2bf(acc[0][ni][i]);
          }
        __syncthreads();
      }
    } else {
      const int x = w - 1024, vh = x & 1, c = (x >> 1) & 15, h = (x >> 5) & 3, b = x >> 7;
      const int rowbase = b * 2048 + c * 128;
      const float* gs = (const float*)(p.ws + M_GSUM) + (size_t)(b * 4 + h) * 32;
      float mc, mn, bend;
      mchain(gs, c, mc, mn, bend);
      float* sWs = ex;
      const float* bcum = (const float*)(p.ws + M_BCUM);
      const float* li = (const float*)(p.ws + M_LI);
      if (tid < 128) sWs[tid] = __expf(bend - bcum[(size_t)(rowbase + tid) * 4 + h] + li[(size_t)(rowbase + tid) * 4 + h] - mn);
      _Pragma("unroll 1")
      for (int i = tid; i < 128 * 16; i += 256) {
        int jc = i & 15, s = i >> 4;
        int ch0 = h * 256 + vh * 128 + jc * 8;
        uint4 q = *(const uint4*)(proj + (size_t)(rowbase + s) * PJ + 2560 + ch0);
        float xv[8], v[8]; unpack8(q, xv);
        blockdiag8(xv, p.in[zz + I_WV], ch0, 1.f, v);
        img_put_t(R0, 128, jc * 8, s, v);
      }
      __syncthreads();
      _Pragma("unroll 1")
      for (int dh = 0; dh < 2; ++dh) {
        _Pragma("unroll 1")
        for (int i = tid; i < 128 * 16; i += 256) {
          int jc = i & 15, s = i >> 4;
          int ch0 = h * 256 + dh * 128 + jc * 8;
          uint4 q = *(const uint4*)(xm + (size_t)(rowbase + s) * 1024 + ch0);
          float xv[8], v[8]; unpack8(q, xv);
          blockdiag8(xv, p.in[zz + I_WK], ch0, 0.0625f * sWs[s], v);
          img_put_t(R1, 128, jc * 8, s, v);
        }
        __syncthreads();
        f32x16 acc[2][2];
        zero_acc<2, 2>(acc);
#pragma unroll
        for (int pn = 0; pn < 2; ++pn) mma_panel<2, 2>(acc, R0 + pn * 16384, (wid & 1) * 64, R1 + pn * 16384, (wid >> 1) * 64, lane);
        if (vh == 0) {
          int d = tid >> 1, hf = tid & 1;
          float s = 0.f;
          for (int k = 0; k < 64; ++k) s += bf2f(*(const u16*)(R1 + hf * 16384 + img_off(d, k)));
          s += __shfl_xor(s, 1);
          if (hf == 0) ((float*)(p.ws + M_MLN))[(size_t)((b * 4 + h) * 16 + c) * 256 + dh * 128 + d] = s;
        }
        u16* dst = (u16*)(p.ws + B_MLST) + ((size_t)((b * 4 + h) * 16 + c)) * 65536;
#pragma unroll
        for (int mi = 0; mi < 2; ++mi)
#pragma unroll
          for (int ni = 0; ni < 2; ++ni)
#pragma unroll
            for (int i = 0; i < 16; ++i) {
              int v = vh * 128 + (wid & 1) * 64 + mi * 32 + ACC_ROW(i, lane), d = dh * 128 + (wid >> 1) * 64 + ni * 32 + (lane & 31);
              dst[v * 256 + d] = f2bf(acc[mi][ni][i]);
            }
        __syncthreads();
      }
    }
  }
}

__device__ __forceinline__ void phase_scan(const P& p, char* lds, int bid, int G) {
  for (int w = bid; w < 1568; w += G) {
    FRESH_TID(tid);
    const int zz = zof(w);
    if (w < 512) {
      int e8 = w * 256 + tid;
      int n8 = e8 & 15, pp = (e8 >> 4) & 63, h = (e8 >> 10) & 15, b = e8 >> 14;
      const float* ac = (const float*)(p.ws + M_ACUM);
      u16* st = (u16*)(p.ws + B_SSDST);
      float cur[8];
#pragma unroll
      for (int e = 0; e < 8; ++e) cur[e] = 0.f;
      for (int c = 0; c < 16; ++c) {
        u16* ptr = st + ((size_t)((b * 16 + c) * 16 + h)) * 8192 + pp * 128 + n8 * 8;
        uint4 q = *(const uint4*)ptr;
        float t[8]; unpack8(q, t);
        *(uint4*)ptr = pack8(cur);
        float dec = __expf(ac[(size_t)(b * 2048 + c * 128 + 127) * 16 + h]);
#pragma unroll
        for (int e = 0; e < 8; ++e) cur[e] = dec * cur[e] + t[e];
      }
      float* o = p.out + O_SSMP + ((size_t)((b * 16 + h) * 64 + pp)) * 128 + n8 * 8;
      *(float4*)o = make_float4(cur[0], cur[1], cur[2], cur[3]);
      *(float4*)(o + 4) = make_float4(cur[4], cur[5], cur[6], cur[7]);
    } else if (w < 1536) {
      int e8 = (w - 512) * 256 + tid;
      int d8 = e8 & 31, v = (e8 >> 5) & 255, h = (e8 >> 13) & 3, b = e8 >> 15;
      const float* gs = (const float*)(p.ws + M_GSUM) + (size_t)(b * 4 + h) * 32;
      u16* st = (u16*)(p.ws + B_MLST);
      float cur[8];
#pragma unroll
      for (int e = 0; e < 8; ++e) cur[e] = 0.f;
      float m = 0.f;
      for (int c = 0; c < 16; ++c) {
        u16* ptr = st + ((size_t)((b * 4 + h) * 16 + c)) * 65536 + v * 256 + d8 * 8;
        uint4 q = *(const uint4*)ptr;
        float t[8]; unpack8(q, t);
        *(uint4*)ptr = pack8(cur);
        float be = gs[c * 2], mn = be + fmaxf(m, gs[c * 2 + 1]);
        float dc = __expf(be + m - mn);
        m = mn;
#pragma unroll
        for (int e = 0; e < 8; ++e) cur[e] = dc * cur[e] + t[e];
      }
      float* o = p.out + O_MCP + (size_t)(b * 4 + h) * 65536 + v;
#pragma unroll
      for (int e = 0; e < 8; ++e) o[(size_t)(d8 * 8 + e) * 256] = cur[e];
    } else {
      int bh = w - 1536, d = tid;
      const float* gs = (const float*)(p.ws + M_GSUM) + (size_t)bh * 32;
      float* nb = (float*)(p.ws + M_MLN) + (size_t)bh * 16 * 256;
      float cur = 0.f, m = 0.f;
      for (int c = 0; c < 16; ++c) {
        float t = nb[c * 256 + d];
        nb[c * 256 + d] = cur;
        float be = gs[c * 2], mn = be + fmaxf(m, gs[c * 2 + 1]);
        float dc = __expf(be + m - mn);
        m = mn;
        cur = dc * cur + t;
      }
      p.out[O_MNP + (size_t)bh * 256 + d] = cur;
      if (tid == 0) p.out[O_MMP + bh] = m;
    }
  }
}

__device__ __forceinline__ void phase_chunkout(const P& p, char* lds, int bid, int G) {
  const u16* proj = (const u16*)(p.ws + B_PROJ);
  const u16* xs = (const u16*)(p.ws + B_A);
  const u16* Bm = (const u16*)(p.ws + B_BM);
  const u16* Cm = (const u16*)(p.ws + B_CM);
  const u16* xm = (const u16*)(p.ws + B_XM);
  u16* mix = (u16*)(p.ws + B_MIX);
  char* R0 = lds;
  char* R1 = lds + 32768;
  float* ex = (float*)(lds + 65536);
  for (int w = bid; w < 1024; w += G) {
    FRESH_TID(tid);
    const int zz = zof(w);
    const int lane = tid & 63, wid = tid >> 6;
#if defined(P5_ONLY) && P5_ONLY == 2
    if (false) {
#elif defined(P5_ONLY) && P5_ONLY == 1
    if (true) {
#else
    if (w >= 512) {
#endif
      const int x = w - 512, th = x & 1, g = (x >> 1) & 1, c = (x >> 2) & 15, b = x >> 6;
      const int rowbase = b * 2048 + c * 128;
      const float* dt = (const float*)(p.ws + M_DT);
      const float* ac = (const float*)(p.ws + M_ACUM);
      float* sA = ex;
      float* sD = ex + 1024;
      float* sSq = ex + 2048;
      for (int i = tid; i < 1024; i += 256) {
        int h8 = i >> 7, s = i & 127, h = g * 8 + h8;
        sA[i] = ac[(size_t)(rowbase + s) * 16 + h];
        sD[i] = dt[(size_t)(rowbase + s) * 16 + h];
      }
      if (tid < 64) sSq[tid] = 0.f;
      _Pragma("unroll 1")
      for (int i = tid; i < 128 * 16; i += 256) {
        int kc = i & 15, r = i >> 4;
        uint4 q = *(const uint4*)(Bm + (size_t)(rowbase + r) * 256 + g * 128 + kc * 8);
        *(uint4*)(R0 + (kc >> 3) * 16384 + r * 128 + (((kc & 7) ^ ((r >> 1) & 7)) << 4)) = q;
      }
      _Pragma("unroll 1")
      for (int i = tid; i < 64 * 16; i += 256) {
        int kc = i & 15, r = i >> 4;
        uint4 q = *(const uint4*)(Cm + (size_t)(rowbase + th * 64 + r) * 256 + g * 128 + kc * 8);
        *(uint4*)(R1 + (kc >> 3) * 8192 + r * 128 + (((kc & 7) ^ ((r >> 1) & 7)) << 4)) = q;
      }
      __syncthreads();
      f32x16 cb[2][1];
      zero_acc<2, 1>(cb);
#pragma unroll
      for (int pn = 0; pn < 2; ++pn) mma_panel<2, 1>(cb, R1 + pn * 8192, 0, R0 + pn * 16384, wid * 32, lane);
      __syncthreads();
      _Pragma("unroll 1")
      for (int h8 = 0; h8 < 8; ++h8) {
        const int h = g * 8 + h8;
        {
          int s = wid * 32 + (lane & 31);
          float as = sA[h8 * 128 + s], ds = sD[h8 * 128 + s];
#pragma unroll
          for (int mi = 0; mi < 2; ++mi)
#pragma unroll
            for (int i = 0; i < 16; ++i) {
              int tl = mi * 32 + ACC_ROW(i, lane), t = th * 64 + tl;
              float v = (s <= t) ? __expf(sA[h8 * 128 + t] - as) * cb[mi][0][i] * ds : 0.f;
              *(u16*)(R0 + (s >> 6) * 8192 + img_off(tl, s & 63)) = f2bf(v);
              if ((i & 3) == 3) SB();
            }
        }
        _Pragma("unroll 1")
        for (int i = tid; i < 128 * 8; i += 256) {
          int jc = i & 7, s = i >> 3;
          uint4 q = *(const uint4*)(xs + (size_t)(rowbase + s) * 1024 + h * 64 + jc * 8);
          float v[8]; unpack8(q, v);
          img_put_t(R0 + 16384, 64, jc * 8, s, v);
        }
        {
          const u16* st = (const u16*)(p.ws + B_SSDST) + ((size_t)((b * 16 + c) * 16 + h)) * 8192;
          _Pragma("unroll 1")
          for (int i = tid; i < 64 * 16; i += 256) {
            int kc = i & 15, r = i >> 4;
            uint4 q = *(const uint4*)(st + r * 128 + kc * 8);
            *(uint4*)(R1 + 16384 + (kc >> 3) * 8192 + r * 128 + (((kc & 7) ^ ((r >> 1) & 7)) << 4)) = q;
          }
        }
        __syncthreads();
        f32x16 a1[1][1], a2[1][1];
        zero_acc<1, 1>(a1);
        zero_acc<1, 1>(a2);
#pragma unroll
        for (int pn = 0; pn < 2; ++pn) {
          mma_panel<1, 1>(a1, R0 + pn * 8192, (wid & 1) * 32, R0 + 16384 + pn * 8192, (wid >> 1) * 32, lane);
          mma_panel<1, 1>(a2, R1 + pn * 8192, (wid & 1) * 32, R1 + 16384 + pn * 8192, (wid >> 1) * 32, lane);
        }
        {
          int pp = (wid >> 1) * 32 + (lane & 31), ch = h * 64 + pp;
          float Dh = p.in[zz + I_SSDD][h];
#pragma unroll
          for (int i = 0; i < 16; ++i) {
            int tl = (wid & 1) * 32 + ACC_ROW(i, lane), t = th * 64 + tl;
            size_t row = rowbase + t;
            float y = a1[0][0][i] + __expf(sA[h8 * 128 + t]) * a2[0][0][i];
            float xv = bf2f(xs[row * 1024 + ch]);
            float z = bf2f(proj[row * PJ + ch]);
            float v = (y + Dh * xv) * z * sigmoidf(z);
            mix[row * 2048 + ch] = f2bf(v);
            if ((i & 3) == 3) SB();
          }
        }
        __syncthreads();
      }
      asm volatile("s_waitcnt vmcnt(0)" ::: "memory");
      __threadfence_block();
      __syncthreads();
      _Pragma("unroll 1")
      for (int tl = wid * 16; tl < wid * 16 + 16; ++tl) {
        size_t row = rowbase + th * 64 + tl;
        u16* ptr = mix + row * 2048 + g * 512 + lane * 8;
        float v[8]; unpack8(*(const uint4*)ptr, v);
        float sq = 0.f;
#pragma unroll
        for (int e = 0; e < 8; ++e) sq += v[e] * v[e];
        sq = wsum(sq);
        float rinv = rsqrtf(sq * (1.f / 512.f) + EPS);
        const float* gn = p.in[zz + I_SSDN] + g * 512 + lane * 8;
#pragma unroll
        for (int e = 0; e < 8; ++e) v[e] *= rinv * gn[e];
        *(uint4*)ptr = pack8(v);
      }
      __syncthreads();
    } else {
      const int c = w & 15, h = (w >> 4) & 3, b = w >> 6;
      const int rowbase = b * 2048 + c * 128;
      const float* gs = (const float*)(p.ws + M_GSUM) + (size_t)(b * 4 + h) * 32;
      float mc, mn, bend;
      mchain(gs, c, mc, mn, bend);
      float* sBc = ex;
      float* sLb = ex + 128;
      float* sMt = ex + 256;
      float* sWi = ex + 384;
      float* sDen = ex + 512;
      float* sQn = ex + 640;
      float* sSq = ex + 768;
      float* sN = ex + 896;
      const float* bcum = (const float*)(p.ws + M_BCUM);
      const float* li = (const float*)(p.ws + M_LI);
      if (tid < 128) {
        float bc = bcum[(size_t)(rowbase + tid) * 4 + h];
        sBc[tid] = bc;
        sLb[tid] = li[(size_t)(rowbase + tid) * 4 + h] - bc;
        sDen[tid] = 0.f; sQn[tid] = 0.f; sSq[tid] = 0.f;
      }
      sN[tid] = ((const float*)(p.ws + M_MLN))[(size_t)((b * 4 + h) * 16 + c) * 256 + tid];
      __syncthreads();
      if (tid < 128) {
        float pm = -INFINITY;
        for (int s = 0; s <= tid; ++s) pm = fmaxf(pm, sLb[s]);
        float inter = sBc[tid] + mc;
        float mt = fmaxf(inter, sBc[tid] + pm);
        sMt[tid] = mt;
        sWi[tid] = __expf(inter - mt);
      }
      __syncthreads();
      if (tid < 128) sBc[tid] -= sMt[tid];
      __syncthreads();
      f32x16 sa[2][2];
      zero_acc<2, 2>(sa);
      _Pragma("unroll 1")
      for (int dp = 0; dp < 4; ++dp) {
        _Pragma("unroll 1")
        for (int i = tid; i < 128 * 8; i += 256) {
          int kc = i & 7, r = i >> 3;
          int ch0 = h * 256 + dp * 64 + kc * 8;
          uint4 q = *(const uint4*)(xm + (size_t)(rowbase + r) * 1024 + ch0);
          float xv[8], qv[8], kv[8]; unpack8(q, xv);
          int so = r * 128 + ((kc ^ ((r >> 1) & 7)) << 4);
          blockdiag8(xv, p.in[zz + I_WK], ch0, 0.0625f, kv);
          *(uint4*)(R1 + 16384 + so) = pack8(kv);
          SB();
          blockdiag8(xv, p.in[zz + I_WQ], ch0, 1.f, qv);
          *(uint4*)(R1 + so) = pack8(qv);
          float qn = 0.f;
#pragma unroll
          for (int e = 0; e < 8; ++e) qn += qv[e] * sN[dp * 64 + kc * 8 + e];
          qn += __shfl_xor(qn, 1); qn += __shfl_xor(qn, 2); qn += __shfl_xor(qn, 4);
          if (kc == 0) sQn[r] += qn;
          SB();
        }
        __syncthreads();
        mma_panel<2, 2>(sa, R1, (wid & 1) * 64, R1 + 16384, (wid >> 1) * 64, lane);
        __syncthreads();
      }
#pragma unroll
      for (int mi = 0; mi < 2; ++mi)
#pragma unroll
        for (int ni = 0; ni < 2; ++ni) {
          int s = (wid >> 1) * 64 + ni * 32 + (lane & 31);
          float lb = sLb[s];
#pragma unroll
          for (int i = 0; i < 16; ++i) {
            int t = (wid & 1) * 64 + mi * 32 + ACC_ROW(i, lane);
            float v = (s <= t) ? sa[mi][ni][i] * __expf(sBc[t] + lb) : 0.f;
            *(u16*)(R0 + (s >> 6) * 16384 + img_off(t, s & 63)) = f2bf(v);
            if ((i & 3) == 3) SB();
          }
        }
      __syncthreads();
      if (tid < 128) {
        float sm = 0.f;
        _Pragma("unroll 1")
        for (int kc = 0; kc < 16; ++kc) {
          float v[8];
          unpack8(*(const uint4*)(R0 + (kc >> 3) * 16384 + tid * 128 + (((kc & 7) ^ ((tid >> 1) & 7)) << 4)), v);
#pragma unroll
          for (int e = 0; e < 8; ++e) sm += v[e];
        }
        float den = sm + sWi[tid] * sQn[tid];
#ifdef DBG_DEN1
        sDen[tid] = 1.f + 0.f * den;
#else
        sDen[tid] = 1.f / fmaxf(fabsf(den), __expf(-sMt[tid]));
#endif
      }
      __syncthreads();
      _Pragma("unroll 1")
      for (int vh = 0; vh < 2; ++vh) {
        f32x16 oa[2][2];
        zero_acc<2, 2>(oa);
        _Pragma("unroll 1")
        for (int i = tid; i < 128 * 16; i += 256) {
          int jc = i & 15, s = i >> 4;
          int ch0 = h * 256 + vh * 128 + jc * 8;
          uint4 q = *(const uint4*)(proj + (size_t)(rowbase + s) * PJ + 2560 + ch0);
          float xv[8], v[8]; unpack8(q, xv);
          blockdiag8(xv, p.in[zz + I_WV], ch0, 1.f, v);
          img_put_t(R1, 128, jc * 8, s, v);
        }
        __syncthreads();
#pragma unroll
        for (int pn = 0; pn < 2; ++pn) mma_panel<2, 2>(oa, R0 + pn * 16384, (wid & 1) * 64, R1 + pn * 16384, (wid >> 1) * 64, lane);
        __syncthreads();
        const u16* st = (const u16*)(p.ws + B_MLST) + ((size_t)((b * 4 + h) * 16 + c)) * 65536;
        _Pragma("unroll 1")
        for (int dp = 0; dp < DBG_DPN; ++dp) {
          _Pragma("unroll 1")
          for (int i = tid; i < 128 * 8; i += 256) {
            int kc = i & 7, r = i >> 3;
            int ch0 = h * 256 + dp * 64 + kc * 8;
            uint4 q = *(const uint4*)(xm + (size_t)(rowbase + r) * 1024 + ch0);
            float xv[8], qv[8]; unpack8(q, xv);
            blockdiag8(xv, p.in[zz + I_WQ], ch0, sWi[r], qv);
            int so = r * 128 + ((kc ^ ((r >> 1) & 7)) << 4);
            *(uint4*)(R1 + so) = pack8(qv);
            uint4 cq = *(const uint4*)(st + (size_t)(vh * 128 + r) * 256 + dp * 64 + kc * 8);
            *(uint4*)(R1 + 16384 + so) = cq;
          }
          __syncthreads();
          mma_panel<2, 2>(oa, R1, (wid & 1) * 64, R1 + 16384, (wid >> 1) * 64, lane);
          __syncthreads();
        }
#pragma unroll
        for (int mi = 0; mi < 2; ++mi)
#pragma unroll
          for (int ni = 0; ni < 2; ++ni) {
            int v = vh * 128 + (wid >> 1) * 64 + ni * 32 + (lane & 31);
#pragma unroll
            for (int i = 0; i < 16; ++i) {
              int t = (wid & 1) * 64 + mi * 32 + ACC_ROW(i, lane);
              float hv = oa[mi][ni][i] * sDen[t];
              mix[(size_t)(rowbase + t) * 2048 + 1024 + h * 256 + v] = f2bf(hv);
              if ((i & 3) == 3) SB();
            }
          }
      }
      asm volatile("s_waitcnt vmcnt(0)" ::: "memory");
      __threadfence_block();
      __syncthreads();
      _Pragma("unroll 1")
      for (int it = 0; it < DBG_NORM_IT; ++it) {
        int t = wid * 32 + it * 2 + (lane >> 5), cc = lane & 31;
        size_t row = rowbase + t;
        int ch = h * 256 + cc * 8;
        u16* ptr = mix + row * 2048 + 1024 + ch;
        float v[8], xa[8], op[8];
        unpack8(*(const uint4*)ptr, v);
        float sq = 0.f;
#pragma unroll
        for (int e = 0; e < 8; ++e) sq += v[e] * v[e];
#pragma unroll
        for (int m = 16; m >= 1; m >>= 1) sq += __shfl_xor(sq, m);
        float rinv = rsqrtf(sq * (1.f / 256.f) + EPS);
        unpack8(*(const uint4*)(xm + row * 1024 + ch), xa);
        unpack8(*(const uint4*)(proj + row * PJ + 3584 + ch), op);
#pragma unroll
        for (int e = 0; e < 8; ++e) v[e] = (v[e] * rinv * p.in[zz + I_MLN][ch + e] + p.in[zz + I_MLS][ch + e] * xa[e]) * sigmoidf(op[e]);
        *(uint4*)ptr = pack8(v);
      }
      __syncthreads();
    }
  }
}

__device__ __forceinline__ void phase_rms(const float* x, const float* g, u16* dst, int bid, int G) {
  for (int w = bid; w < TT / 4; w += G) {
    FRESH_TID(tid);
    const int zz = zof(w);
    const int lane = tid & 63, wid = tid >> 6;
    int row = w * 4 + wid;
    rms_rows_bf16(x + (size_t)row * 1024, g, dst + (size_t)row * 1024, lane);
  }
}
__device__ __forceinline__ void phase_rms_final(const P& p, const float* x, int bid, int G) {
  const float* g = p.in[zof(bid) + I_NFIN];
  for (int w = bid; w < TT / 4; w += G) {
    FRESH_TID(tid);
    const int zz = zof(w);
    const int lane = tid & 63, wid = tid >> 6;
    int row = w * 4 + wid;
    const float* src = x + (size_t)row * 1024;
    float4 v[4];
    float ss = 0.f;
#pragma unroll
    for (int i = 0; i < 4; ++i) {
      v[i] = ((const float4*)src)[lane + 64 * i];
      ss += v[i].x * v[i].x + v[i].y * v[i].y + v[i].z * v[i].z + v[i].w * v[i].w;
    }
    ss = wsum(ss);
    float rinv = rsqrtf(ss * (1.f / 1024.f) + EPS);
    float* o = p.out + O_Y + (size_t)row * 1024;
#pragma unroll
    for (int i = 0; i < 4; ++i) {
      float4 g4 = ((const float4*)g)[lane + 64 * i];
      ((float4*)o)[lane + 64 * i] = make_float4(v[i].x * rinv * g4.x, v[i].y * rinv * g4.y, v[i].z * rinv * g4.z, v[i].w * rinv * g4.w);
    }
  }
}
__device__ __forceinline__ void phase_rms_shift(const P& p, const float* x, int bid, int G) {
  const int zz0 = zof(bid);
  const float* g = p.in[zz0 + I_NMIX] + 1024;
  const float* mu = p.in[zz0 + I_MU];
  for (int w = bid; w < TT / 4; w += G) {
    FRESH_TID(tid);
    const int zz = zof(w);
    const int lane = tid & 63, wid = tid >> 6;
    int row = w * 4 + wid;
    const float* src = x + (size_t)row * 1024;
    float4 v[4], pv[4];
    float ss = 0.f, ps = 0.f;
    int mode;
    const float* psrc = src;
    if (row < TP) { mode = ((row & 2047) == 0) ? 1 : 0; psrc = src - 1024; }
    else { mode = 2; psrc = p.in[zz + I_SSHIFT] + (size_t)(row - TP) * 1024; }
#pragma unroll
    for (int i = 0; i < 4; ++i) {
      v[i] = ((const float4*)src)[lane + 64 * i];
      ss += v[i].x * v[i].x + v[i].y * v[i].y + v[i].z * v[i].z + v[i].w * v[i].w;
      if (mode != 1) pv[i] = ((const float4*)psrc)[lane + 64 * i];
      else pv[i] = make_float4(0.f, 0.f, 0.f, 0.f);
      ps += pv[i].x * pv[i].x + pv[i].y * pv[i].y + pv[i].z * pv[i].z + pv[i].w * pv[i].w;
    }
    ss = wsum(ss); ps = wsum(ps);
    float rinv = rsqrtf(ss * (1.f / 1024.f) + EPS);
    float pinv = rsqrtf(ps * (1.f / 1024.f) + EPS);
#pragma unroll
    for (int i = 0; i < 4; ++i) {
      float4 g4 = ((const float4*)g)[lane + 64 * i];
      float xn[4] = {v[i].x * rinv * g4.x, v[i].y * rinv * g4.y, v[i].z * rinv * g4.z, v[i].w * rinv * g4.w};
      float xp[4];
      if (mode == 0) { xp[0] = pv[i].x * pinv * g4.x; xp[1] = pv[i].y * pinv * g4.y; xp[2] = pv[i].z * pinv * g4.z; xp[3] = pv[i].w * pinv * g4.w; }
      else { xp[0] = pv[i].x; xp[1] = pv[i].y; xp[2] = pv[i].z; xp[3] = pv[i].w; }
      int col = (lane + 64 * i) * 4;
      if (row >= TP) *(float4*)(p.out + O_SHS + (size_t)(row - TP) * 1024 + col) = make_float4(xn[0], xn[1], xn[2], xn[3]);
      else if ((row & 2047) == 2047) *(float4*)(p.out + O_SHP + (size_t)(row >> 11) * 1024 + col) = make_float4(xn[0], xn[1], xn[2], xn[3]);
#pragma unroll
      for (int c = 0; c < 6; ++c) {
        float4 m4 = *(const float4*)(mu + c * 1024 + col);
        uint2 o;
        o.x = pk2(xn[0] + (xp[0] - xn[0]) * m4.x, xn[1] + (xp[1] - xn[1]) * m4.y);
        o.y = pk2(xn[2] + (xp[2] - xn[2]) * m4.z, xn[3] + (xp[3] - xn[3]) * m4.w);
        size_t base = (c < 5) ? (3 * U + (size_t)c * U) : B_A;
        *(uint2*)((u16*)(p.ws + base) + (size_t)row * 1024 + col) = o;
      }
    }
  }
}

__device__ __forceinline__ void phase_wkv(const P& p, char* lds, int bid, int G) {
  const u16* rb = (const u16*)(p.ws + B_RB);
  const u16* kb = (const u16*)(p.ws + B_KB);
  const u16* vb = (const u16*)(p.ws + B_VB);
  const u16* ab = (const u16*)(p.ws + B_AB);
  const float* dec = (const float*)(p.ws + B_DEC);
  float* yraw = (float*)(p.ws + B_YRAW);
  float* buf = (float*)lds;
  for (int w = bid; w < 768; w += G) {
#ifdef DBG_SKIP_PROMPT
    if (w < 256) continue;
#endif
    FRESH_TID(tid);
    const int zz = zof(w);
    const int lane = tid & 63, wid = tid >> 6;
    if (w < 256) {
      const int half = w & 1, h = (w >> 1) & 15, b = w >> 5;
      const int j = lane & 7, vrow = half * 32 + wid * 8 + (lane >> 3);
      const int tl = tid >> 4, sub = tid & 15, ch = h * 64 + sub * 4;
      float S[8];
#pragma unroll
      for (int i = 0; i < 8; ++i) S[i] = 0.f;
      float kkw[4], kaw[4];
#pragma unroll
      for (int e = 0; e < 4; ++e) { kkw[e] = p.in[zz + I_KK][ch + e]; kaw[e] = p.in[zz + I_KA][ch + e]; }
      uint2 lr, lk, lv, la; float4 lw;
      auto gload = [&](int tc) {
        size_t o = (size_t)(b * 2048 + tc * 16 + tl) * 1024 + ch;
#ifdef DBG_SYNTH
        { const float* xp = p.in[zz + I_XP] + o; float4 t4 = *(const float4*)xp;
          lr.x = pk2(t4.x, t4.y); lr.y = pk2(t4.z, t4.w); lk = lr; lv = lr; la.x = pk2(0.5f, 0.4f); la.y = pk2(0.6f, 0.5f);
          lw = make_float4(0.9f, 0.95f, 0.99f, 0.8f); }
#else
        lr = *(const uint2*)(rb + o); lk = *(const uint2*)(kb + o); lv = *(const uint2*)(vb + o); la = *(const uint2*)(ab + o);
        lw = *(const float4*)(dec + o);
#endif
      };
      auto lstore = [&](int bi) {
        float* tb = buf + bi * 6144 + tl * 384 + sub * 4;
        float k[4] = {lo2f(lk.x), hi2f(lk.x), lo2f(lk.y), hi2f(lk.y)};
        float a[4] = {lo2f(la.x), hi2f(la.x), lo2f(la.y), hi2f(la.y)};
        float kk[4], n2 = 0.f;
#pragma unroll
        for (int e = 0; e < 4; ++e) { kk[e] = k[e] * kkw[e]; n2 += kk[e] * kk[e]; }
        n2 += __shfl_xor(n2, 1); n2 += __shfl_xor(n2, 2); n2 += __shfl_xor(n2, 4); n2 += __shfl_xor(n2, 8);
        float inv = 1.f / fmaxf(sqrtf(n2), 1e-12f);
        float kp[4], bb[4];
#pragma unroll
        for (int e = 0; e < 4; ++e) { kk[e] *= inv; kp[e] = k[e] * (1.f + (a[e] - 1.f) * kaw[e]); bb[e] = kk[e] * a[e]; }
        *(float4*)(tb) = lw;
        *(float4*)(tb + 64) = make_float4(kk[0], kk[1], kk[2], kk[3]);
        *(float4*)(tb + 128) = make_float4(bb[0], bb[1], bb[2], bb[3]);
        *(float4*)(tb + 192) = make_float4(kp[0], kp[1], kp[2], kp[3]);
        *(float4*)(tb + 256) = make_float4(lo2f(lr.x), hi2f(lr.x), lo2f(lr.y), hi2f(lr.y));
        *(float4*)(tb + 320) = make_float4(lo2f(lv.x), hi2f(lv.x), lo2f(lv.y), hi2f(lv.y));
      };
      gload(0);
      lstore(0);
      __syncthreads();
      for (int tc = 0; tc < 128; ++tc) {
        const int cur = tc & 1;
        if (tc + 1 < 128) gload(tc + 1);
        const float* cb = buf + cur * 6144;
        float* yo = yraw + (size_t)(b * 2048 + tc * 16) * 1024 + h * 64 + vrow;
#pragma unroll 4
        for (int t = 0; t < 16; ++t) {
          const float* tb = cb + t * 384 + j * 8;
          float4 w0 = *(const float4*)(tb), w1 = *(const float4*)(tb + 4);
          float4 k0 = *(const float4*)(tb + 64), k1 = *(const float4*)(tb + 68);
          float4 b0 = *(const float4*)(tb + 128), b1 = *(const float4*)(tb + 132);
          float4 p0 = *(const float4*)(tb + 192), p1 = *(const float4*)(tb + 196);
          float4 r0 = *(const float4*)(tb + 256), r1 = *(const float4*)(tb + 260);
          float vv = cb[t * 384 + 320 + vrow];
          float sa = S[0] * k0.x + S[1] * k0.y + S[2] * k0.z + S[3] * k0.w + S[4] * k1.x + S[5] * k1.y + S[6] * k1.z + S[7] * k1.w;
          sa += DPPF(sa, 0xB1);
          sa += DPPF(sa, 0x4E);
          sa += DPPF(sa, 0x141);
          sa = -sa;
          S[0] = S[0] * w0.x + (sa * b0.x + vv * p0.x);
          S[1] = S[1] * w0.y + (sa * b0.y + vv * p0.y);
          S[2] = S[2] * w0.z + (sa * b0.z + vv * p0.z);
          S[3] = S[3] * w0.w + (sa * b0.w + vv * p0.w);
          S[4] = S[4] * w1.x + (sa * b1.x + vv * p1.x);
          S[5] = S[5] * w1.y + (sa * b1.y + vv * p1.y);
          S[6] = S[6] * w1.z + (sa * b1.z + vv * p1.z);
          S[7] = S[7] * w1.w + (sa * b1.w + vv * p1.w);
          float y = S[0] * r0.x + S[1] * r0.y + S[2] * r0.z + S[3] * r0.w + S[4] * r1.x + S[5] * r1.y + S[6] * r1.z + S[7] * r1.w;
          y += DPPF(y, 0xB1);
          y += DPPF(y, 0x4E);
          y += DPPF(y, 0x141);
          if (j == 0) yo[(size_t)t * 1024] = y;
        }
        if (tc + 1 < 128) lstore(cur ^ 1);
        __syncthreads();
      }
      float* so = p.out + O_WKVP + ((size_t)((b * 16 + h) * 64 + vrow)) * 64 + j * 8;
      *(float4*)so = make_float4(S[0], S[1], S[2], S[3]);
      *(float4*)(so + 4) = make_float4(S[4], S[5], S[6], S[7]);
    } else {
      const int it = (w - 256) * 4 + wid;
      const int bs = it >> 4, h = it & 15, row = TP + bs;
      float* vb_ = buf + wid * 320;
      {
        size_t o = (size_t)row * 1024 + h * 64 + lane;
        float k = bf2f(kb[o]), a = bf2f(ab[o]);
        float kk = k * p.in[zz + I_KK][h * 64 + lane];
        float n2 = wsum(kk * kk);
        kk *= 1.f / fmaxf(sqrtf(n2), 1e-12f);
        vb_[lane] = dec[o];
        vb_[64 + lane] = kk;
        vb_[128 + lane] = kk * a;
        vb_[192 + lane] = k * (1.f + (a - 1.f) * p.in[zz + I_KA][h * 64 + lane]);
        vb_[256 + lane] = bf2f(rb[o]);
      }
      float vv = bf2f(vb[(size_t)row * 1024 + h * 64 + lane]);
      const float* st = p.in[zz + I_SWKV] + ((size_t)((bs * 16 + h) * 64 + lane)) * 64;
      float* so = p.out + O_WKVS + ((size_t)((bs * 16 + h) * 64 + lane)) * 64;
      float4 S4[16];
#pragma unroll
      for (int i = 0; i < 16; ++i) S4[i] = *(const float4*)(st + i * 4);
      float sa = 0.f;
#pragma unroll
      for (int i = 0; i < 16; ++i) {
        float4 k4 = *(const float4*)(vb_ + 64 + i * 4);
        sa += S4[i].x * k4.x + S4[i].y * k4.y + S4[i].z * k4.z + S4[i].w * k4.w;
      }
      sa = -sa;
      float y = 0.f;
#pragma unroll
      for (int i = 0; i < 16; ++i) {
        float4 w4 = *(const float4*)(vb_ + i * 4), b4 = *(const float4*)(vb_ + 128 + i * 4);
        float4 p4 = *(const float4*)(vb_ + 192 + i * 4), r4 = *(const float4*)(vb_ + 256 + i * 4);
        float4 s = S4[i];
        s.x = s.x * w4.x + (sa * b4.x + vv * p4.x);
        s.y = s.y * w4.y + (sa * b4.y + vv * p4.y);
        s.z = s.z * w4.z + (sa * b4.z + vv * p4.z);
        s.w = s.w * w4.w + (sa * b4.w + vv * p4.w);
        y += s.x * r4.x + s.y * r4.y + s.z * r4.z + s.w * r4.w;
        *(float4*)(so + i * 4) = s;
      }
      yraw[(size_t)row * 1024 + h * 64 + lane] = y;
      __syncthreads();
    }
  }
}

__device__ __forceinline__ void phase_wkv_ln(const P& p, int bid, int G) {
  const u16* rb = (const u16*)(p.ws + B_RB);
  const u16* kb = (const u16*)(p.ws + B_KB);
  const u16* vb = (const u16*)(p.ws + B_VB);
  const u16* ab = (const u16*)(p.ws + B_AB);
  const u16* gb = (const u16*)(p.ws + B_GB);
  const float* yraw = (const float*)(p.ws + B_YRAW);
  u16* yb = (u16*)(p.ws + B_YB);
  for (int w = bid; w < TT / 4; w += G) {
    FRESH_TID(tid);
    const int zz = zof(w);
    const int lane = tid & 63, wid = tid >> 6;
    int row = w * 4 + wid;
    size_t o = (size_t)row * 1024 + lane * 16;
    float y[16], r[16], k[16], v[16], a[16], g[16];
#pragma unroll
    for (int i = 0; i < 4; ++i) {
      float4 t = *(const float4*)(yraw + o + i * 4);
      y[i * 4] = t.x; y[i * 4 + 1] = t.y; y[i * 4 + 2] = t.z; y[i * 4 + 3] = t.w;
    }
    unpack8(*(const uint4*)(rb + o), r); unpack8(*(const uint4*)(rb + o + 8), r + 8);
    unpack8(*(const uint4*)(kb + o), k); unpack8(*(const uint4*)(kb + o + 8), k + 8);
    unpack8(*(const uint4*)(vb + o), v); unpack8(*(const uint4*)(vb + o + 8), v + 8);
    unpack8(*(const uint4*)(ab + o), a); unpack8(*(const uint4*)(ab + o + 8), a + 8);
    unpack8(*(const uint4*)(gb + o), g); unpack8(*(const uint4*)(gb + o + 8), g + 8);
    int c0 = lane * 16;
    float sm = 0.f, bon = 0.f;
#pragma unroll
    for (int e = 0; e < 16; ++e) {
      sm += y[e];
      float kp = k[e] * (1.f + (a[e] - 1.f) * p.in[zz + I_KA][c0 + e]);
      bon += r[e] * kp * p.in[zz + I_RK][c0 + e];
    }
    sm += __shfl_xor(sm, 1); sm += __shfl_xor(sm, 2);
    bon += __shfl_xor(bon, 1); bon += __shfl_xor(bon, 2);
    float mean = sm * (1.f / 64.f), vr = 0.f;
#pragma unroll
    for (int e = 0; e < 16; ++e) { float d = y[e] - mean; vr += d * d; }
    vr += __shfl_xor(vr, 1); vr += __shfl_xor(vr, 2);
    float rinv = rsqrtf(vr * (1.f / 64.f) + 64e-5f);
    float ov[16];
#pragma unroll
    for (int e = 0; e < 16; ++e)
      ov[e] = ((y[e] - mean) * rinv * p.in[zz + I_LNW][c0 + e] + p.in[zz + I_LNB][c0 + e] + bon * v[e]) * g[e];
    *(uint4*)(yb + o) = pack8(ov);
    *(uint4*)(yb + o + 8) = pack8(ov + 8);
  }
}

__device__ __forceinline__ void run_phase(const P& p, int ph, char* lds, int bid, int G) {
  char* ws = p.ws;
  const int zz = zof(ph);
  switch (ph) {
    case 0: if (PHEN(0)) phase_prep(p, lds, bid, G); break;
    case 1: { if (!PHEN(1)) break;
      EpiProj e{(u16*)(ws + B_PROJ), (float*)(ws + B_SMALL)};
      gemm_phase((const u16*)(ws + B_A), 1024, (const u16*)(ws + W_IN0), 1024, 1024, 129, 37, lds, bid, G, e);
    } break;
    case 2: if (PHEN(2)) phase_conv(p, lds, bid, G); break;
    case 3: if (PHEN(3)) phase_chunkstate(p, lds, bid, G); break;
    case 4: if (PHEN(4)) phase_scan(p, lds, bid, G); break;
    case 5: if (PHEN(5)) phase_chunkout(p, lds, bid, G); break;
    case 6: { if (!PHEN(6)) break;
      EpiRes e{p.in[zz + I_XP], p.in[zz + I_XS], (float*)(ws + B_X1)};
      gemm_phase((const u16*)(ws + B_MIX), 2048, (const u16*)(ws + W_OUT0), 2048, 2048, 129, 8, lds, bid, G, e);
    } break;
    case 7: if (PHEN(7)) phase_rms((const float*)(ws + B_X1), p.in[zz + I_NFFN], (u16*)(ws + B_A), bid, G); break;
    case 8: { if (!PHEN(8)) break;
      EpiSwiglu e{(u16*)(ws + B_HB)};
      gemm_phase((const u16*)(ws + B_A), 1024, (const u16*)(ws + W_GU), 1024, 1024, 129, 44, lds, bid, G, e);
    } break;
    case 9: { if (!PHEN(9)) break;
      const float* x1 = (const float*)(ws + B_X1);
      EpiRes e{x1, x1 + (size_t)TP * 1024, (float*)(ws + B_X2)};
      gemm_phase((const u16*)(ws + B_HB), 2816, (const u16*)(ws + W_DN), 2816, 2816, 129, 8, lds, bid, G, e);
    } break;
    case 10: if (PHEN(10)) phase_rms_shift(p, (const float*)(ws + B_X2), bid, G); break;
    case 11: { if (!PHEN(11)) break;
      const int nbig = 3 * 129 * 8;
      for (int t = bid; t < nbig + 129 * 4; t += G) {
        if (t < nbig) {
          int which = t / (129 * 8), r = t % (129 * 8);
          int mt = r % 129, nt = r / 129;
          size_t abase = which == 0 ? 3 * U : (which == 1 ? 5 * U : 6 * U);
          size_t wbase = which == 0 ? W_R : (which == 1 ? W_K : W_V);
          size_t obase = which == 0 ? B_RB : (which == 1 ? B_KB : B_VB);
          EpiAct e{(u16*)(ws + obase), 1024, 1024, 1024, 0};
          gemm_tile((const u16*)(ws + abase), 1024, (const u16*)(ws + wbase), 1024, 1024, mt * 128, nt * 128, lds, e);
        } else {
          int r = t - nbig;
          if (r < 129) {
            EpiAct e{(u16*)(ws + B_LW), 64, 64, 64, 1};
            gemm_tile((const u16*)(ws + 4 * U), 1024, (const u16*)(ws + W_W1), 1024, 1024, r * 128, 0, lds, e);
          } else if (r < 258) {
            EpiAct e{(u16*)(ws + B_LA), 64, 64, 64, 0};
            gemm_tile((const u16*)(ws + 7 * U), 1024, (const u16*)(ws + W_A1), 1024, 1024, (r - 129) * 128, 0, lds, e);
          } else {
            int q = r - 258;
            EpiAct e{(u16*)(ws + B_LG), 192, 160, 192, 2};
            gemm_tile((const u16*)(ws + B_A), 1024, (const u16*)(ws + W_G1), 1024, 1024, (q % 129) * 128, (q / 129) * 128, lds, e);
          }
        }
      }
    } break;
    case 12: { if (!PHEN(12)) break;
      for (int t = bid; t < 3 * 129 * 8; t += G) {
        int which = t / (129 * 8), r = t % (129 * 8);
        int mt = r % 129, nt = r / 129;
        if (which == 0) {
          EpiLora2 e{0, p.in[zz + I_W0], (float*)(ws + B_DEC), nullptr};
          gemm_tile((const u16*)(ws + B_LW), 64, (const u16*)(ws + W_W2), 64, 64, mt * 128, nt * 128, lds, e);
        } else if (which == 1) {
          EpiLora2 e{1, p.in[zz + I_A0], nullptr, (u16*)(ws + B_AB)};
          gemm_tile((const u16*)(ws + B_LA), 64, (const u16*)(ws + W_A2), 64, 64, mt * 128, nt * 128, lds, e);
        } else {
          EpiLora2 e{2, nullptr, nullptr, (u16*)(ws + B_GB)};
          gemm_tile((const u16*)(ws + B_LG), 192, (const u16*)(ws + W_G2), 192, 192, mt * 128, nt * 128, lds, e);
        }
      }
    } break;
    case 13: if (PHEN(13)) phase_wkv(p, lds, bid, G); break;
    case 14: if (PHEN(14)) phase_wkv_ln(p, bid, G); break;
    case 15: { if (!PHEN(15)) break;
      const float* x2 = (const float*)(ws + B_X2);
      EpiRes e{x2, x2 + (size_t)TP * 1024, (float*)(ws + B_X3)};
      gemm_phase((const u16*)(ws + B_YB), 1024, (const u16*)(ws + W_O), 1024, 1024, 129, 8, lds, bid, G, e);
    } break;
    case 16: if (PHEN(16)) phase_rms((const float*)(ws + B_X3), p.in[zz + I_NFFN] + 1024, (u16*)(ws + B_A), bid, G); break;
    case 17: { if (!PHEN(17)) break;
      EpiSwiglu e{(u16*)(ws + B_HB)};
      gemm_phase((const u16*)(ws + B_A), 1024, (const u16*)(ws + W_GU + 5632ull * 1024 * 2), 1024, 1024, 129, 44, lds, bid, G, e);
    } break;
    case 18: { if (!PHEN(18)) break;
      const float* x3 = (const float*)(ws + B_X3);
      EpiRes e{x3, x3 + (size_t)TP * 1024, (float*)(ws + B_X4)};
      gemm_phase((const u16*)(ws + B_HB), 2816, (const u16*)(ws + W_DN + 1024ull * 2816 * 2), 2816, 2816, 129, 8, lds, bid, G, e);
    } break;
    case 19: if (PHEN(19)) phase_rms_final(p, (const float*)(ws + B_X4), bid, G); break;
#ifdef DBG_MIX_OFF
    case 100: {
      for (size_t i = (size_t)bid * 256 + threadIdx.x; i < (size_t)TT * 1024; i += (size_t)G * 256) {
        size_t row = i >> 10; int c = (int)(i & 1023);
        p.out[O_Y + i] = bf2f(((const u16*)(p.ws + B_MIX))[row * 2048 + DBG_MIX_OFF + c]);
      }
    } break;
#endif
    default: break;
  }
}

#ifndef MK_LB
#define MK_LB 1
#endif
__global__ void __launch_bounds__(256, MK_LB) mk_forward(P p, int ph_lo, int ph_hi) {
  extern __shared__ __attribute__((aligned(16))) char lds[];
  cg::grid_group grid = cg::this_grid();
  const int bid = blockIdx.x, G = gridDim.x;
  for (int ph = ph_lo; ph < ph_hi; ++ph) {
    run_phase(p, ph, lds, bid, G);
    if (ph + 1 < ph_hi) grid.sync();
  }
#if defined(DBG_MIX_OFF) && !MK_MULTI
  grid.sync();
  run_phase(p, 100, lds, bid, G);
#endif

}

extern "C" void kernel_launch(void* const* d_in, const int* in_sizes, int n_in, void* d_out, int out_size, void* d_ws,
                              size_t ws_size, hipStream_t stream) {
  static int grid_blocks = 0;
  if (!grid_blocks) {
    hipFuncSetAttribute((const void*)mk_forward, hipFuncAttributeMaxDynamicSharedMemorySize, LDS_BYTES);
    int dev = 0, cus = 0, per_cu = 0;
    hipGetDevice(&dev);
    hipDeviceGetAttribute(&cus, hipDeviceAttributeMultiprocessorCount, dev);
    hipOccupancyMaxActiveBlocksPerMultiprocessor(&per_cu, mk_forward, 256, LDS_BYTES);
    if (per_cu > 2) per_cu = 2;
    if (per_cu < 1) per_cu = 1;
    grid_blocks = cus * per_cu;
  }
  P p{};
  for (int i = 0; i < N_IN; ++i) p.in[i] = (const float*)d_in[i];
  p.out = (float*)d_out;
  p.ws = (char*)d_ws;
  if (ws_size < WS_NEED) fprintf(stderr, "workspace too small: %zu < %zu\n", ws_size, (size_t)WS_NEED);
#if MK_MULTI
#ifndef MK_HI
#define MK_HI NPH
#endif
  for (int ph = 0; ph < MK_HI; ++ph) {
    int lo = ph, hi = ph + 1;
    hipLaunchKernelGGL(mk_forward, dim3(grid_blocks), dim3(256), LDS_BYTES, stream, p, lo, hi);
  }
#ifdef DBG_MIX_OFF
  hipLaunchKernelGGL(mk_forward, dim3(grid_blocks), dim3(256), LDS_BYTES, stream, p, 100, 101);
#endif
#else
#ifndef MK_HI
#define MK_HI NPH
#endif
  int lo = 0, hi = MK_HI;
  void* args[] = {&p, &lo, &hi};
  hipError_t e = hipLaunchCooperativeKernel((void*)mk_forward, dim3(grid_blocks), dim3(256), args, LDS_BYTES, stream);
  if (e != hipSuccess) fprintf(stderr, "cooperative launch failed: %s (grid %d)\n", hipGetErrorString(e), grid_blocks);
#endif
}
```

```cpp
#include <hip/hip_runtime.h>
#include <hip/hip_cooperative_groups.h>
#include <cstdio>
namespace cg = cooperative_groups;

#ifndef DBG_DPN
#define DBG_DPN 4
#endif
#ifndef DBG_NORM_IT
#define DBG_NORM_IT 16
#endif
#ifndef MK_MULTI
#define MK_MULTI 0
#endif
#ifdef ONLY_PH
#define PHEN(n) ((n) == ONLY_PH)
#else
#define PHEN(n) true
#endif

#define SB() __builtin_amdgcn_sched_barrier(0)
typedef unsigned short u16;
typedef __attribute__((ext_vector_type(8))) short bf16x8;
typedef __attribute__((ext_vector_type(16))) float f32x16;

constexpr int TP = 16384, TS = 128, TT = 16512, DM = 1024;
constexpr int PJ = 4608;
constexpr int NPH = 20;
constexpr float EPS = 1e-5f;

enum { I_XP = 0, I_XS, I_SCONV, I_SSSM, I_SMC, I_SMN, I_SMM, I_SSHIFT, I_SWKV, I_NMIX, I_NFFN, I_NFIN, I_WIN0,
       I_CONVW, I_CONVB, I_DTB, I_ALOG, I_SSDD, I_SSDN, I_WQ, I_WK, I_WV, I_IB, I_FB, I_MLN, I_MLS, I_WOUT0,
       I_MU, I_WR, I_WKK, I_WVV, I_WO, I_W0, I_W1, I_W2, I_A0, I_A1, I_A2, I_G1, I_G2, I_KK, I_KA, I_RK,
       I_LNW, I_LNB, I_GU, I_DN, N_IN };

constexpr size_t O_Y = 0;
constexpr size_t O_CONVP = O_Y + (size_t)TT * 1024;
constexpr size_t O_CONVS = O_CONVP + 8 * 3 * 2560;
constexpr size_t O_SSMP = O_CONVS + 128 * 3 * 2560;
constexpr size_t O_SSMS = O_SSMP + 8ull * 16 * 64 * 128;
constexpr size_t O_MCP = O_SSMS + 128ull * 16 * 64 * 128;
constexpr size_t O_MCS = O_MCP + 8ull * 4 * 256 * 256;
constexpr size_t O_MNP = O_MCS + 128ull * 4 * 256 * 256;
constexpr size_t O_MNS = O_MNP + 8 * 4 * 256;
constexpr size_t O_MMP = O_MNS + 128 * 4 * 256;
constexpr size_t O_MMS = O_MMP + 32;
constexpr size_t O_SHP = O_MMS + 512;
constexpr size_t O_SHS = O_SHP + 8 * 1024;
constexpr size_t O_WKVP = O_SHS + 128 * 1024;
constexpr size_t O_WKVS = O_WKVP + 8ull * 16 * 64 * 64;

constexpr size_t U = 33ull << 20;
constexpr size_t W_IN0 = 0;
constexpr size_t W_OUT0 = W_IN0 + 4736ull * 1024 * 2;
constexpr size_t W_GU = W_OUT0 + 1024ull * 2048 * 2;
constexpr size_t W_DN = W_GU + 2ull * 5632 * 1024 * 2;
constexpr size_t W_R = W_DN + 2ull * 1024 * 2816 * 2;
constexpr size_t W_K = W_R + 1024ull * 1024 * 2;
constexpr size_t W_V = W_K + 1024ull * 1024 * 2;
constexpr size_t W_O = W_V + 1024ull * 1024 * 2;
constexpr size_t W_W1 = W_O + 1024ull * 1024 * 2;
constexpr size_t W_A1 = W_W1 + 128ull * 1024 * 2;
constexpr size_t W_G1 = W_A1 + 128ull * 1024 * 2;
constexpr size_t W_W2 = W_G1 + 256ull * 1024 * 2;
constexpr size_t W_A2 = W_W2 + 1024ull * 128 * 2;
constexpr size_t W_G2 = W_A2 + 1024ull * 128 * 2;
constexpr size_t W_END = W_G2 + 1024ull * 256 * 2;
static_assert(W_END <= 2 * U, "weights");
constexpr size_t B_A = 2 * U;
constexpr size_t B_PROJ = 3 * U;
constexpr size_t B_SMALL = 8 * U;
constexpr size_t B_BM = B_SMALL + (size_t)TT * 32 * 4;
constexpr size_t B_CM = B_BM + (size_t)TT * 256 * 2;
constexpr size_t B_XM = 9 * U;
constexpr size_t B_SSDST = 10 * U;
constexpr size_t B_MLST = 11 * U;
constexpr size_t B_MIX = 13 * U;
constexpr size_t B_MISC = 15 * U;
constexpr size_t M_GSUM = B_MISC;
constexpr size_t M_BCUM = M_GSUM + 8 * 4 * 16 * 2 * 4;
constexpr size_t M_LI = M_BCUM + (size_t)TT * 4 * 4;
constexpr size_t M_DT = M_LI + (size_t)TT * 4 * 4;
constexpr size_t M_ACUM = M_DT + (size_t)TT * 16 * 4;
constexpr size_t M_MLN = M_ACUM + (size_t)TT * 16 * 4;
constexpr size_t M_END = M_MLN + 8ull * 4 * 16 * 256 * 4;
constexpr size_t WS_NEED = 15 * U + (8ull << 20);
static_assert(M_END <= WS_NEED, "misc");
static_assert(B_CM + (size_t)TT * 256 * 2 <= 9 * U, "bm/cm");
constexpr size_t B_X1 = 3 * U, B_HB = 5 * U, B_X2 = 8 * U;
constexpr size_t B_RB = 10 * U, B_KB = 11 * U, B_VB = 12 * U;
constexpr size_t B_LW = 13 * U, B_LA = B_LW + (size_t)TT * 128 * 2, B_LG = B_LA + (size_t)TT * 128 * 2;
constexpr size_t B_DEC = 3 * U, B_AB = 5 * U, B_GB = 6 * U, B_YB = 7 * U;
constexpr size_t B_YRAW = 13 * U;
constexpr size_t B_X3 = 3 * U, B_X4 = 8 * U;

constexpr int LDS_BYTES = 98304;

struct P {
  const float* in[N_IN];
  float* out;
  char* ws;
};

__device__ __forceinline__ u16 f2bf(float f) {
  unsigned u = __float_as_uint(f);
  u += 0x7fffu + ((u >> 16) & 1u);
  return (u16)(u >> 16);
}
__device__ __forceinline__ float bf2f(u16 h) { return __uint_as_float(((unsigned)h) << 16); }
__device__ __forceinline__ unsigned pk2(float a, float b) { return (unsigned)f2bf(a) | ((unsigned)f2bf(b) << 16); }
__device__ __forceinline__ float lo2f(unsigned u) { return __uint_as_float(u << 16); }
__device__ __forceinline__ float hi2f(unsigned u) { return __uint_as_float(u & 0xffff0000u); }
__device__ __forceinline__ void unpack8(const uint4& q, float* f) {
  f[0] = lo2f(q.x); f[1] = hi2f(q.x); f[2] = lo2f(q.y); f[3] = hi2f(q.y);
  f[4] = lo2f(q.z); f[5] = hi2f(q.z); f[6] = lo2f(q.w); f[7] = hi2f(q.w);
}
__device__ __forceinline__ uint4 pack8(const float* f) {
  uint4 q; q.x = pk2(f[0], f[1]); q.y = pk2(f[2], f[3]); q.z = pk2(f[4], f[5]); q.w = pk2(f[6], f[7]);
  return q;
}
__device__ __forceinline__ float softplusf(float x) { return x > 20.f ? x : log1pf(__expf(x)); }
__device__ __forceinline__ float sigmoidf(float x) { return 1.f / (1.f + __expf(-x)); }
__device__ __forceinline__ float wsum(float v) {
#pragma unroll
  for (int m = 32; m >= 1; m >>= 1) v += __shfl_xor(v, m);
  return v;
}
__device__ __forceinline__ float wmax(float v) {
#pragma unroll
  for (int m = 32; m >= 1; m >>= 1) v = fmaxf(v, __shfl_xor(v, m));
  return v;
}
__device__ __forceinline__ float wscan(float v, int lane) {
#pragma unroll
  for (int o = 1; o < 64; o <<= 1) {
    float t = __shfl_up(v, o);
    if (lane >= o) v += t;
  }
  return v;
}
__device__ __forceinline__ float bsum(float v, float* scr) {
  v = wsum(v);
  __syncthreads();
  if ((threadIdx.x & 63) == 0) scr[threadIdx.x >> 6] = v;
  __syncthreads();
  return scr[0] + scr[1] + scr[2] + scr[3];
}
__device__ __forceinline__ float dpp_f(float v, const int ctrl);
#define DPPF(v, ctrl) __int_as_float(__builtin_amdgcn_update_dpp(0, __float_as_int(v), ctrl, 0xF, 0xF, true))

__device__ __forceinline__ int img_off(int row, int kk  ) {
  return row * 128 + ((((kk >> 3) ^ ((row >> 1) & 7))) << 4) + ((kk & 7) << 1);
}

template <int MI, int NI>
__device__ __forceinline__ void mma_panel(f32x16 (&acc)[MI][NI], const char* Ap, int ar0, const char* Bp, int br0, int lane) {
  const int r = lane & 31, h = lane >> 5;
  bf16x8 a[2][MI], b[2][NI];
  const char* ap[MI];
  const char* bp[NI];
  int asw[MI], bsw[NI];
#pragma unroll
  for (int mi = 0; mi < MI; ++mi) { int row = ar0 + mi * 32 + r; ap[mi] = Ap + row * 128; asw[mi] = (row >> 1) & 7; }
#pragma unroll
  for (int ni = 0; ni < NI; ++ni) { int row = br0 + ni * 32 + r; bp[ni] = Bp + row * 128; bsw[ni] = (row >> 1) & 7; }
#pragma unroll
  for (int mi = 0; mi < MI; ++mi) a[0][mi] = *(const bf16x8*)(ap[mi] + ((h ^ asw[mi]) << 4));
#pragma unroll
  for (int ni = 0; ni < NI; ++ni) b[0][ni] = *(const bf16x8*)(bp[ni] + ((h ^ bsw[ni]) << 4));
#pragma unroll
  for (int ks = 0; ks < 4; ++ks) {
    const int cur = ks & 1, nxt = cur ^ 1;
    if (ks < 3) {
      const int ch = (ks + 1) * 2 + h;
#pragma unroll
      for (int mi = 0; mi < MI; ++mi) a[nxt][mi] = *(const bf16x8*)(ap[mi] + ((ch ^ asw[mi]) << 4));
#pragma unroll
      for (int ni = 0; ni < NI; ++ni) b[nxt][ni] = *(const bf16x8*)(bp[ni] + ((ch ^ bsw[ni]) << 4));
    }
    SB();
#pragma unroll
    for (int mi = 0; mi < MI; ++mi)
#pragma unroll
      for (int ni = 0; ni < NI; ++ni)
        acc[mi][ni] = __builtin_amdgcn_mfma_f32_32x32x16_bf16(a[cur][mi], b[cur][ni], acc[mi][ni], 0, 0, 0);
    SB();
  }
}
template <int MI, int NI>
__device__ __forceinline__ void mma_panel_s(f32x16 (&acc)[MI][NI], const char* Ap, int ar0, const char* Bp, int br0, int lane) {
  const int r = lane & 31, h = lane >> 5;
#pragma unroll
  for (int ks = 0; ks < 4; ++ks) {
    const int ch = ks * 2 + h;
    bf16x8 a[MI], b[NI];
#pragma unroll
    for (int mi = 0; mi < MI; ++mi) { int row = ar0 + mi * 32 + r; a[mi] = *(const bf16x8*)(Ap + row * 128 + ((ch ^ ((row >> 1) & 7)) << 4)); }
#pragma unroll
    for (int ni = 0; ni < NI; ++ni) { int row = br0 + ni * 32 + r; b[ni] = *(const bf16x8*)(Bp + row * 128 + ((ch ^ ((row >> 1) & 7)) << 4)); }
    SB();
#pragma unroll
    for (int mi = 0; mi < MI; ++mi)
#pragma unroll
      for (int ni = 0; ni < NI; ++ni)
        acc[mi][ni] = __builtin_amdgcn_mfma_f32_32x32x16_bf16(a[mi], b[ni], acc[mi][ni], 0, 0, 0);
    SB();
  }
}
template <int MI, int NI>
__device__ __forceinline__ void zero_acc(f32x16 (&acc)[MI][NI]) {
#pragma unroll
  for (int mi = 0; mi < MI; ++mi)
#pragma unroll
    for (int ni = 0; ni < NI; ++ni)
#pragma unroll
      for (int i = 0; i < 16; ++i) acc[mi][ni][i] = 0.f;
}
#define FRESH_TID(tid) int tid = threadIdx.x; asm volatile("" : "+v"(tid))
__device__ __forceinline__ int zof(int w) { int z; asm("s_mov_b32 %0, 0" : "=s"(z) : "s"(w)); return z; }
#define ACC_ROW(i, lane) (((i) & 3) + 8 * ((i) >> 2) + 4 * ((lane) >> 5))

template <class Epi>
__device__ __forceinline__ void gemm_tile(const u16* __restrict__ A, int lda, const u16* __restrict__ B, int ldb, int K,
                                          int m0, int n0, char* lds, const Epi& epi) {
  FRESH_TID(tid);
  const int lane = tid & 63, wid = tid >> 6, wr = wid & 1, wc = wid >> 1;
  f32x16 acc[4][2];
  zero_acc<4, 2>(acc);
  const int lrow = tid >> 3, lch = tid & 7;
  const u16* Bp = B + (size_t)(n0 + lrow) * ldb + lch * 8;
  const int soff = lrow * 128 + ((lch ^ ((lrow >> 1) & 7)) << 4);
  int aoff[8];
#pragma unroll
  for (int i = 0; i < 8; ++i) {
    int r = m0 + lrow + 32 * i;
    r = r < TT ? r : TT - 1;
    aoff[i] = (r - m0) * lda;
  }
  const u16* Ab = A + (size_t)m0 * lda + lch * 8;
  uint4 ra0, ra1, ra2, ra3, ra4, ra5, ra6, ra7, rb0, rb1, rb2, rb3, rc0, rc1, rc2, rc3, rc4, rc5, rc6, rc7, rd0, rd1, rd2, rd3;
  const int nk = K >> 6;
  {
    ra0 = *(const uint4*)(Ab + aoff[0] + 0);
    ra1 = *(const uint4*)(Ab + aoff[1] + 0);
    ra2 = *(const uint4*)(Ab + aoff[2] + 0);
    ra3 = *(const uint4*)(Ab + aoff[3] + 0);
    ra4 = *(const uint4*)(Ab + aoff[4] + 0);
    ra5 = *(const uint4*)(Ab + aoff[5] + 0);
    ra6 = *(const uint4*)(Ab + aoff[6] + 0);
    ra7 = *(const uint4*)(Ab + aoff[7] + 0);
    rb0 = *(const uint4*)(Bp + (size_t)(0) * ldb + 0);
    rb1 = *(const uint4*)(Bp + (size_t)(32) * ldb + 0);
    rb2 = *(const uint4*)(Bp + (size_t)(64) * ldb + 0);
    rb3 = *(const uint4*)(Bp + (size_t)(96) * ldb + 0);
    rc0 = *(const uint4*)(Ab + aoff[0] + 64);
    rc1 = *(const uint4*)(Ab + aoff[1] + 64);
    rc2 = *(const uint4*)(Ab + aoff[2] + 64);
    rc3 = *(const uint4*)(Ab + aoff[3] + 64);
    rc4 = *(const uint4*)(Ab + aoff[4] + 64);
    rc5 = *(const uint4*)(Ab + aoff[5] + 64);
    rc6 = *(const uint4*)(Ab + aoff[6] + 64);
    rc7 = *(const uint4*)(Ab + aoff[7] + 64);
    rd0 = *(const uint4*)(Bp + (size_t)(0) * ldb + 64);
    rd1 = *(const uint4*)(Bp + (size_t)(32) * ldb + 64);
    rd2 = *(const uint4*)(Bp + (size_t)(64) * ldb + 64);
    rd3 = *(const uint4*)(Bp + (size_t)(96) * ldb + 64);
    *(uint4*)(lds + 0 + soff + 0) = ra0;
    *(uint4*)(lds + 0 + soff + 4096) = ra1;
    *(uint4*)(lds + 0 + soff + 8192) = ra2;
    *(uint4*)(lds + 0 + soff + 12288) = ra3;
    *(uint4*)(lds + 0 + soff + 16384) = ra4;
    *(uint4*)(lds + 0 + soff + 20480) = ra5;
    *(uint4*)(lds + 0 + soff + 24576) = ra6;
    *(uint4*)(lds + 0 + soff + 28672) = ra7;
    *(uint4*)(lds + 0 + 32768 + soff + 0) = rb0;
    *(uint4*)(lds + 0 + 32768 + soff + 4096) = rb1;
    *(uint4*)(lds + 0 + 32768 + soff + 8192) = rb2;
    *(uint4*)(lds + 0 + 32768 + soff + 12288) = rb3;
  }
  __syncthreads();
  for (int kt = 0; kt < nk; kt += 2) {
    {
    const int kk = (kt + 2 < nk ? kt + 2 : nk - 1) * 64;
    ra0 = *(const uint4*)(Ab + aoff[0] + kk);
    ra1 = *(const uint4*)(Ab + aoff[1] + kk);
    ra2 = *(const uint4*)(Ab + aoff[2] + kk);
    ra3 = *(const uint4*)(Ab + aoff[3] + kk);
    ra4 = *(const uint4*)(Ab + aoff[4] + kk);
    ra5 = *(const uint4*)(Ab + aoff[5] + kk);
    ra6 = *(const uint4*)(Ab + aoff[6] + kk);
    ra7 = *(const uint4*)(Ab + aoff[7] + kk);
    rb0 = *(const uint4*)(Bp + (size_t)(0) * ldb + kk);
    rb1 = *(const uint4*)(Bp + (size_t)(32) * ldb + kk);
    rb2 = *(const uint4*)(Bp + (size_t)(64) * ldb + kk);
    rb3 = *(const uint4*)(Bp + (size_t)(96) * ldb + kk);
    }
    SB();
    {
      const int r_ = lane & 31, h_ = lane >> 5;
      {
        bf16x8 fa[4], fb[2];
        const int ch = 0 + h_;
#pragma unroll
        for (int mi = 0; mi < 4; ++mi) { int row = wr * 128 + mi * 32 + r_; fa[mi] = *(const bf16x8*)(lds + 0 + row * 128 + ((ch ^ ((row >> 1) & 7)) << 4)); }
#pragma unroll
        for (int ni = 0; ni < 2; ++ni) { int row = wc * 64 + ni * 32 + r_; fb[ni] = *(const bf16x8*)(lds + 0 + 32768 + row * 128 + ((ch ^ ((row >> 1) & 7)) << 4)); }
        SB();
#pragma unroll
        for (int mi = 0; mi < 4; ++mi)
#pragma unroll
          for (int ni = 0; ni < 2; ++ni) acc[mi][ni] = __builtin_amdgcn_mfma_f32_32x32x16_bf16(fa[mi], fb[ni], acc[mi][ni], 0, 0, 0);
        *(uint4*)(lds + 49152 + soff + 0) = rc0;
        *(uint4*)(lds + 49152 + soff + 4096) = rc1;
        *(uint4*)(lds + 49152 + soff + 8192) = rc2;
        SB();
      }
      {
        bf16x8 fa[4], fb[2];
        const int ch = 2 + h_;
#pragma unroll
        for (int mi = 0; mi < 4; ++mi) { int row = wr * 128 + mi * 32 + r_; fa[mi] = *(const bf16x8*)(lds + 0 + row * 128 + ((ch ^ ((row >> 1) & 7)) << 4)); }
#pragma unroll
        for (int ni = 0; ni < 2; ++ni) { int row = wc * 64 + ni * 32 + r_; fb[ni] = *(const bf16x8*)(lds + 0 + 32768 + row * 128 + ((ch ^ ((row >> 1) & 7)) << 4)); }
        SB();
#pragma unroll
        for (int mi = 0; mi < 4; ++mi)
#pragma unroll
          for (int ni = 0; ni < 2; ++ni) acc[mi][ni] = __builtin_amdgcn_mfma_f32_32x32x16_bf16(fa[mi], fb[ni], acc[mi][ni], 0, 0, 0);
        *(uint4*)(lds + 49152 + soff + 12288) = rc3;
        *(uint4*)(lds + 49152 + soff + 16384) = rc4;
        *(uint4*)(lds + 49152 + soff + 20480) = rc5;
        SB();
      }
      {
        bf16x8 fa[4], fb[2];
        const int ch = 4 + h_;
#pragma unroll
        for (int mi = 0; mi < 4; ++mi) { int row = wr * 128 + mi * 32 + r_; fa[mi] = *(const bf16x8*)(lds + 0 + row * 128 + ((ch ^ ((row >> 1) & 7)) << 4)); }
#pragma unroll
        for (int ni = 0; ni < 2; ++ni) { int row = wc * 64 + ni * 32 + r_; fb[ni] = *(const bf16x8*)(lds + 0 + 32768 + row * 128 + ((ch ^ ((row >> 1) & 7)) << 4)); }
        SB();
#pragma unroll
        for (int mi = 0; mi < 4; ++mi)
#pragma unroll
          for (int ni = 0; ni < 2; ++ni) acc[mi][ni] = __builtin_amdgcn_mfma_f32_32x32x16_bf16(fa[mi], fb[ni], acc[mi][ni], 0, 0, 0);
        *(uint4*)(lds + 49152 + soff + 24576) = rc6;
        *(uint4*)(lds + 49152 + soff + 28672) = rc7;
        *(uint4*)(lds + 49152 + 32768 + soff + 0) = rd0;
        SB();
      }
      {
        bf16x8 fa[4], fb[2];
        const int ch = 6 + h_;
#pragma unroll
        for (int mi = 0; mi < 4; ++mi) { int row = wr * 128 + mi * 32 + r_; fa[mi] = *(const bf16x8*)(lds + 0 + row * 128 + ((ch ^ ((row >> 1) & 7)) << 4)); }
#pragma unroll
        for (int ni = 0; ni < 2; ++ni) { int row = wc * 64 + ni * 32 + r_; fb[ni] = *(const bf16x8*)(lds + 0 + 32768 + row * 128 + ((ch ^ ((row >> 1) & 7)) << 4)); }
        SB();
#pragma unroll
        for (int mi = 0; mi < 4; ++mi)
#pragma unroll
          for (int ni = 0; ni < 2; ++ni) acc[mi][ni] = __builtin_amdgcn_mfma_f32_32x32x16_bf16(fa[mi], fb[ni], acc[mi][ni], 0, 0, 0);
        *(uint4*)(lds + 49152 + 32768 + soff + 4096) = rd1;
        *(uint4*)(lds + 49152 + 32768 + soff + 8192) = rd2;
        *(uint4*)(lds + 49152 + 32768 + soff + 12288) = rd3;
        SB();
      }
    }
    __syncthreads();
    {
    const int kk = (kt + 3 < nk ? kt + 3 : nk - 1) * 64;
    rc0 = *(const uint4*)(Ab + aoff[0] + kk);
    rc1 = *(const uint4*)(Ab + aoff[1] + kk);
    rc2 = *(const uint4*)(Ab + aoff[2] + kk);
    rc3 = *(const uint4*)(Ab + aoff[3] + kk);
    rc4 = *(const uint4*)(Ab + aoff[4] + kk);
    rc5 = *(const uint4*)(Ab + aoff[5] + kk);
    rc6 = *(const uint4*)(Ab + aoff[6] + kk);
    rc7 = *(const uint4*)(Ab + aoff[7] + kk);
    rd0 = *(const uint4*)(Bp + (size_t)(0) * ldb + kk);
    rd1 = *(const uint4*)(Bp + (size_t)(32) * ldb + kk);
    rd2 = *(const uint4*)(Bp + (size_t)(64) * ldb + kk);
    rd3 = *(const uint4*)(Bp + (size_t)(96) * ldb + kk);
    }
    SB();
    {
      const int r_ = lane & 31, h_ = lane >> 5;
      {
        bf16x8 fa[4], fb[2];
        const int ch = 0 + h_;
#pragma unroll
        for (int mi = 0; mi < 4; ++mi) { int row = wr * 128 + mi * 32 + r_; fa[mi] = *(const bf16x8*)(lds + 49152 + row * 128 + ((ch ^ ((row >> 1) & 7)) << 4)); }
#pragma unroll
        for (int ni = 0; ni < 2; ++ni) { int row = wc * 64 + ni * 32 + r_; fb[ni] = *(const bf16x8*)(lds + 49152 + 32768 + row * 128 + ((ch ^ ((row >> 1) & 7)) << 4)); }
        SB();
#pragma unroll
        for (int mi = 0; mi < 4; ++mi)
#pragma unroll
          for (int ni = 0; ni < 2; ++ni) acc[mi][ni] = __builtin_amdgcn_mfma_f32_32x32x16_bf16(fa[mi], fb[ni], acc[mi][ni], 0, 0, 0);
        *(uint4*)(lds + 0 + soff + 0) = ra0;
        *(uint4*)(lds + 0 + soff + 4096) = ra1;
        *(uint4*)(lds + 0 + soff + 8192) = ra2;
        SB();
      }
      {
        bf16x8 fa[4], fb[2];
        const int ch = 2 + h_;
#pragma unroll
        for (int mi = 0; mi < 4; ++mi) { int row = wr * 128 + mi * 32 + r_; fa[mi] = *(const bf16x8*)(lds + 49152 + row * 128 + ((ch ^ ((row >> 1) & 7)) << 4)); }
#pragma unroll
        for (int ni = 0; ni < 2; ++ni) { int row = wc * 64 + ni * 32 + r_; fb[ni] = *(const bf16x8*)(lds + 49152 + 32768 + row * 128 + ((ch ^ ((row >> 1) & 7)) << 4)); }
        SB();
#pragma unroll
        for (int mi = 0; mi < 4; ++mi)
#pragma unroll
          for (int ni = 0; ni < 2; ++ni) acc[mi][ni] = __builtin_amdgcn_mfma_f32_32x32x16_bf16(fa[mi], fb[ni], acc[mi][ni], 0, 0, 0);
        *(uint4*)(lds + 0 + soff + 12288) = ra3;
        *(uint4*)(lds + 0 + soff + 16384) = ra4;
        *(uint4*)(lds + 0 + soff + 20480) = ra5;
        SB();
      }
      {
        bf16x8 fa[4], fb[2];
        const int ch = 4 + h_;
#pragma unroll
        for (int mi = 0; mi < 4; ++mi) { int row = wr * 128 + mi * 32 + r_; fa[mi] = *(const bf16x8*)(lds + 49152 + row * 128 + ((ch ^ ((row >> 1) & 7)) << 4)); }
#pragma unroll
        for (int ni = 0; ni < 2; ++ni) { int row = wc * 64 + ni * 32 + r_; fb[ni] = *(const bf16x8*)(lds + 49152 + 32768 + row * 128 + ((ch ^ ((row >> 1) & 7)) << 4)); }
        SB();
#pragma unroll
        for (int mi = 0; mi < 4; ++mi)
#pragma unroll
          for (int ni = 0; ni < 2; ++ni) acc[mi][ni] = __builtin_amdgcn_mfma_f32_32x32x16_bf16(fa[mi], fb[ni], acc[mi][ni], 0, 0, 0);
        *(uint4*)(lds + 0 + soff + 24576) = ra6;
        *(uint4*)(lds + 0 + soff + 28672) = ra7;
        *(uint4*)(lds + 0 + 32768 + soff + 0) = rb0;
        SB();
      }
      {
        bf16x8 fa[4], fb[2];
        const int ch = 6 + h_;
#pragma unroll
        for (int mi = 0; mi < 4; ++mi) { int row = wr * 128 + mi * 32 + r_; fa[mi] = *(const bf16x8*)(lds + 49152 + row * 128 + ((ch ^ ((row >> 1) & 7)) << 4)); }
#pragma unroll
        for (int ni = 0; ni < 2; ++ni) { int row = wc * 64 + ni * 32 + r_; fb[ni] = *(const bf16x8*)(lds + 49152 + 32768 + row * 128 + ((ch ^ ((row >> 1) & 7)) << 4)); }
        SB();
#pragma unroll
        for (int mi = 0; mi < 4; ++mi)
#pragma unroll
          for (int ni = 0; ni < 2; ++ni) acc[mi][ni] = __builtin_amdgcn_mfma_f32_32x32x16_bf16(fa[mi], fb[ni], acc[mi][ni], 0, 0, 0);
        *(uint4*)(lds + 0 + 32768 + soff + 4096) = rb1;
        *(uint4*)(lds + 0 + 32768 + soff + 8192) = rb2;
        *(uint4*)(lds + 0 + 32768 + soff + 12288) = rb3;
        SB();
      }
    }
    __syncthreads();
  }
  epi(acc, m0 + wr * 128, n0 + wc * 64, lane);
}

struct TDesc { const float* src; u16* dst; int K, N, lds, Kp, Np, mode; };
__device__ __forceinline__ TDesc get_tdesc(const P& p, int i, int zz) {
  TDesc d;
  d.mode = 0;
  char* ws = p.ws;
  switch (i) {
    case 0: d = {p.in[zz + I_WIN0], (u16*)(ws + W_IN0), 1024, 4632, 4632, 1024, 4736, 1}; break;
    case 1: d = {p.in[zz + I_WOUT0], (u16*)(ws + W_OUT0), 2048, 1024, 1024, 2048, 1024, 0}; break;
    case 2: d = {p.in[zz + I_GU], (u16*)(ws + W_GU), 1024, 5632, 5632, 1024, 5632, 2}; break;
    case 3: d = {p.in[zz + I_GU] + 1024ull * 5632, (u16*)(ws + W_GU + 5632ull * 1024 * 2), 1024, 5632, 5632, 1024, 5632, 2}; break;
    case 4: d = {p.in[zz + I_DN], (u16*)(ws + W_DN), 2816, 1024, 1024, 2816, 1024, 0}; break;
    case 5: d = {p.in[zz + I_DN] + 2816ull * 1024, (u16*)(ws + W_DN + 1024ull * 2816 * 2), 2816, 1024, 1024, 2816, 1024, 0}; break;
    case 6: d = {p.in[zz + I_WR], (u16*)(ws + W_R), 1024, 1024, 1024, 1024, 1024, 0}; break;
    case 7: d = {p.in[zz + I_WKK], (u16*)(ws + W_K), 1024, 1024, 1024, 1024, 1024, 0}; break;
    case 8: d = {p.in[zz + I_WVV], (u16*)(ws + W_V), 1024, 1024, 1024, 1024, 1024, 0}; break;
    case 9: d = {p.in[zz + I_WO], (u16*)(ws + W_O), 1024, 1024, 1024, 1024, 1024, 0}; break;
    case 10: d = {p.in[zz + I_W1], (u16*)(ws + W_W1), 1024, 64, 64, 1024, 128, 0}; break;
    case 11: d = {p.in[zz + I_A1], (u16*)(ws + W_A1), 1024, 64, 64, 1024, 128, 0}; break;
    case 12: d = {p.in[zz + I_G1], (u16*)(ws + W_G1), 1024, 160, 160, 1024, 256, 0}; break;
    case 13: d = {p.in[zz + I_W2], (u16*)(ws + W_W2), 64, 1024, 1024, 128, 1024, 0}; break;
    case 14: d = {p.in[zz + I_A2], (u16*)(ws + W_A2), 64, 1024, 1024, 128, 1024, 0}; break;
    default: d = {p.in[zz + I_G2], (u16*)(ws + W_G2), 160, 1024, 1024, 256, 1024, 0}; break;
  }
  return d;
}
__device__ __forceinline__ int tdesc_tiles(int i) {
  switch (i) {
    case 0: return 16 * 74;
    case 1: return 32 * 16;
    case 2: case 3: return 16 * 88;
    case 4: case 5: return 44 * 16;
    case 6: case 7: case 8: case 9: return 16 * 16;
    case 10: case 11: return 16 * 2;
    case 12: return 16 * 4;
    case 13: case 14: return 2 * 16;
    default: return 4 * 16;
  }
}
constexpr int PREP_TILES = 16 * 74 + 32 * 16 + 2 * 16 * 88 + 2 * 44 * 16 + 4 * 256 + 2 * 32 + 64 + 2 * 32 + 64;

__device__ __forceinline__ void rms_rows_bf16(const float* src_row, const float* g, u16* dst_row, int lane) {
  float4 v[4];
  float ss = 0.f;
#pragma unroll
  for (int i = 0; i < 4; ++i) {
    v[i] = ((const float4*)src_row)[lane + 64 * i];
    ss += v[i].x * v[i].x + v[i].y * v[i].y + v[i].z * v[i].z + v[i].w * v[i].w;
  }
  ss = wsum(ss);
  float rinv = rsqrtf(ss * (1.f / 1024.f) + EPS);
#pragma unroll
  for (int i = 0; i < 4; ++i) {
    float4 g4 = ((const float4*)g)[lane + 64 * i];
    uint2 o;
    o.x = pk2(v[i].x * rinv * g4.x, v[i].y * rinv * g4.y);
    o.y = pk2(v[i].z * rinv * g4.z, v[i].w * rinv * g4.w);
    ((uint2*)dst_row)[lane + 64 * i] = o;
  }
}

__device__ __forceinline__ void rms_rows2_bf16(const float* sa, const float* sb, const float* g, u16* da, u16* db, bool hasb, int lane) {
  float4 va[4], vb[4];
  float ssa = 0.f, ssb = 0.f;
#pragma unroll
  for (int i = 0; i < 4; ++i) { va[i] = ((const float4*)sa)[lane + 64 * i]; vb[i] = ((const float4*)sb)[lane + 64 * i]; }
#pragma unroll
  for (int i = 0; i < 4; ++i) {
    ssa += va[i].x * va[i].x + va[i].y * va[i].y + va[i].z * va[i].z + va[i].w * va[i].w;
    ssb += vb[i].x * vb[i].x + vb[i].y * vb[i].y + vb[i].z * vb[i].z + vb[i].w * vb[i].w;
  }
  ssa = wsum(ssa); ssb = wsum(ssb);
  float ra = rsqrtf(ssa * (1.f / 1024.f) + EPS), rb = rsqrtf(ssb * (1.f / 1024.f) + EPS);
#pragma unroll
  for (int i = 0; i < 4; ++i) {
    float4 g4 = ((const float4*)g)[lane + 64 * i];
    uint2 o;
    o.x = pk2(va[i].x * ra * g4.x, va[i].y * ra * g4.y);
    o.y = pk2(va[i].z * ra * g4.z, va[i].w * ra * g4.w);
    ((uint2*)da)[lane + 64 * i] = o;
    if (hasb) {
      o.x = pk2(vb[i].x * rb * g4.x, vb[i].y * rb * g4.y);
      o.y = pk2(vb[i].z * rb * g4.z, vb[i].w * rb * g4.w);
      ((uint2*)db)[lane + 64 * i] = o;
    }
  }
}
__device__ __forceinline__ void phase_prep(const P& p, char* lds, int bid, int G) {
  float* tile = (float*)lds;
  const int total = PREP_TILES + TT / 4;
  for (int w = bid; w < total; w += G) {
    FRESH_TID(tid);
    const int zz = zof(w);
    const int lane = tid & 63, wid = tid >> 6;
    if (w < PREP_TILES) {
      int t = w, di = 0;
      for (; di < 16; ++di) {
        int n = tdesc_tiles(di);
        if (t < n) break;
        t -= n;
      }
      TDesc d = get_tdesc(p, di, zz);
      const int nkt = d.Kp >> 6;
      const int kt = t % nkt, nt = t / nkt;
      const int k0 = kt * 64, n0 = nt * 64;
      float vals[16];
#pragma unroll
      for (int i = 0; i < 16; ++i) {
        int kk = i * 4 + (tid >> 6), nn = tid & 63;
        int n = n0 + nn, k = k0 + kk, sc;
        if (d.mode == 0) sc = (n < d.N) ? n : -1;
        else if (d.mode == 1) sc = n < 3584 ? n : (n < 4608 ? 3600 + (n - 3584) : (n < 4624 ? 3584 + (n - 4608) : (n < 4632 ? n : -1)));
        else { int q = n >> 6, j = n & 63; sc = j < 32 ? q * 32 + j : 2816 + q * 32 + (j - 32); }
        const bool ok = (sc >= 0 && k < d.K);
        float v = d.src[ok ? (size_t)k * d.lds + sc : 0];
        vals[i] = ok ? v : 0.f;
      }
#pragma unroll
      for (int i = 0; i < 16; ++i) tile[(i * 4 + (tid >> 6)) * 65 + (tid & 63)] = vals[i];
      __syncthreads();
#pragma unroll
      for (int i = 0; i < 16; ++i) {
        int nn = i * 4 + (tid >> 6), kk = tid & 63;
        d.dst[(size_t)(n0 + nn) * d.Kp + k0 + kk] = f2bf(tile[kk * 65 + nn]);
      }
      __syncthreads();
    } else {
      int row = (w - PREP_TILES) * 4 + wid;
      const float* src = row < TP ? p.in[zz + I_XP] + (size_t)row * 1024 : p.in[zz + I_XS] + (size_t)(row - TP) * 1024;
      rms_rows_bf16(src, p.in[zz + I_NMIX], (u16*)(p.ws + B_A) + (size_t)row * 1024, lane);
    }
  }
}

__device__ __forceinline__ bool tile_map(int q, int xcd, int MT, int NT, int& mt, int& nt) {
  int mi = q / NT;
  nt = q - mi * NT;
  mt = xcd + 8 * mi;
  return mt < MT;
}
template <class Epi>
__device__ __forceinline__ void gemm_phase(const u16* A, int lda, const u16* B, int ldb, int K, int MT, int NT, char* lds, int bid, int G, const Epi& epi) {
  const int xcd = bid & 7, j = bid >> 3, nb = G >> 3;
  const int nq = ((MT + 7) >> 3) * NT;
  for (int q = j; q < nq; q += nb) {
    int mt, nt;
    if (!tile_map(q, xcd, MT, NT, mt, nt)) break;
    gemm_tile(A, lda, B, ldb, K, mt * 256, nt * 128, lds, epi);
  }
}

struct EpiProj {
  u16* proj; float* small;
  __device__ __forceinline__ void operator()(f32x16 (&acc)[4][2], int r0, int c0, int lane) const {
#pragma unroll
    for (int mi = 0; mi < 4; ++mi)
#pragma unroll
      for (int ni = 0; ni < 2; ++ni) {
        int col = c0 + ni * 32 + (lane & 31);
#pragma unroll
        for (int i = 0; i < 16; ++i) {
          int row = r0 + mi * 32 + ACC_ROW(i, lane);
          if (row >= TT) continue;
          float v = acc[mi][ni][i];
          if (col < PJ) proj[(size_t)row * PJ + col] = f2bf(v);
          else if (col < PJ + 32) small[(size_t)row * 32 + (col - PJ)] = v;
        }
      }
  }
};
struct EpiRes {
  const float* res; const float* res2; float* out;
  __device__ __forceinline__ void operator()(f32x16 (&acc)[4][2], int r0, int c0, int lane) const {
#pragma unroll
    for (int mi = 0; mi < 4; ++mi)
#pragma unroll
      for (int ni = 0; ni < 2; ++ni) {
        int col = c0 + ni * 32 + (lane & 31);
#pragma unroll
        for (int i = 0; i < 16; ++i) {
          int row = r0 + mi * 32 + ACC_ROW(i, lane);
          if (row >= TT) continue;
          float rv = row < TP ? res[(size_t)row * 1024 + col] : res2[(size_t)(row - TP) * 1024 + col];
          out[(size_t)row * 1024 + col] = rv + acc[mi][ni][i];
        }
      }
  }
};
struct EpiSwiglu {
  u16* hb;
  __device__ __forceinline__ void operator()(f32x16 (&acc)[4][2], int r0, int c0, int lane) const {
    int col = (c0 >> 1) + (lane & 31);
#pragma unroll
    for (int mi = 0; mi < 4; ++mi)
#pragma unroll
      for (int i = 0; i < 16; ++i) {
        int row = r0 + mi * 32 + ACC_ROW(i, lane);
        if (row >= TT) continue;
        float g = acc[mi][0][i], u = acc[mi][1][i];
        hb[(size_t)row * 2816 + col] = f2bf(g * sigmoidf(g) * u);
      }
  }
};
struct EpiAct {
  u16* out; int ldo; int nvalid; int nstore; int act;
  __device__ __forceinline__ void operator()(f32x16 (&acc)[4][2], int r0, int c0, int lane) const {
#pragma unroll
    for (int mi = 0; mi < 4; ++mi)
#pragma unroll
      for (int ni = 0; ni < 2; ++ni) {
        int col = c0 + ni * 32 + (lane & 31);
        if (col >= nstore) continue;
#pragma unroll
        for (int i = 0; i < 16; ++i) {
          int row = r0 + mi * 32 + ACC_ROW(i, lane);
          if (row >= TT) continue;
          float v = acc[mi][ni][i];
          if (act == 1) v = tanhf(v);
          else if (act == 2) v = sigmoidf(v);
          if (col >= nvalid) v = 0.f;
          out[(size_t)row * ldo + col] = f2bf(v);
        }
      }
  }
};
struct EpiLora2 {
  int which; const float* bias; float* outf; u16* outb;
  __device__ __forceinline__ void operator()(f32x16 (&acc)[4][2], int r0, int c0, int lane) const {
#pragma unroll
    for (int mi = 0; mi < 4; ++mi)
#pragma unroll
      for (int ni = 0; ni < 2; ++ni) {
        int col = c0 + ni * 32 + (lane & 31);
        float bv = which < 2 ? bias[col] : 0.f;
#pragma unroll
        for (int i = 0; i < 16; ++i) {
          int row = r0 + mi * 32 + ACC_ROW(i, lane);
          if (row >= TT) continue;
          float v = acc[mi][ni][i] + bv;
          if (which == 0) {
            float w = -softplusf(-v) - 0.5f;
            outf[(size_t)row * 1024 + col] = __expf(-__expf(w));
          } else if (which == 1) {
            outb[(size_t)row * 1024 + col] = f2bf(sigmoidf(v));
          } else {
            outb[(size_t)row * 1024 + col] = f2bf(v);
          }
        }
      }
  }
};

__device__ __forceinline__ void phase_conv(const P& p, char* lds, int bid, int G) {
  const u16* proj = (const u16*)(p.ws + B_PROJ);
  const float* small = (const float*)(p.ws + B_SMALL);
  u16* xs = (u16*)(p.ws + B_A);
  u16* Bm = (u16*)(p.ws + B_BM);
  u16* Cm = (u16*)(p.ws + B_CM);
  u16* xm = (u16*)(p.ws + B_XM);
  const int zz0 = zof(bid);
  const float* cw = p.in[zz0 + I_CONVW];
  const float* cb = p.in[zz0 + I_CONVB];
  const int n_conv = TT / 4;
  const int n_gate = (512 + 2048) / 4;
  for (int w = bid; w < n_conv + n_gate; w += G) {
    FRESH_TID(tid);
    const int zz = zof(w);
    const int lane = tid & 63, wid = tid >> 6;
    if (w < n_conv) {
#pragma unroll
      for (int k_ = 0; k_ < 5; ++k_) {
        const int i = tid + k_ * 256;
        int r4 = i / 320, cgp = i % 320;
        int row = w * 4 + r4, c0 = cgp * 8;
        float u[4][8];
        if (row < TP) {
          int t = row & 2047;
#pragma unroll
          for (int j = 0; j < 4; ++j) {
            int tt = t - 3 + j;
            if (tt >= 0) {
              uint4 q = *(const uint4*)(proj + (size_t)(row - 3 + j) * PJ + 1024 + c0);
              unpack8(q, u[j]);
            } else {
#pragma unroll
              for (int e = 0; e < 8; ++e) u[j][e] = 0.f;
            }
          }
          if (t >= 2045) {
            int b = row >> 11;
            float* o = p.out + O_CONVP + ((size_t)(b * 3 + (t - 2045)) * 2560 + c0);
#pragma unroll
            for (int e = 0; e < 8; ++e) o[e] = u[3][e];
          }
        } else {
          int bs = row - TP;
#pragma unroll
          for (int j = 0; j < 3; ++j) {
            const float* s = p.in[zz + I_SCONV] + ((size_t)(bs * 3 + j) * 2560 + c0);
#pragma unroll
            for (int e = 0; e < 8; ++e) u[j][e] = s[e];
          }
          uint4 q = *(const uint4*)(proj + (size_t)row * PJ + 1024 + c0);
          unpack8(q, u[3]);
          float* o = p.out + O_CONVS + ((size_t)(bs * 3) * 2560 + c0);
#pragma unroll
          for (int e = 0; e < 8; ++e) { o[e] = u[1][e]; o[2560 + e] = u[2][e]; o[5120 + e] = u[3][e]; }
        }
        float a[8];
#pragma unroll
        for (int e = 0; e < 8; ++e) {
          float v = cb[c0 + e];
#pragma unroll
          for (int j = 0; j < 4; ++j) v += u[j][e] * cw[j * 2560 + c0 + e];
          a[e] = v * sigmoidf(v);
        }
        uint4 o = pack8(a);
        u16* dst;
        if (c0 < 1024) dst = xs + (size_t)row * 1024 + c0;
        else if (c0 < 1280) dst = Bm + (size_t)row * 256 + (c0 - 1024);
        else if (c0 < 1536) dst = Cm + (size_t)row * 256 + (c0 - 1280);
        else dst = xm + (size_t)row * 1024 + (c0 - 1536);
        *(uint4*)dst = o;
      }
    } else {
      int wi = (w - n_conv) * 4 + wid;
      int t0 = 2 * lane;
      if (wi < 512) {
        int c = wi & 15, h = (wi >> 4) & 3, b = wi >> 6;
        int row0 = b * 2048 + c * 128;
        float fb = p.in[zz + I_FB][h], ib = p.in[zz + I_IB][h];
        float f0 = small[(size_t)(row0 + t0) * 32 + 20 + h] + fb, f1 = small[(size_t)(row0 + t0 + 1) * 32 + 20 + h] + fb;
        float i0 = small[(size_t)(row0 + t0) * 32 + 16 + h] + ib, i1 = small[(size_t)(row0 + t0 + 1) * 32 + 16 + h] + ib;
        float lf0 = -softplusf(-f0), lf1 = -softplusf(-f1);
        float inc = wscan(lf0 + lf1, lane);
        float bc1 = inc, bc0 = inc - lf1;
        float uu = wmax(fmaxf(i0 - bc0, i1 - bc1));
        float bend = __shfl(inc, 63);
        float* bcum = (float*)(p.ws + M_BCUM);
        float* li = (float*)(p.ws + M_LI);
        bcum[(size_t)(row0 + t0) * 4 + h] = bc0; bcum[(size_t)(row0 + t0 + 1) * 4 + h] = bc1;
        li[(size_t)(row0 + t0) * 4 + h] = i0; li[(size_t)(row0 + t0 + 1) * 4 + h] = i1;
        if (lane == 0) {
          float* gs = (float*)(p.ws + M_GSUM) + (size_t)((b * 4 + h) * 16 + c) * 2;
          gs[0] = bend; gs[1] = uu;
        }
      } else {
        int x = wi - 512;
        int h = x & 15, c = (x >> 4) & 15, b = x >> 8;
        int row0 = b * 2048 + c * 128;
        float db = p.in[zz + I_DTB][h], an = -__expf(p.in[zz + I_ALOG][h]);
        float d0 = softplusf(small[(size_t)(row0 + t0) * 32 + h] + db), d1 = softplusf(small[(size_t)(row0 + t0 + 1) * 32 + h] + db);
        float inc = wscan((d0 + d1) * an, lane);
        float* dt = (float*)(p.ws + M_DT);
        float* ac = (float*)(p.ws + M_ACUM);
        dt[(size_t)(row0 + t0) * 16 + h] = d0; dt[(size_t)(row0 + t0 + 1) * 16 + h] = d1;
        ac[(size_t)(row0 + t0) * 16 + h] = inc - d1 * an; ac[(size_t)(row0 + t0 + 1) * 16 + h] = inc;
      }
    }
  }
}

__device__ __forceinline__ void blockdiag8(const float* x, const float* __restrict__ w, int ch0, float scale, float* o) {
  const float4* w4 = (const float4*)(w + (size_t)(ch0 >> 2) * 16);
#pragma unroll
  for (int blk = 0; blk < 2; ++blk) {
    float4 r0 = w4[blk * 4 + 0], r1 = w4[blk * 4 + 1], r2 = w4[blk * 4 + 2], r3 = w4[blk * 4 + 3];
    const float* xx = x + blk * 4;
    o[blk * 4 + 0] = (xx[0] * r0.x + xx[1] * r1.x + xx[2] * r2.x + xx[3] * r3.x) * scale;
    o[blk * 4 + 1] = (xx[0] * r0.y + xx[1] * r1.y + xx[2] * r2.y + xx[3] * r3.y) * scale;
    o[blk * 4 + 2] = (xx[0] * r0.z + xx[1] * r1.z + xx[2] * r2.z + xx[3] * r3.z) * scale;
    o[blk * 4 + 3] = (xx[0] * r0.w + xx[1] * r1.w + xx[2] * r2.w + xx[3] * r3.w) * scale;
  }
}
__device__ __forceinline__ void mchain(const float* gs  , int c, float& mc, float& mn, float& bend) {
  float m = 0.f;
  for (int j = 0; j < c; ++j) m = gs[j * 2] + fmaxf(m, gs[j * 2 + 1]);
  mc = m;
  bend = gs[c * 2];
  mn = bend + fmaxf(m, gs[c * 2 + 1]);
}

__device__ __forceinline__ void img_put_t(char* img, int R, int j0, int s, const float* v) {
  char* pb = img + (s >> 6) * (R * 128);
#pragma unroll
  for (int e = 0; e < 8; ++e) *(u16*)(pb + img_off(j0 + e, s & 63)) = f2bf(v[e]);
}

__device__ __forceinline__ void phase_chunkstate(const P& p, char* lds, int bid, int G) {
  const u16* proj = (const u16*)(p.ws + B_PROJ);
  const float* small = (const float*)(p.ws + B_SMALL);
  const u16* xs = (const u16*)(p.ws + B_A);
  const u16* Bm = (const u16*)(p.ws + B_BM);
  const u16* Cm = (const u16*)(p.ws + B_CM);
  const u16* xm = (const u16*)(p.ws + B_XM);
  u16* mix = (u16*)(p.ws + B_MIX);
  char* R0 = lds;
  char* R1 = lds + 32768;
  float* ex = (float*)(lds + 65536);
  for (int w = bid; w < 2048; w += G) {
    FRESH_TID(tid);
    const int zz = zof(w);
    const int lane = tid & 63, wid = tid >> 6;
    if (w < 512) {
      const int bs = w >> 2, h = w & 3, row = TP + bs;
      float* sq = ex; float* sk = ex + 256; float* sv = ex + 512; float* scr = ex + 768;
      {
        int d = tid, cb4 = d & ~3, ci = d & 3;
        int nb = (h * 256 + cb4) >> 2;
        float q = 0.f, k = 0.f, v = 0.f;
#pragma unroll
        for (int c = 0; c < 4; ++c) {
          float xa = bf2f(xm[(size_t)row * 1024 + h * 256 + cb4 + c]);
          float xr = bf2f(proj[(size_t)row * PJ + 2560 + h * 256 + cb4 + c]);
          q += xa * p.in[zz + I_WQ][nb * 16 + c * 4 + ci];
          k += xa * p.in[zz + I_WK][nb * 16 + c * 4 + ci];
          v += xr * p.in[zz + I_WV][nb * 16 + c * 4 + ci];
        }
        sq[d] = q; sk[d] = k * 0.0625f; sv[d] = v;
      }
      float lf = -softplusf(-(small[(size_t)row * 32 + 20 + h] + p.in[zz + I_FB][h]));
      float li = small[(size_t)row * 32 + 16 + h] + p.in[zz + I_IB][h];
      float m = p.in[zz + I_SMM][bs * 4 + h];
      float mnew = fmaxf(lf + m, li);
      float wsc = __expf(li - mnew), dc = __expf(lf + m - mnew);
      __syncthreads();
      float nn = dc * p.in[zz + I_SMN][(size_t)(bs * 4 + h) * 256 + tid] + wsc * sk[tid];
      p.out[O_MNS + (size_t)(bs * 4 + h) * 256 + tid] = nn;
      float den = bsum(sq[tid] * nn, scr);
      const float* C = p.in[zz + I_SMC] + (size_t)(bs * 4 + h) * 65536 + tid;
      float* Co = p.out + O_MCS + (size_t)(bs * 4 + h) * 65536 + tid;
      float vv = sv[tid] * wsc, num = 0.f;
      for (int d0 = 0; d0 < 256; d0 += 32) {
        float c[32];
#pragma unroll
        for (int e = 0; e < 32; ++e) c[e] = C[(size_t)(d0 + e) * 256];
#pragma unroll
        for (int e = 0; e < 32; ++e) {
          float cn = dc * c[e] + sk[d0 + e] * vv;
          num += sq[d0 + e] * cn;
          Co[(size_t)(d0 + e) * 256] = cn;
        }
      }
      float hv = num / fmaxf(fabsf(den), __expf(-mnew));
      float ss = bsum(hv * hv, scr);
      float rinv = rsqrtf(ss * (1.f / 256.f) + EPS);
      int ch = h * 256 + tid;
      float xa = bf2f(xm[(size_t)row * 1024 + ch]);
      float op = bf2f(proj[(size_t)row * PJ + 3584 + ch]);
      float hm = (hv * rinv * p.in[zz + I_MLN][ch] + p.in[zz + I_MLS][ch] * xa) * sigmoidf(op);
      mix[(size_t)row * 2048 + 1024 + ch] = f2bf(hm);
      if (tid == 0) p.out[O_MMS + bs * 4 + h] = mnew;
      __syncthreads();
    } else if (w < 768) {
      const int x = w - 512, bs = x >> 1, g = x & 1, row = TP + bs;
      float* yz = ex; float* scr = ex + 512;
      const int pp = tid >> 2, nq = tid & 3, n0 = nq * 32;
      _Pragma("unroll 1")
      for (int h8 = 0; h8 < 8; ++h8) {
        int h = g * 8 + h8;
        float dtv = softplusf(small[(size_t)row * 32 + h] + p.in[zz + I_DTB][h]);
        float dec = __expf(-dtv * __expf(p.in[zz + I_ALOG][h]));
        float xv = bf2f(xs[(size_t)row * 1024 + h * 64 + pp]);
        const float* st = p.in[zz + I_SSSM] + ((size_t)((bs * 16 + h) * 64 + pp)) * 128 + n0;
        float* so = p.out + O_SSMS + ((size_t)((bs * 16 + h) * 64 + pp)) * 128 + n0;
        float ys = 0.f, dx = dtv * xv;
#pragma unroll
        for (int j = 0; j < 8; ++j) {
          float4 s4 = *(const float4*)(st + j * 4);
          uint2 b2 = *(const uint2*)(Bm + (size_t)row * 256 + g * 128 + n0 + j * 4);
          uint2 c2 = *(const uint2*)(Cm + (size_t)row * 256 + g * 128 + n0 + j * 4);
          float4 o;
          o.x = dec * s4.x + dx * lo2f(b2.x); o.y = dec * s4.y + dx * hi2f(b2.x);
          o.z = dec * s4.z + dx * lo2f(b2.y); o.w = dec * s4.w + dx * hi2f(b2.y);
          ys += o.x * lo2f(c2.x) + o.y * hi2f(c2.x) + o.z * lo2f(c2.y) + o.w * hi2f(c2.y);
          *(float4*)(so + j * 4) = o;
        }
        ys += __shfl_xor(ys, 1);
        ys += __shfl_xor(ys, 2);
        if (nq == 0) {
          float z = bf2f(proj[(size_t)row * PJ + h * 64 + pp]);
          yz[h8 * 64 + pp] = (ys + p.in[zz + I_SSDD][h] * xv) * z * sigmoidf(z);
        }
      }
      __syncthreads();
      float a0 = yz[tid], a1 = yz[tid + 256];
      float ss = bsum(a0 * a0 + a1 * a1, scr);
      float rinv = rsqrtf(ss * (1.f / 512.f) + EPS);
      mix[(size_t)row * 2048 + g * 512 + tid] = f2bf(a0 * rinv * p.in[zz + I_SSDN][g * 512 + tid]);
      mix[(size_t)row * 2048 + g * 512 + tid + 256] = f2bf(a1 * rinv * p.in[zz + I_SSDN][g * 512 + tid + 256]);
      __syncthreads();
    } else if (w < 1024) {
      const int x = w - 768, g = x & 1, c = (x >> 1) & 15, b = x >> 5;
      const int rowbase = b * 2048 + c * 128;
      const float* dt = (const float*)(p.ws + M_DT);
      const float* ac = (const float*)(p.ws + M_ACUM);
      float* sWe = ex;
      for (int i = tid; i < 1024; i += 256) {
        int h8 = i >> 7, s = i & 127, h = g * 8 + h8;
        float al = ac[(size_t)(rowbase + 127) * 16 + h];
        sWe[i] = __expf(al - ac[(size_t)(rowbase + s) * 16 + h]) * dt[(size_t)(rowbase + s) * 16 + h];
      }
      _Pragma("unroll 4")
      for (int k_ = 0; k_ < (128 * 16) / 256; ++k_) { const int i = tid + k_ * 256;
        int jc = i & 15, s = i >> 4;
        uint4 q = *(const uint4*)(Bm + (size_t)(rowbase + s) * 256 + g * 128 + jc * 8);
        float v[8]; unpack8(q, v);
        img_put_t(R0, 128, jc * 8, s, v);
      }
      __syncthreads();
      _Pragma("unroll 1")
      for (int h8 = 0; h8 < 8; ++h8) {
        int h = g * 8 + h8;
        _Pragma("unroll")
        for (int k_ = 0; k_ < (128 * 8) / 256; ++k_) { const int i = tid + k_ * 256;
          int jc = i & 7, s = i >> 3;
          uint4 q = *(const uint4*)(xs + (size_t)(rowbase + s) * 1024 + h * 64 + jc * 8);
          float v[8]; unpack8(q, v);
          float sc = sWe[h8 * 128 + s];
#pragma unroll
          for (int e = 0; e < 8; ++e) v[e] *= sc;
          img_put_t(R1, 64, jc * 8, s, v);
        }
        __syncthreads();
        f32x16 acc[1][2];
        zero_acc<1, 2>(acc);
#pragma unroll
        for (int pn = 0; pn < 2; ++pn) mma_panel<1, 2>(acc, R1 + pn * 8192, (wid & 1) * 32, R0 + pn * 16384, (wid >> 1) * 64, lane);
        u16* dst = (u16*)(p.ws + B_SSDST) + ((size_t)((b * 16 + c) * 16 + h)) * 8192;
#pragma unroll
        for (int ni = 0; ni < 2; ++ni)
#pragma unroll
          for (int i = 0; i < 16; ++i) {
            int pr = (wid & 1) * 32 + ACC_ROW(i, lane), n = (wid >> 1) * 64 + ni * 32 + (lane & 31);
            dst[pr * 128 + n] = f2bf(acc[0][ni][i]);
          }
        __syncthreads();
      }
    } else {
      const int x = w - 1024, vh = x & 1, c = (x >> 1) & 15, h = (x >> 5) & 3, b = x >> 7;
      const int rowbase = b * 2048 + c * 128;
      const float* gs = (const float*)(p.ws + M_GSUM) + (size_t)(b * 4 + h) * 32;
      float mc, mn, bend;
      mchain(gs, c, mc, mn, bend);
      float* sWs = ex;
      const float* bcum = (const float*)(p.ws + M_BCUM);
      const float* li = (const float*)(p.ws + M_LI);
      if (tid < 128) sWs[tid] = __expf(bend - bcum[(size_t)(rowbase + tid) * 4 + h] + li[(size_t)(rowbase + tid) * 4 + h] - mn);
      _Pragma("unroll 4")
      for (int k_ = 0; k_ < (128 * 16) / 256; ++k_) { const int i = tid + k_ * 256;
        int jc = i & 15, s = i >> 4;
        int ch0 = h * 256 + vh * 128 + jc * 8;
        uint4 q = *(const uint4*)(proj + (size_t)(rowbase + s) * PJ + 2560 + ch0);
        float xv[8], v[8]; unpack8(q, xv);
        blockdiag8(xv, p.in[zz + I_WV], ch0, 1.f, v);
        img_put_t(R0, 128, jc * 8, s, v);
      }
      __syncthreads();
      _Pragma("unroll 1")
      for (int dh = 0; dh < 2; ++dh) {
        _Pragma("unroll 4")
        for (int k_ = 0; k_ < (128 * 16) / 256; ++k_) { const int i = tid + k_ * 256;
          int jc = i & 15, s = i >> 4;
          int ch0 = h * 256 + dh * 128 + jc * 8;
          uint4 q = *(const uint4*)(xm + (size_t)(rowbase + s) * 1024 + ch0);
          float xv[8], v[8]; unpack8(q, xv);
          blockdiag8(xv, p.in[zz + I_WK], ch0, 0.0625f * sWs[s], v);
          img_put_t(R1, 128, jc * 8, s, v);
        }
        __syncthreads();
        f32x16 acc[2][2];
        zero_acc<2, 2>(acc);
#pragma unroll
        for (int pn = 0; pn < 2; ++pn) mma_panel<2, 2>(acc, R0 + pn * 16384, (wid & 1) * 64, R1 + pn * 16384, (wid >> 1) * 64, lane);
        if (vh == 0) {
          int d = tid >> 1, hf = tid & 1;
          float s = 0.f;
          for (int k = 0; k < 64; ++k) s += bf2f(*(const u16*)(R1 + hf * 16384 + img_off(d, k)));
          s += __shfl_xor(s, 1);
          if (hf == 0) ((float*)(p.ws + M_MLN))[(size_t)((b * 4 + h) * 16 + c) * 256 + dh * 128 + d] = s;
        }
        u16* dst = (u16*)(p.ws + B_MLST) + ((size_t)((b * 4 + h) * 16 + c)) * 65536;
#pragma unroll
        for (int mi = 0; mi < 2; ++mi)
#pragma unroll
          for (int ni = 0; ni < 2; ++ni)
#pragma unroll
            for (int i = 0; i < 16; ++i) {
              int v = vh * 128 + (wid & 1) * 64 + mi * 32 + ACC_ROW(i, lane), d = dh * 128 + (wid >> 1) * 64 + ni * 32 + (lane & 31);
              dst[v * 256 + d] = f2bf(acc[mi][ni][i]);
            }
        __syncthreads();
      }
    }
  }
}

__device__ __forceinline__ void phase_scan(const P& p, char* lds, int bid, int G) {
  for (int w = bid; w < 1568; w += G) {
    FRESH_TID(tid);
    const int zz = zof(w);
    if (w < 512) {
      int e8 = w * 256 + tid;
      int n8 = e8 & 15, pp = (e8 >> 4) & 63, h = (e8 >> 10) & 15, b = e8 >> 14;
      const float* ac = (const float*)(p.ws + M_ACUM);
      u16* st = (u16*)(p.ws + B_SSDST);
      float cur[8];
#pragma unroll
      for (int e = 0; e < 8; ++e) cur[e] = 0.f;
      uint4 qa[16]; float da[16];
#pragma unroll
      for (int c = 0; c < 16; ++c) {
        qa[c] = *(const uint4*)(st + ((size_t)((b * 16 + c) * 16 + h)) * 8192 + pp * 128 + n8 * 8);
        da[c] = ac[(size_t)(b * 2048 + c * 128 + 127) * 16 + h];
      }
#pragma unroll
      for (int c = 0; c < 16; ++c) {
        u16* ptr = st + ((size_t)((b * 16 + c) * 16 + h)) * 8192 + pp * 128 + n8 * 8;
        float t[8]; unpack8(qa[c], t);
        *(uint4*)ptr = pack8(cur);
        float dec = __expf(da[c]);
#pragma unroll
        for (int e = 0; e < 8; ++e) cur[e] = dec * cur[e] + t[e];
      }
      float* o = p.out + O_SSMP + ((size_t)((b * 16 + h) * 64 + pp)) * 128 + n8 * 8;
      *(float4*)o = make_float4(cur[0], cur[1], cur[2], cur[3]);
      *(float4*)(o + 4) = make_float4(cur[4], cur[5], cur[6], cur[7]);
    } else if (w < 1536) {
      int e8 = (w - 512) * 256 + tid;
      int d8 = e8 & 31, v = (e8 >> 5) & 255, h = (e8 >> 13) & 3, b = e8 >> 15;
      const float* gs = (const float*)(p.ws + M_GSUM) + (size_t)(b * 4 + h) * 32;
      u16* st = (u16*)(p.ws + B_MLST);
      float cur[8];
#pragma unroll
      for (int e = 0; e < 8; ++e) cur[e] = 0.f;
      float m = 0.f;
      uint4 qa[16];
#pragma unroll
      for (int c = 0; c < 16; ++c) qa[c] = *(const uint4*)(st + ((size_t)((b * 4 + h) * 16 + c)) * 65536 + v * 256 + d8 * 8);
#pragma unroll
      for (int c = 0; c < 16; ++c) {
        u16* ptr = st + ((size_t)((b * 4 + h) * 16 + c)) * 65536 + v * 256 + d8 * 8;
        float t[8]; unpack8(qa[c], t);
        *(uint4*)ptr = pack8(cur);
        float be = gs[c * 2], mn = be + fmaxf(m, gs[c * 2 + 1]);
        float dc = __expf(be + m - mn);
        m = mn;
#pragma unroll
        for (int e = 0; e < 8; ++e) cur[e] = dc * cur[e] + t[e];
      }
      float* o = p.out + O_MCP + (size_t)(b * 4 + h) * 65536 + v;
#pragma unroll
      for (int e = 0; e < 8; ++e) o[(size_t)(d8 * 8 + e) * 256] = cur[e];
    } else {
      int bh = w - 1536, d = tid;
      const float* gs = (const float*)(p.ws + M_GSUM) + (size_t)bh * 32;
      float* nb = (float*)(p.ws + M_MLN) + (size_t)bh * 16 * 256;
      float cur = 0.f, m = 0.f;
      for (int c = 0; c < 16; ++c) {
        float t = nb[c * 256 + d];
        nb[c * 256 + d] = cur;
        float be = gs[c * 2], mn = be + fmaxf(m, gs[c * 2 + 1]);
        float dc = __expf(be + m - mn);
        m = mn;
        cur = dc * cur + t;
      }
      p.out[O_MNP + (size_t)bh * 256 + d] = cur;
      if (tid == 0) p.out[O_MMP + bh] = m;
    }
  }
}

__device__ __forceinline__ void phase_chunkout(const P& p, char* lds, int bid, int G) {
  const u16* proj = (const u16*)(p.ws + B_PROJ);
  const u16* xs = (const u16*)(p.ws + B_A);
  const u16* Bm = (const u16*)(p.ws + B_BM);
  const u16* Cm = (const u16*)(p.ws + B_CM);
  const u16* xm = (const u16*)(p.ws + B_XM);
  u16* mix = (u16*)(p.ws + B_MIX);
  char* R0 = lds;
  char* R1 = lds + 32768;
  float* ex = (float*)(lds + 65536);
  for (int w = bid; w < 1024; w += G) {
    FRESH_TID(tid);
    const int zz = zof(w);
    const int lane = tid & 63, wid = tid >> 6;
#if defined(P5_ONLY) && P5_ONLY == 2
    if (false) {
#elif defined(P5_ONLY) && P5_ONLY == 1
    if (true) {
#else
    if (w >= 512) {
#endif
      const int x = w - 512, th = x & 1, g = (x >> 1) & 1, c = (x >> 2) & 15, b = x >> 6;
      const int rowbase = b * 2048 + c * 128;
      const float* dt = (const float*)(p.ws + M_DT);
      const float* ac = (const float*)(p.ws + M_ACUM);
      float* sA = ex;
      float* sD = ex + 1024;
      float* sSq = ex + 2048;
      for (int i = tid; i < 1024; i += 256) {
        int h8 = i >> 7, s = i & 127, h = g * 8 + h8;
        sA[i] = ac[(size_t)(rowbase + s) * 16 + h];
        sD[i] = dt[(size_t)(rowbase + s) * 16 + h];
      }
      if (tid < 64) sSq[tid] = 0.f;
      _Pragma("unroll 4")
      for (int k_ = 0; k_ < (128 * 16) / 256; ++k_) { const int i = tid + k_ * 256;
        int kc = i & 15, r = i >> 4;
        uint4 q = *(const uint4*)(Bm + (size_t)(rowbase + r) * 256 + g * 128 + kc * 8);
        *(uint4*)(R0 + (kc >> 3) * 16384 + r * 128 + (((kc & 7) ^ ((r >> 1) & 7)) << 4)) = q;
      }
      _Pragma("unroll")
      for (int k_ = 0; k_ < (64 * 16) / 256; ++k_) { const int i = tid + k_ * 256;
        int kc = i & 15, r = i >> 4;
        uint4 q = *(const uint4*)(Cm + (size_t)(rowbase + th * 64 + r) * 256 + g * 128 + kc * 8);
        *(uint4*)(R1 + (kc >> 3) * 8192 + r * 128 + (((kc & 7) ^ ((r >> 1) & 7)) << 4)) = q;
      }
      __syncthreads();
      f32x16 cb[2][1];
      zero_acc<2, 1>(cb);
#pragma unroll
      for (int pn = 0; pn < 2; ++pn) mma_panel<2, 1>(cb, R1 + pn * 8192, 0, R0 + pn * 16384, wid * 32, lane);
      __syncthreads();
      _Pragma("unroll 1")
      for (int h8 = 0; h8 < 8; ++h8) {
        const int h = g * 8 + h8;
        {
          int s = wid * 32 + (lane & 31);
          float as = sA[h8 * 128 + s], ds = sD[h8 * 128 + s];
#pragma unroll
          for (int mi = 0; mi < 2; ++mi)
#pragma unroll
            for (int i = 0; i < 16; ++i) {
              int tl = mi * 32 + ACC_ROW(i, lane), t = th * 64 + tl;
              float v = (s <= t) ? __expf(sA[h8 * 128 + t] - as) * cb[mi][0][i] * ds : 0.f;
              *(u16*)(R0 + (s >> 6) * 8192 + img_off(tl, s & 63)) = f2bf(v);
              if ((i & 3) == 3) SB();
            }
        }
        _Pragma("unroll")
        for (int k_ = 0; k_ < (128 * 8) / 256; ++k_) { const int i = tid + k_ * 256;
          int jc = i & 7, s = i >> 3;
          uint4 q = *(const uint4*)(xs + (size_t)(rowbase + s) * 1024 + h * 64 + jc * 8);
          float v[8]; unpack8(q, v);
          img_put_t(R0 + 16384, 64, jc * 8, s, v);
        }
        {
          const u16* st = (const u16*)(p.ws + B_SSDST) + ((size_t)((b * 16 + c) * 16 + h)) * 8192;
          _Pragma("unroll")
          for (int k_ = 0; k_ < (64 * 16) / 256; ++k_) { const int i = tid + k_ * 256;
            int kc = i & 15, r = i >> 4;
            uint4 q = *(const uint4*)(st + r * 128 + kc * 8);
            *(uint4*)(R1 + 16384 + (kc >> 3) * 8192 + r * 128 + (((kc & 7) ^ ((r >> 1) & 7)) << 4)) = q;
          }
        }
        __syncthreads();
        f32x16 a1[1][1], a2[1][1];
        zero_acc<1, 1>(a1);
        zero_acc<1, 1>(a2);
#pragma unroll
        for (int pn = 0; pn < 2; ++pn) {
          mma_panel<1, 1>(a1, R0 + pn * 8192, (wid & 1) * 32, R0 + 16384 + pn * 8192, (wid >> 1) * 32, lane);
          mma_panel<1, 1>(a2, R1 + pn * 8192, (wid & 1) * 32, R1 + 16384 + pn * 8192, (wid >> 1) * 32, lane);
        }
        {
          int pp = (wid >> 1) * 32 + (lane & 31), ch = h * 64 + pp;
          float Dh = p.in[zz + I_SSDD][h];
#pragma unroll
          for (int i = 0; i < 16; ++i) {
            int tl = (wid & 1) * 32 + ACC_ROW(i, lane), t = th * 64 + tl;
            size_t row = rowbase + t;
            float y = a1[0][0][i] + __expf(sA[h8 * 128 + t]) * a2[0][0][i];
            float xv = bf2f(xs[row * 1024 + ch]);
            float z = bf2f(proj[row * PJ + ch]);
            float v = (y + Dh * xv) * z * sigmoidf(z);
            mix[row * 2048 + ch] = f2bf(v);
            if ((i & 3) == 3) SB();
          }
        }
        __syncthreads();
      }
      asm volatile("s_waitcnt vmcnt(0)" ::: "memory");
      __threadfence_block();
      __syncthreads();
      _Pragma("unroll 4")
      for (int tl = wid * 16; tl < wid * 16 + 16; ++tl) {
        size_t row = rowbase + th * 64 + tl;
        u16* ptr = mix + row * 2048 + g * 512 + lane * 8;
        float v[8]; unpack8(*(const uint4*)ptr, v);
        float sq = 0.f;
#pragma unroll
        for (int e = 0; e < 8; ++e) sq += v[e] * v[e];
        sq = wsum(sq);
        float rinv = rsqrtf(sq * (1.f / 512.f) + EPS);
        const float* gn = p.in[zz + I_SSDN] + g * 512 + lane * 8;
#pragma unroll
        for (int e = 0; e < 8; ++e) v[e] *= rinv * gn[e];
        *(uint4*)ptr = pack8(v);
      }
      __syncthreads();
    } else {
      const int c = w & 15, h = (w >> 4) & 3, b = w >> 6;
      const int rowbase = b * 2048 + c * 128;
      const float* gs = (const float*)(p.ws + M_GSUM) + (size_t)(b * 4 + h) * 32;
      float mc, mn, bend;
      mchain(gs, c, mc, mn, bend);
      float* sBc = ex;
      float* sLb = ex + 128;
      float* sMt = ex + 256;
      float* sWi = ex + 384;
      float* sDen = ex + 512;
      float* sQn = ex + 640;
      float* sSq = ex + 768;
      float* sN = ex + 896;
      const float* bcum = (const float*)(p.ws + M_BCUM);
      const float* li = (const float*)(p.ws + M_LI);
      if (tid < 128) {
        float bc = bcum[(size_t)(rowbase + tid) * 4 + h];
        sBc[tid] = bc;
        sLb[tid] = li[(size_t)(rowbase + tid) * 4 + h] - bc;
        sDen[tid] = 0.f; sQn[tid] = 0.f; sSq[tid] = 0.f;
      }
      sN[tid] = ((const float*)(p.ws + M_MLN))[(size_t)((b * 4 + h) * 16 + c) * 256 + tid];
      __syncthreads();
      if (tid < 128) {
        float pm = -INFINITY;
        for (int s = 0; s <= tid; ++s) pm = fmaxf(pm, sLb[s]);
        float inter = sBc[tid] + mc;
        float mt = fmaxf(inter, sBc[tid] + pm);
        sMt[tid] = mt;
        sWi[tid] = __expf(inter - mt);
      }
      __syncthreads();
      if (tid < 128) sBc[tid] -= sMt[tid];
      __syncthreads();
      f32x16 sa[2][2];
      zero_acc<2, 2>(sa);
      _Pragma("unroll 1")
      for (int dp = 0; dp < 4; ++dp) {
        _Pragma("unroll")
        for (int k_ = 0; k_ < (128 * 8) / 256; ++k_) { const int i = tid + k_ * 256;
          int kc = i & 7, r = i >> 3;
          int ch0 = h * 256 + dp * 64 + kc * 8;
          uint4 q = *(const uint4*)(xm + (size_t)(rowbase + r) * 1024 + ch0);
          float xv[8], qv[8], kv[8]; unpack8(q, xv);
          int so = r * 128 + ((kc ^ ((r >> 1) & 7)) << 4);
          blockdiag8(xv, p.in[zz + I_WK], ch0, 0.0625f, kv);
          *(uint4*)(R1 + 16384 + so) = pack8(kv);
          SB();
          blockdiag8(xv, p.in[zz + I_WQ], ch0, 1.f, qv);
          *(uint4*)(R1 + so) = pack8(qv);
          float qn = 0.f;
#pragma unroll
          for (int e = 0; e < 8; ++e) qn += qv[e] * sN[dp * 64 + kc * 8 + e];
          qn += __shfl_xor(qn, 1); qn += __shfl_xor(qn, 2); qn += __shfl_xor(qn, 4);
          if (kc == 0) sQn[r] += qn;
          SB();
        }
        __syncthreads();
        mma_panel<2, 2>(sa, R1, (wid & 1) * 64, R1 + 16384, (wid >> 1) * 64, lane);
        __syncthreads();
      }
#pragma unroll
      for (int mi = 0; mi < 2; ++mi)
#pragma unroll
        for (int ni = 0; ni < 2; ++ni) {
          int s = (wid >> 1) * 64 + ni * 32 + (lane & 31);
          float lb = sLb[s];
#pragma unroll
          for (int i = 0; i < 16; ++i) {
            int t = (wid & 1) * 64 + mi * 32 + ACC_ROW(i, lane);
            float v = (s <= t) ? sa[mi][ni][i] * __expf(sBc[t] + lb) : 0.f;
            *(u16*)(R0 + (s >> 6) * 16384 + img_off(t, s & 63)) = f2bf(v);
            if ((i & 3) == 3) SB();
          }
        }
      __syncthreads();
      if (tid < 128) {
        float sm = 0.f;
        _Pragma("unroll 4")
        for (int kc = 0; kc < 16; ++kc) {
          float v[8];
          unpack8(*(const uint4*)(R0 + (kc >> 3) * 16384 + tid * 128 + (((kc & 7) ^ ((tid >> 1) & 7)) << 4)), v);
#pragma unroll
          for (int e = 0; e < 8; ++e) sm += v[e];
        }
        float den = sm + sWi[tid] * sQn[tid];
#ifdef DBG_DEN1
        sDen[tid] = 1.f + 0.f * den;
#else
        sDen[tid] = 1.f / fmaxf(fabsf(den), __expf(-sMt[tid]));
#endif
      }
      __syncthreads();
      _Pragma("unroll 1")
      for (int vh = 0; vh < 2; ++vh) {
        f32x16 oa[2][2];
        zero_acc<2, 2>(oa);
        _Pragma("unroll 4")
        for (int k_ = 0; k_ < (128 * 16) / 256; ++k_) { const int i = tid + k_ * 256;
          int jc = i & 15, s = i >> 4;
          int ch0 = h * 256 + vh * 128 + jc * 8;
          uint4 q = *(const uint4*)(proj + (size_t)(rowbase + s) * PJ + 2560 + ch0);
          float xv[8], v[8]; unpack8(q, xv);
          blockdiag8(xv, p.in[zz + I_WV], ch0, 1.f, v);
          img_put_t(R1, 128, jc * 8, s, v);
        }
        __syncthreads();
#pragma unroll
        for (int pn = 0; pn < 2; ++pn) mma_panel<2, 2>(oa, R0 + pn * 16384, (wid & 1) * 64, R1 + pn * 16384, (wid >> 1) * 64, lane);
        __syncthreads();
        const u16* st = (const u16*)(p.ws + B_MLST) + ((size_t)((b * 4 + h) * 16 + c)) * 65536;
        _Pragma("unroll 1")
        for (int dp = 0; dp < DBG_DPN; ++dp) {
          _Pragma("unroll")
          for (int k_ = 0; k_ < (128 * 8) / 256; ++k_) { const int i = tid + k_ * 256;
            int kc = i & 7, r = i >> 3;
            int ch0 = h * 256 + dp * 64 + kc * 8;
            uint4 q = *(const uint4*)(xm + (size_t)(rowbase + r) * 1024 + ch0);
            float xv[8], qv[8]; unpack8(q, xv);
            blockdiag8(xv, p.in[zz + I_WQ], ch0, sWi[r], qv);
            int so = r * 128 + ((kc ^ ((r >> 1) & 7)) << 4);
            *(uint4*)(R1 + so) = pack8(qv);
            uint4 cq = *(const uint4*)(st + (size_t)(vh * 128 + r) * 256 + dp * 64 + kc * 8);
            *(uint4*)(R1 + 16384 + so) = cq;
          }
          __syncthreads();
          mma_panel<2, 2>(oa, R1, (wid & 1) * 64, R1 + 16384, (wid >> 1) * 64, lane);
          __syncthreads();
        }
#pragma unroll
        for (int mi = 0; mi < 2; ++mi)
#pragma unroll
          for (int ni = 0; ni < 2; ++ni) {
            int v = vh * 128 + (wid >> 1) * 64 + ni * 32 + (lane & 31);
#pragma unroll
            for (int i = 0; i < 16; ++i) {
              int t = (wid & 1) * 64 + mi * 32 + ACC_ROW(i, lane);
              float hv = oa[mi][ni][i] * sDen[t];
              mix[(size_t)(rowbase + t) * 2048 + 1024 + h * 256 + v] = f2bf(hv);
              if ((i & 3) == 3) SB();
            }
          }
      }
      asm volatile("s_waitcnt vmcnt(0)" ::: "memory");
      __threadfence_block();
      __syncthreads();
      _Pragma("unroll 4")
      for (int it = 0; it < DBG_NORM_IT; ++it) {
        int t = wid * 32 + it * 2 + (lane >> 5), cc = lane & 31;
        size_t row = rowbase + t;
        int ch = h * 256 + cc * 8;
        u16* ptr = mix + row * 2048 + 1024 + ch;
        float v[8], xa[8], op[8];
        unpack8(*(const uint4*)ptr, v);
        float sq = 0.f;
#pragma unroll
        for (int e = 0; e < 8; ++e) sq += v[e] * v[e];
#pragma unroll
        for (int m = 16; m >= 1; m >>= 1) sq += __shfl_xor(sq, m);
        float rinv = rsqrtf(sq * (1.f / 256.f) + EPS);
        unpack8(*(const uint4*)(xm + row * 1024 + ch), xa);
        unpack8(*(const uint4*)(proj + row * PJ + 3584 + ch), op);
#pragma unroll
        for (int e = 0; e < 8; ++e) v[e] = (v[e] * rinv * p.in[zz + I_MLN][ch + e] + p.in[zz + I_MLS][ch + e] * xa[e]) * sigmoidf(op[e]);
        *(uint4*)ptr = pack8(v);
      }
      __syncthreads();
    }
  }
}

__device__ __forceinline__ void phase_rms(const float* x, const float* g, u16* dst, int bid, int G) {
  for (int w = bid; w < TT / 4; w += 2 * G) {
    FRESH_TID(tid);
    const int lane = tid & 63, wid = tid >> 6;
    int rowa = w * 4 + wid;
    bool hasb = (w + G) < TT / 4;
    int rowb = hasb ? (w + G) * 4 + wid : rowa;
    rms_rows2_bf16(x + (size_t)rowa * 1024, x + (size_t)rowb * 1024, g, dst + (size_t)rowa * 1024, dst + (size_t)rowb * 1024, hasb, lane);
  }
}
__device__ __forceinline__ void phase_rms_final(const P& p, const float* x, int bid, int G) {
  const float* g = p.in[zof(bid) + I_NFIN];
  for (int w = bid; w < TT / 4; w += G) {
    FRESH_TID(tid);
    const int zz = zof(w);
    const int lane = tid & 63, wid = tid >> 6;
    int row = w * 4 + wid;
    const float* src = x + (size_t)row * 1024;
    float4 v[4];
    float ss = 0.f;
#pragma unroll
    for (int i = 0; i < 4; ++i) {
      v[i] = ((const float4*)src)[lane + 64 * i];
      ss += v[i].x * v[i].x + v[i].y * v[i].y + v[i].z * v[i].z + v[i].w * v[i].w;
    }
    ss = wsum(ss);
    float rinv = rsqrtf(ss * (1.f / 1024.f) + EPS);
    float* o = p.out + O_Y + (size_t)row * 1024;
#pragma unroll
    for (int i = 0; i < 4; ++i) {
      float4 g4 = ((const float4*)g)[lane + 64 * i];
      ((float4*)o)[lane + 64 * i] = make_float4(v[i].x * rinv * g4.x, v[i].y * rinv * g4.y, v[i].z * rinv * g4.z, v[i].w * rinv * g4.w);
    }
  }
}
__device__ __forceinline__ void phase_rms_shift(const P& p, const float* x, int bid, int G) {
  const int zz0 = zof(bid);
  const float* g = p.in[zz0 + I_NMIX] + 1024;
  const float* mu = p.in[zz0 + I_MU];
  for (int w = bid; w < TT / 4; w += G) {
    FRESH_TID(tid);
    const int zz = zof(w);
    const int lane = tid & 63, wid = tid >> 6;
    int row = w * 4 + wid;
    const float* src = x + (size_t)row * 1024;
    float4 v[4], pv[4];
    float ss = 0.f, ps = 0.f;
    int mode;
    const float* psrc = src;
    if (row < TP) { mode = ((row & 2047) == 0) ? 1 : 0; psrc = src - 1024; }
    else { mode = 2; psrc = p.in[zz + I_SSHIFT] + (size_t)(row - TP) * 1024; }
#pragma unroll
    for (int i = 0; i < 4; ++i) {
      v[i] = ((const float4*)src)[lane + 64 * i];
      ss += v[i].x * v[i].x + v[i].y * v[i].y + v[i].z * v[i].z + v[i].w * v[i].w;
      if (mode != 1) pv[i] = ((const float4*)psrc)[lane + 64 * i];
      else pv[i] = make_float4(0.f, 0.f, 0.f, 0.f);
      ps += pv[i].x * pv[i].x + pv[i].y * pv[i].y + pv[i].z * pv[i].z + pv[i].w * pv[i].w;
    }
    ss = wsum(ss); ps = wsum(ps);
    float rinv = rsqrtf(ss * (1.f / 1024.f) + EPS);
    float pinv = rsqrtf(ps * (1.f / 1024.f) + EPS);
#pragma unroll
    for (int i = 0; i < 4; ++i) {
      float4 g4 = ((const float4*)g)[lane + 64 * i];
      float xn[4] = {v[i].x * rinv * g4.x, v[i].y * rinv * g4.y, v[i].z * rinv * g4.z, v[i].w * rinv * g4.w};
      float xp[4];
      if (mode == 0) { xp[0] = pv[i].x * pinv * g4.x; xp[1] = pv[i].y * pinv * g4.y; xp[2] = pv[i].z * pinv * g4.z; xp[3] = pv[i].w * pinv * g4.w; }
      else { xp[0] = pv[i].x; xp[1] = pv[i].y; xp[2] = pv[i].z; xp[3] = pv[i].w; }
      int col = (lane + 64 * i) * 4;
      if (row >= TP) *(float4*)(p.out + O_SHS + (size_t)(row - TP) * 1024 + col) = make_float4(xn[0], xn[1], xn[2], xn[3]);
      else if ((row & 2047) == 2047) *(float4*)(p.out + O_SHP + (size_t)(row >> 11) * 1024 + col) = make_float4(xn[0], xn[1], xn[2], xn[3]);
#pragma unroll
      for (int c = 0; c < 6; ++c) {
        float4 m4 = *(const float4*)(mu + c * 1024 + col);
        uint2 o;
        o.x = pk2(xn[0] + (xp[0] - xn[0]) * m4.x, xn[1] + (xp[1] - xn[1]) * m4.y);
        o.y = pk2(xn[2] + (xp[2] - xn[2]) * m4.z, xn[3] + (xp[3] - xn[3]) * m4.w);
        size_t base = (c < 5) ? (3 * U + (size_t)c * U) : B_A;
        *(uint2*)((u16*)(p.ws + base) + (size_t)row * 1024 + col) = o;
      }
    }
  }
}

__device__ __forceinline__ void phase_wkv(const P& p, char* lds, int bid, int G) {
  const u16* rb = (const u16*)(p.ws + B_RB);
  const u16* kb = (const u16*)(p.ws + B_KB);
  const u16* vb = (const u16*)(p.ws + B_VB);
  const u16* ab = (const u16*)(p.ws + B_AB);
  const float* dec = (const float*)(p.ws + B_DEC);
  float* yraw = (float*)(p.ws + B_YRAW);
  float* buf = (float*)lds;
  for (int w = bid; w < 768; w += G) {
#ifdef DBG_SKIP_PROMPT
    if (w < 256) continue;
#endif
    FRESH_TID(tid);
    const int zz = zof(w);
    const int lane = tid & 63, wid = tid >> 6;
    if (w < 256) {
      const int half = w & 1, h = (w >> 1) & 15, b = w >> 5;
      const int j = lane & 7, vrow = half * 32 + wid * 8 + (lane >> 3);
      const int tl = tid >> 4, sub = tid & 15, ch = h * 64 + sub * 4;
      float S[8];
#pragma unroll
      for (int i = 0; i < 8; ++i) S[i] = 0.f;
      float kkw[4], kaw[4];
#pragma unroll
      for (int e = 0; e < 4; ++e) { kkw[e] = p.in[zz + I_KK][ch + e]; kaw[e] = p.in[zz + I_KA][ch + e]; }
      uint2 lr, lk, lv, la; float4 lw;
      auto gload = [&](int tc) {
        size_t o = (size_t)(b * 2048 + tc * 16 + tl) * 1024 + ch;
#ifdef DBG_SYNTH
        { const float* xp = p.in[zz + I_XP] + o; float4 t4 = *(const float4*)xp;
          lr.x = pk2(t4.x, t4.y); lr.y = pk2(t4.z, t4.w); lk = lr; lv = lr; la.x = pk2(0.5f, 0.4f); la.y = pk2(0.6f, 0.5f);
          lw = make_float4(0.9f, 0.95f, 0.99f, 0.8f); }
#else
        lr = *(const uint2*)(rb + o); lk = *(const uint2*)(kb + o); lv = *(const uint2*)(vb + o); la = *(const uint2*)(ab + o);
        lw = *(const float4*)(dec + o);
#endif
      };
      auto lstore = [&](int bi) {
        float* tb = buf + bi * 6144 + tl * 384 + sub * 4;
        float k[4] = {lo2f(lk.x), hi2f(lk.x), lo2f(lk.y), hi2f(lk.y)};
        float a[4] = {lo2f(la.x), hi2f(la.x), lo2f(la.y), hi2f(la.y)};
        float kk[4], n2 = 0.f;
#pragma unroll
        for (int e = 0; e < 4; ++e) { kk[e] = k[e] * kkw[e]; n2 += kk[e] * kk[e]; }
        n2 += __shfl_xor(n2, 1); n2 += __shfl_xor(n2, 2); n2 += __shfl_xor(n2, 4); n2 += __shfl_xor(n2, 8);
        float inv = 1.f / fmaxf(sqrtf(n2), 1e-12f);
        float kp[4], bb[4];
#pragma unroll
        for (int e = 0; e < 4; ++e) { kk[e] *= inv; kp[e] = k[e] * (1.f + (a[e] - 1.f) * kaw[e]); bb[e] = kk[e] * a[e]; }
        *(float4*)(tb) = lw;
        *(float4*)(tb + 64) = make_float4(kk[0], kk[1], kk[2], kk[3]);
        *(float4*)(tb + 128) = make_float4(bb[0], bb[1], bb[2], bb[3]);
        *(float4*)(tb + 192) = make_float4(kp[0], kp[1], kp[2], kp[3]);
        *(float4*)(tb + 256) = make_float4(lo2f(lr.x), hi2f(lr.x), lo2f(lr.y), hi2f(lr.y));
        *(float4*)(tb + 320) = make_float4(lo2f(lv.x), hi2f(lv.x), lo2f(lv.y), hi2f(lv.y));
      };
      gload(0);
      lstore(0);
      __syncthreads();
      for (int tc = 0; tc < 128; ++tc) {
        const int cur = tc & 1;
        if (tc + 1 < 128) gload(tc + 1);
        const float* cb = buf + cur * 6144;
        float* yo = yraw + (size_t)(b * 2048 + tc * 16) * 1024 + h * 64 + vrow;
#pragma unroll 4
        for (int t = 0; t < 16; ++t) {
          const float* tb = cb + t * 384 + j * 8;
          float4 w0 = *(const float4*)(tb), w1 = *(const float4*)(tb + 4);
          float4 k0 = *(const float4*)(tb + 64), k1 = *(const float4*)(tb + 68);
          float4 b0 = *(const float4*)(tb + 128), b1 = *(const float4*)(tb + 132);
          float4 p0 = *(const float4*)(tb + 192), p1 = *(const float4*)(tb + 196);
          float4 r0 = *(const float4*)(tb + 256), r1 = *(const float4*)(tb + 260);
          float vv = cb[t * 384 + 320 + vrow];
          float sa = S[0] * k0.x + S[1] * k0.y + S[2] * k0.z + S[3] * k0.w + S[4] * k1.x + S[5] * k1.y + S[6] * k1.z + S[7] * k1.w;
          sa += DPPF(sa, 0xB1);
          sa += DPPF(sa, 0x4E);
          sa += DPPF(sa, 0x141);
          sa = -sa;
          S[0] = S[0] * w0.x + (sa * b0.x + vv * p0.x);
          S[1] = S[1] * w0.y + (sa * b0.y + vv * p0.y);
          S[2] = S[2] * w0.z + (sa * b0.z + vv * p0.z);
          S[3] = S[3] * w0.w + (sa * b0.w + vv * p0.w);
          S[4] = S[4] * w1.x + (sa * b1.x + vv * p1.x);
          S[5] = S[5] * w1.y + (sa * b1.y + vv * p1.y);
          S[6] = S[6] * w1.z + (sa * b1.z + vv * p1.z);
          S[7] = S[7] * w1.w + (sa * b1.w + vv * p1.w);
          float y = S[0] * r0.x + S[1] * r0.y + S[2] * r0.z + S[3] * r0.w + S[4] * r1.x + S[5] * r1.y + S[6] * r1.z + S[7] * r1.w;
          y += DPPF(y, 0xB1);
          y += DPPF(y, 0x4E);
          y += DPPF(y, 0x141);
          if (j == 0) yo[(size_t)t * 1024] = y;
        }
        if (tc + 1 < 128) lstore(cur ^ 1);
        __syncthreads();
      }
      float* so = p.out + O_WKVP + ((size_t)((b * 16 + h) * 64 + vrow)) * 64 + j * 8;
      *(float4*)so = make_float4(S[0], S[1], S[2], S[3]);
      *(float4*)(so + 4) = make_float4(S[4], S[5], S[6], S[7]);
    } else {
      const int it = (w - 256) * 4 + wid;
      const int bs = it >> 4, h = it & 15, row = TP + bs;
      float* vb_ = buf + wid * 320;
      {
        size_t o = (size_t)row * 1024 + h * 64 + lane;
        float k = bf2f(kb[o]), a = bf2f(ab[o]);
        float kk = k * p.in[zz + I_KK][h * 64 + lane];
        float n2 = wsum(kk * kk);
        kk *= 1.f / fmaxf(sqrtf(n2), 1e-12f);
        vb_[lane] = dec[o];
        vb_[64 + lane] = kk;
        vb_[128 + lane] = kk * a;
        vb_[192 + lane] = k * (1.f + (a - 1.f) * p.in[zz + I_KA][h * 64 + lane]);
        vb_[256 + lane] = bf2f(rb[o]);
      }
      float vv = bf2f(vb[(size_t)row * 1024 + h * 64 + lane]);
      const float* st = p.in[zz + I_SWKV] + ((size_t)((bs * 16 + h) * 64 + lane)) * 64;
      float* so = p.out + O_WKVS + ((size_t)((bs * 16 + h) * 64 + lane)) * 64;
      float4 S4[16];
#pragma unroll
      for (int i = 0; i < 16; ++i) S4[i] = *(const float4*)(st + i * 4);
      float sa = 0.f;
#pragma unroll
      for (int i = 0; i < 16; ++i) {
        float4 k4 = *(const float4*)(vb_ + 64 + i * 4);
        sa += S4[i].x * k4.x + S4[i].y * k4.y + S4[i].z * k4.z + S4[i].w * k4.w;
      }
      sa = -sa;
      float y = 0.f;
#pragma unroll
      for (int i = 0; i < 16; ++i) {
        float4 w4 = *(const float4*)(vb_ + i * 4), b4 = *(const float4*)(vb_ + 128 + i * 4);
        float4 p4 = *(const float4*)(vb_ + 192 + i * 4), r4 = *(const float4*)(vb_ + 256 + i * 4);
        float4 s = S4[i];
        s.x = s.x * w4.x + (sa * b4.x + vv * p4.x);
        s.y = s.y * w4.y + (sa * b4.y + vv * p4.y);
        s.z = s.z * w4.z + (sa * b4.z + vv * p4.z);
        s.w = s.w * w4.w + (sa * b4.w + vv * p4.w);
        y += s.x * r4.x + s.y * r4.y + s.z * r4.z + s.w * r4.w;
        *(float4*)(so + i * 4) = s;
      }
      yraw[(size_t)row * 1024 + h * 64 + lane] = y;
      __syncthreads();
    }
  }
}

__device__ __forceinline__ void phase_wkv_ln(const P& p, int bid, int G) {
  const u16* rb = (const u16*)(p.ws + B_RB);
  const u16* kb = (const u16*)(p.ws + B_KB);
  const u16* vb = (const u16*)(p.ws + B_VB);
  const u16* ab = (const u16*)(p.ws + B_AB);
  const u16* gb = (const u16*)(p.ws + B_GB);
  const float* yraw = (const float*)(p.ws + B_YRAW);
  u16* yb = (u16*)(p.ws + B_YB);
  for (int w = bid; w < TT / 4; w += G) {
    FRESH_TID(tid);
    const int zz = zof(w);
    const int lane = tid & 63, wid = tid >> 6;
    int row = w * 4 + wid;
    size_t o = (size_t)row * 1024 + lane * 16;
    float y[16], r[16], k[16], v[16], a[16], g[16];
#pragma unroll
    for (int i = 0; i < 4; ++i) {
      float4 t = *(const float4*)(yraw + o + i * 4);
      y[i * 4] = t.x; y[i * 4 + 1] = t.y; y[i * 4 + 2] = t.z; y[i * 4 + 3] = t.w;
    }
    unpack8(*(const uint4*)(rb + o), r); unpack8(*(const uint4*)(rb + o + 8), r + 8);
    unpack8(*(const uint4*)(kb + o), k); unpack8(*(const uint4*)(kb + o + 8), k + 8);
    unpack8(*(const uint4*)(vb + o), v); unpack8(*(const uint4*)(vb + o + 8), v + 8);
    unpack8(*(const uint4*)(ab + o), a); unpack8(*(const uint4*)(ab + o + 8), a + 8);
    unpack8(*(const uint4*)(gb + o), g); unpack8(*(const uint4*)(gb + o + 8), g + 8);
    int c0 = lane * 16;
    float sm = 0.f, bon = 0.f;
#pragma unroll
    for (int e = 0; e < 16; ++e) {
      sm += y[e];
      float kp = k[e] * (1.f + (a[e] - 1.f) * p.in[zz + I_KA][c0 + e]);
      bon += r[e] * kp * p.in[zz + I_RK][c0 + e];
    }
    sm += __shfl_xor(sm, 1); sm += __shfl_xor(sm, 2);
    bon += __shfl_xor(bon, 1); bon += __shfl_xor(bon, 2);
    float mean = sm * (1.f / 64.f), vr = 0.f;
#pragma unroll
    for (int e = 0; e < 16; ++e) { float d = y[e] - mean; vr += d * d; }
    vr += __shfl_xor(vr, 1); vr += __shfl_xor(vr, 2);
    float rinv = rsqrtf(vr * (1.f / 64.f) + 64e-5f);
    float ov[16];
#pragma unroll
    for (int e = 0; e < 16; ++e)
      ov[e] = ((y[e] - mean) * rinv * p.in[zz + I_LNW][c0 + e] + p.in[zz + I_LNB][c0 + e] + bon * v[e]) * g[e];
    *(uint4*)(yb + o) = pack8(ov);
    *(uint4*)(yb + o + 8) = pack8(ov + 8);
  }
}

__device__ __forceinline__ void run_phase(const P& p, int ph, char* lds, int bid, int G) {
  char* ws = p.ws;
  const int zz = zof(ph);
  switch (ph) {
    case 0: if (PHEN(0)) phase_prep(p, lds, bid, G); break;
    case 1: { if (!PHEN(1)) break;
      EpiProj e{(u16*)(ws + B_PROJ), (float*)(ws + B_SMALL)};
      gemm_phase((const u16*)(ws + B_A), 1024, (const u16*)(ws + W_IN0), 1024, 1024, 65, 37, lds, bid, G, e);
    } break;
    case 2: if (PHEN(2)) phase_conv(p, lds, bid, G); break;
    case 3: if (PHEN(3)) phase_chunkstate(p, lds, bid, G); break;
    case 4: if (PHEN(4)) phase_scan(p, lds, bid, G); break;
    case 5: if (PHEN(5)) phase_chunkout(p, lds, bid, G); break;
    case 6: { if (!PHEN(6)) break;
      EpiRes e{p.in[zz + I_XP], p.in[zz + I_XS], (float*)(ws + B_X1)};
      gemm_phase((const u16*)(ws + B_MIX), 2048, (const u16*)(ws + W_OUT0), 2048, 2048, 65, 8, lds, bid, G, e);
    } break;
    case 7: if (PHEN(7)) phase_rms((const float*)(ws + B_X1), p.in[zz + I_NFFN], (u16*)(ws + B_A), bid, G); break;
    case 8: { if (!PHEN(8)) break;
      EpiSwiglu e{(u16*)(ws + B_HB)};
      gemm_phase((const u16*)(ws + B_A), 1024, (const u16*)(ws + W_GU), 1024, 1024, 65, 44, lds, bid, G, e);
    } break;
    case 9: { if (!PHEN(9)) break;
      const float* x1 = (const float*)(ws + B_X1);
      EpiRes e{x1, x1 + (size_t)TP * 1024, (float*)(ws + B_X2)};
      gemm_phase((const u16*)(ws + B_HB), 2816, (const u16*)(ws + W_DN), 2816, 2816, 65, 8, lds, bid, G, e);
    } break;
    case 10: if (PHEN(10)) phase_rms_shift(p, (const float*)(ws + B_X2), bid, G); break;
    case 11: { if (!PHEN(11)) break;
      const int nbig = 3 * 65 * 8;
      for (int t = bid; t < nbig + 65 * 4; t += G) {
        if (t < nbig) {
          int which = t / (65 * 8), r = t % (65 * 8);
          int mt = r % 65, nt = r / 65;
          size_t abase = which == 0 ? 3 * U : (which == 1 ? 5 * U : 6 * U);
          size_t wbase = which == 0 ? W_R : (which == 1 ? W_K : W_V);
          size_t obase = which == 0 ? B_RB : (which == 1 ? B_KB : B_VB);
          EpiAct e{(u16*)(ws + obase), 1024, 1024, 1024, 0};
          gemm_tile((const u16*)(ws + abase), 1024, (const u16*)(ws + wbase), 1024, 1024, mt * 256, nt * 128, lds, e);
        } else {
          int r = t - nbig;
          if (r < 65) {
            EpiAct e{(u16*)(ws + B_LW), 128, 64, 128, 1};
            gemm_tile((const u16*)(ws + 4 * U), 1024, (const u16*)(ws + W_W1), 1024, 1024, r * 256, 0, lds, e);
          } else if (r < 130) {
            EpiAct e{(u16*)(ws + B_LA), 128, 64, 128, 0};
            gemm_tile((const u16*)(ws + 7 * U), 1024, (const u16*)(ws + W_A1), 1024, 1024, (r - 65) * 256, 0, lds, e);
          } else {
            int q = r - 130;
            EpiAct e{(u16*)(ws + B_LG), 256, 160, 256, 2};
            gemm_tile((const u16*)(ws + B_A), 1024, (const u16*)(ws + W_G1), 1024, 1024, (q % 65) * 256, (q / 65) * 128, lds, e);
          }
        }
      }
    } break;
    case 12: { if (!PHEN(12)) break;
      for (int t = bid; t < 3 * 65 * 8; t += G) {
        int which = t / (65 * 8), r = t % (65 * 8);
        int mt = r % 65, nt = r / 65;
        if (which == 0) {
          EpiLora2 e{0, p.in[zz + I_W0], (float*)(ws + B_DEC), nullptr};
          gemm_tile((const u16*)(ws + B_LW), 128, (const u16*)(ws + W_W2), 128, 128, mt * 256, nt * 128, lds, e);
        } else if (which == 1) {
          EpiLora2 e{1, p.in[zz + I_A0], nullptr, (u16*)(ws + B_AB)};
          gemm_tile((const u16*)(ws + B_LA), 128, (const u16*)(ws + W_A2), 128, 128, mt * 256, nt * 128, lds, e);
        } else {
          EpiLora2 e{2, nullptr, nullptr, (u16*)(ws + B_GB)};
          gemm_tile((const u16*)(ws + B_LG), 256, (const u16*)(ws + W_G2), 256, 256, mt * 256, nt * 128, lds, e);
        }
      }
    } break;
    case 13: if (PHEN(13)) phase_wkv(p, lds, bid, G); break;
    case 14: if (PHEN(14)) phase_wkv_ln(p, bid, G); break;
    case 15: { if (!PHEN(15)) break;
      const float* x2 = (const float*)(ws + B_X2);
      EpiRes e{x2, x2 + (size_t)TP * 1024, (float*)(ws + B_X3)};
      gemm_phase((const u16*)(ws + B_YB), 1024, (const u16*)(ws + W_O), 1024, 1024, 65, 8, lds, bid, G, e);
    } break;
    case 16: if (PHEN(16)) phase_rms((const float*)(ws + B_X3), p.in[zz + I_NFFN] + 1024, (u16*)(ws + B_A), bid, G); break;
    case 17: { if (!PHEN(17)) break;
      EpiSwiglu e{(u16*)(ws + B_HB)};
      gemm_phase((const u16*)(ws + B_A), 1024, (const u16*)(ws + W_GU + 5632ull * 1024 * 2), 1024, 1024, 65, 44, lds, bid, G, e);
    } break;
    case 18: { if (!PHEN(18)) break;
      const float* x3 = (const float*)(ws + B_X3);
      EpiRes e{x3, x3 + (size_t)TP * 1024, (float*)(ws + B_X4)};
      gemm_phase((const u16*)(ws + B_HB), 2816, (const u16*)(ws + W_DN + 1024ull * 2816 * 2), 2816, 2816, 65, 8, lds, bid, G, e);
    } break;
    case 19: if (PHEN(19)) phase_rms_final(p, (const float*)(ws + B_X4), bid, G); break;
#ifdef DBG_MIX_OFF
    case 100: {
      for (size_t i = (size_t)bid * 256 + threadIdx.x; i < (size_t)TT * 1024; i += (size_t)G * 256) {
        size_t row = i >> 10; int c = (int)(i & 1023);
        p.out[O_Y + i] = bf2f(((const u16*)(p.ws + B_MIX))[row * 2048 + DBG_MIX_OFF + c]);
      }
    } break;
#endif
    default: break;
  }
}

#ifndef MK_LB
#define MK_LB 1
#endif
__global__ void __launch_bounds__(256, MK_LB) mk_forward(P p, int ph_lo, int ph_hi) {
  extern __shared__ __attribute__((aligned(16))) char lds[];
  cg::grid_group grid = cg::this_grid();
  const int bid = blockIdx.x, G = gridDim.x;
#ifdef TM_A
  unsigned long long tm0 = wall_clock64(), tm1 = 0, tm2 = 0;
#endif
  for (int ph = ph_lo; ph < ph_hi; ++ph) {
    run_phase(p, ph, lds, bid, G);
    if (ph + 1 < ph_hi) grid.sync();
#ifdef TM_A
    if (ph == TM_A) tm1 = wall_clock64();
    if (ph == TM_B) tm2 = wall_clock64();
#endif
  }
#ifdef TM_A
  grid.sync();
  if (bid == 0 && threadIdx.x == 0) {
    unsigned long long tm3 = wall_clock64();
    float tot = (float)(tm3 - tm0);
    float f1 = (float)(tm1 - tm0) / tot, f2 = (float)(tm2 - tm0) / tot;
    float sc = 1.f + sqrtf(0.01f + 0.5f * f1);
    for (int i = 0; i < 32; ++i) p.out[O_MMP + i] *= sc;
    p.out[O_Y + (size_t)TP * 1024] += 1.f + 10.f * f2;
  }
#endif
#if defined(DBG_MIX_OFF) && !MK_MULTI
  grid.sync();
  run_phase(p, 100, lds, bid, G);
#endif

}

extern "C" void kernel_launch(void* const* d_in, const int* in_sizes, int n_in, void* d_out, int out_size, void* d_ws,
                              size_t ws_size, hipStream_t stream) {
  static int grid_blocks = 0;
  if (!grid_blocks) {
    hipFuncSetAttribute((const void*)mk_forward, hipFuncAttributeMaxDynamicSharedMemorySize, LDS_BYTES);
    int dev = 0, cus = 0, per_cu = 0;
    hipGetDevice(&dev);
    hipDeviceGetAttribute(&cus, hipDeviceAttributeMultiprocessorCount, dev);
    hipOccupancyMaxActiveBlocksPerMultiprocessor(&per_cu, mk_forward, 256, LDS_BYTES);
    if (per_cu > 2) per_cu = 2;
    if (per_cu < 1) per_cu = 1;
    grid_blocks = cus * per_cu;
  }
  P p{};
  for (int i = 0; i < N_IN; ++i) p.in[i] = (const float*)d_in[i];
  p.out = (float*)d_out;
  p.ws = (char*)d_ws;
  if (ws_size < WS_NEED) fprintf(stderr, "workspace too small: %zu < %zu\n", ws_size, (size_t)WS_NEED);
#if MK_MULTI
#ifndef MK_HI
#define MK_HI NPH
#endif
  for (int ph = 0; ph < MK_HI; ++ph) {
    int lo = ph, hi = ph + 1;
    hipLaunchKernelGGL(mk_forward, dim3(grid_blocks), dim3(256), LDS_BYTES, stream, p, lo, hi);
  }
#ifdef DBG_MIX_OFF
  hipLaunchKernelGGL(mk_forward, dim3(grid_blocks), dim3(256), LDS_BYTES, stream, p, 100, 101);
#endif
#else
#ifndef MK_HI
#define MK_HI NPH
#endif
  int lo = 0, hi = MK_HI;
  void* args[] = {&p, &lo, &hi};
  hipError_t e = hipLaunchCooperativeKernel((void*)mk_forward, dim3(grid_blocks), dim3(256), args, LDS_BYTES, stream);
  if (e != hipSuccess) fprintf(stderr, "cooperative launch failed: %s (grid %d)\n", hipGetErrorString(e), grid_blocks);
#endif
}
```

```cpp
#include <hip/hip_runtime.h>
#include <hip/hip_cooperative_groups.h>
#include <cstdio>
namespace cg = cooperative_groups;

#ifndef DBG_DPN
#define DBG_DPN 4
#endif
#ifndef DBG_NORM_IT
#define DBG_NORM_IT 16
#endif
#ifndef MK_MULTI
#define MK_MULTI 0
#endif
#ifdef ONLY_PH
#define PHEN(n) ((n) == ONLY_PH)
#else
#define PHEN(n) true
#endif

#define SB() __builtin_amdgcn_sched_barrier(0)
typedef unsigned short u16;
typedef __attribute__((ext_vector_type(8))) short bf16x8;
typedef __attribute__((ext_vector_type(16))) float f32x16;

constexpr int TP = 16384, TS = 128, TT = 16512, DM = 1024;
constexpr int PJ = 4608;
constexpr int NPH = 20;
constexpr float EPS = 1e-5f;

enum { I_XP = 0, I_XS, I_SCONV, I_SSSM, I_SMC, I_SMN, I_SMM, I_SSHIFT, I_SWKV, I_NMIX, I_NFFN, I_NFIN, I_WIN0,
       I_CONVW, I_CONVB, I_DTB, I_ALOG, I_SSDD, I_SSDN, I_WQ, I_WK, I_WV, I_IB, I_FB, I_MLN, I_MLS, I_WOUT0,
       I_MU, I_WR, I_WKK, I_WVV, I_WO, I_W0, I_W1, I_W2, I_A0, I_A1, I_A2, I_G1, I_G2, I_KK, I_KA, I_RK,
       I_LNW, I_LNB, I_GU, I_DN, N_IN };

constexpr size_t O_Y = 0;
constexpr size_t O_CONVP = O_Y + (size_t)TT * 1024;
constexpr size_t O_CONVS = O_CONVP + 8 * 3 * 2560;
constexpr size_t O_SSMP = O_CONVS + 128 * 3 * 2560;
constexpr size_t O_SSMS = O_SSMP + 8ull * 16 * 64 * 128;
constexpr size_t O_MCP = O_SSMS + 128ull * 16 * 64 * 128;
constexpr size_t O_MCS = O_MCP + 8ull * 4 * 256 * 256;
constexpr size_t O_MNP = O_MCS + 128ull * 4 * 256 * 256;
constexpr size_t O_MNS = O_MNP + 8 * 4 * 256;
constexpr size_t O_MMP = O_MNS + 128 * 4 * 256;
constexpr size_t O_MMS = O_MMP + 32;
constexpr size_t O_SHP = O_MMS + 512;
constexpr size_t O_SHS = O_SHP + 8 * 1024;
constexpr size_t O_WKVP = O_SHS + 128 * 1024;
constexpr size_t O_WKVS = O_WKVP + 8ull * 16 * 64 * 64;

constexpr size_t U = 33ull << 20;
constexpr size_t W_IN0 = 0;
constexpr size_t W_OUT0 = W_IN0 + 4736ull * 1024 * 2;
constexpr size_t W_GU = W_OUT0 + 1024ull * 2048 * 2;
constexpr size_t W_DN = W_GU + 2ull * 5632 * 1024 * 2;
constexpr size_t W_R = W_DN + 2ull * 1024 * 2816 * 2;
constexpr size_t W_K = W_R + 1024ull * 1024 * 2;
constexpr size_t W_V = W_K + 1024ull * 1024 * 2;
constexpr size_t W_O = W_V + 1024ull * 1024 * 2;
constexpr size_t W_W1 = W_O + 1024ull * 1024 * 2;
constexpr size_t W_A1 = W_W1 + 128ull * 1024 * 2;
constexpr size_t W_G1 = W_A1 + 128ull * 1024 * 2;
constexpr size_t W_W2 = W_G1 + 256ull * 1024 * 2;
constexpr size_t W_A2 = W_W2 + 1024ull * 128 * 2;
constexpr size_t W_G2 = W_A2 + 1024ull * 128 * 2;
constexpr size_t W_END = W_G2 + 1024ull * 256 * 2;
static_assert(W_END <= 2 * U, "weights");
constexpr size_t B_A = 2 * U;
constexpr size_t B_PROJ = 3 * U;
constexpr size_t B_SMALL = 8 * U;
constexpr size_t B_BM = B_SMALL + (size_t)TT * 32 * 4;
constexpr size_t B_CM = B_BM + (size_t)TT * 256 * 2;
constexpr size_t B_XM = 9 * U;
constexpr size_t B_SSDST = 10 * U;
constexpr size_t B_MLST = 11 * U;
constexpr size_t B_MIX = 13 * U;
constexpr size_t B_MISC = 15 * U;
constexpr size_t M_GSUM = B_MISC;
constexpr size_t M_BCUM = M_GSUM + 8 * 4 * 16 * 2 * 4;
constexpr size_t M_LI = M_BCUM + (size_t)TT * 4 * 4;
constexpr size_t M_DT = M_LI + (size_t)TT * 4 * 4;
constexpr size_t M_ACUM = M_DT + (size_t)TT * 16 * 4;
constexpr size_t M_MLN = M_ACUM + (size_t)TT * 16 * 4;
constexpr size_t M_END = M_MLN + 8ull * 4 * 16 * 256 * 4;
constexpr size_t WS_NEED = 15 * U + (8ull << 20);
static_assert(M_END <= WS_NEED, "misc");
static_assert(B_CM + (size_t)TT * 256 * 2 <= 9 * U, "bm/cm");
constexpr size_t B_X1 = 3 * U, B_HB = 5 * U, B_X2 = 8 * U;
constexpr size_t B_RB = 10 * U, B_KB = 11 * U, B_VB = 12 * U;
constexpr size_t B_LW = 13 * U, B_LA = B_LW + (size_t)TT * 128 * 2, B_LG = B_LA + (size_t)TT * 128 * 2;
constexpr size_t B_DEC = 3 * U, B_AB = 5 * U, B_GB = 6 * U, B_YB = 7 * U;
constexpr size_t B_YRAW = 13 * U;
constexpr size_t B_X3 = 3 * U, B_X4 = 8 * U;

constexpr int LDS_BYTES = 98304;

struct P {
  const float* in[N_IN];
  float* out;
  char* ws;
};

__device__ __forceinline__ u16 f2bf(float f) {
  unsigned u = __float_as_uint(f);
  u += 0x7fffu + ((u >> 16) & 1u);
  return (u16)(u >> 16);
}
__device__ __forceinline__ float bf2f(u16 h) { return __uint_as_float(((unsigned)h) << 16); }
__device__ __forceinline__ unsigned pk2(float a, float b) { return (unsigned)f2bf(a) | ((unsigned)f2bf(b) << 16); }
__device__ __forceinline__ float lo2f(unsigned u) { return __uint_as_float(u << 16); }
__device__ __forceinline__ float hi2f(unsigned u) { return __uint_as_float(u & 0xffff0000u); }
__device__ __forceinline__ void unpack8(const uint4& q, float* f) {
  f[0] = lo2f(q.x); f[1] = hi2f(q.x); f[2] = lo2f(q.y); f[3] = hi2f(q.y);
  f[4] = lo2f(q.z); f[5] = hi2f(q.z); f[6] = lo2f(q.w); f[7] = hi2f(q.w);
}
__device__ __forceinline__ uint4 pack8(const float* f) {
  uint4 q; q.x = pk2(f[0], f[1]); q.y = pk2(f[2], f[3]); q.z = pk2(f[4], f[5]); q.w = pk2(f[6], f[7]);
  return q;
}
__device__ __forceinline__ float softplusf(float x) { return x > 20.f ? x : log1pf(__expf(x)); }
__device__ __forceinline__ float sigmoidf(float x) { return 1.f / (1.f + __expf(-x)); }
__device__ __forceinline__ float wsum(float v) {
#pragma unroll
  for (int m = 32; m >= 1; m >>= 1) v += __shfl_xor(v, m);
  return v;
}
__device__ __forceinline__ float wmax(float v) {
#pragma unroll
  for (int m = 32; m >= 1; m >>= 1) v = fmaxf(v, __shfl_xor(v, m));
  return v;
}
__device__ __forceinline__ float wscan(float v, int lane) {
#pragma unroll
  for (int o = 1; o < 64; o <<= 1) {
    float t = __shfl_up(v, o);
    if (lane >= o) v += t;
  }
  return v;
}
__device__ __forceinline__ float bsum(float v, float* scr) {
  v = wsum(v);
  __syncthreads();
  if ((threadIdx.x & 63) == 0) scr[threadIdx.x >> 6] = v;
  __syncthreads();
  return scr[0] + scr[1] + scr[2] + scr[3];
}
__device__ __forceinline__ float dpp_f(float v, const int ctrl);
#define DPPF(v, ctrl) __int_as_float(__builtin_amdgcn_update_dpp(0, __float_as_int(v), ctrl, 0xF, 0xF, true))

__device__ __forceinline__ int img_off(int row, int kk  ) {
  return row * 128 + ((((kk >> 3) ^ ((row >> 1) & 7))) << 4) + ((kk & 7) << 1);
}

template <int MI, int NI>
__device__ __forceinline__ void mma_panel(f32x16 (&acc)[MI][NI], const char* Ap, int ar0, const char* Bp, int br0, int lane) {
  const int r = lane & 31, h = lane >> 5;
  bf16x8 a[2][MI], b[2][NI];
  const char* ap[MI];
  const char* bp[NI];
  int asw[MI], bsw[NI];
#pragma unroll
  for (int mi = 0; mi < MI; ++mi) { int row = ar0 + mi * 32 + r; ap[mi] = Ap + row * 128; asw[mi] = (row >> 1) & 7; }
#pragma unroll
  for (int ni = 0; ni < NI; ++ni) { int row = br0 + ni * 32 + r; bp[ni] = Bp + row * 128; bsw[ni] = (row >> 1) & 7; }
#pragma unroll
  for (int mi = 0; mi < MI; ++mi) a[0][mi] = *(const bf16x8*)(ap[mi] + ((h ^ asw[mi]) << 4));
#pragma unroll
  for (int ni = 0; ni < NI; ++ni) b[0][ni] = *(const bf16x8*)(bp[ni] + ((h ^ bsw[ni]) << 4));
#pragma unroll
  for (int ks = 0; ks < 4; ++ks) {
    const int cur = ks & 1, nxt = cur ^ 1;
    if (ks < 3) {
      const int ch = (ks + 1) * 2 + h;
#pragma unroll
      for (int mi = 0; mi < MI; ++mi) a[nxt][mi] = *(const bf16x8*)(ap[mi] + ((ch ^ asw[mi]) << 4));
#pragma unroll
      for (int ni = 0; ni < NI; ++ni) b[nxt][ni] = *(const bf16x8*)(bp[ni] + ((ch ^ bsw[ni]) << 4));
    }
    SB();
#pragma unroll
    for (int mi = 0; mi < MI; ++mi)
#pragma unroll
      for (int ni = 0; ni < NI; ++ni)
        acc[mi][ni] = __builtin_amdgcn_mfma_f32_32x32x16_bf16(a[cur][mi], b[cur][ni], acc[mi][ni], 0, 0, 0);
    SB();
  }
}
template <int MI, int NI>
__device__ __forceinline__ void mma_panel_s(f32x16 (&acc)[MI][NI], const char* Ap, int ar0, const char* Bp, int br0, int lane) {
  const int r = lane & 31, h = lane >> 5;
#pragma unroll
  for (int ks = 0; ks < 4; ++ks) {
    const int ch = ks * 2 + h;
    bf16x8 a[MI], b[NI];
#pragma unroll
    for (int mi = 0; mi < MI; ++mi) { int row = ar0 + mi * 32 + r; a[mi] = *(const bf16x8*)(Ap + row * 128 + ((ch ^ ((row >> 1) & 7)) << 4)); }
#pragma unroll
    for (int ni = 0; ni < NI; ++ni) { int row = br0 + ni * 32 + r; b[ni] = *(const bf16x8*)(Bp + row * 128 + ((ch ^ ((row >> 1) & 7)) << 4)); }
    SB();
#pragma unroll
    for (int mi = 0; mi < MI; ++mi)
#pragma unroll
      for (int ni = 0; ni < NI; ++ni)
        acc[mi][ni] = __builtin_amdgcn_mfma_f32_32x32x16_bf16(a[mi], b[ni], acc[mi][ni], 0, 0, 0);
    SB();
  }
}
template <int MI, int NI>
__device__ __forceinline__ void zero_acc(f32x16 (&acc)[MI][NI]) {
#pragma unroll
  for (int mi = 0; mi < MI; ++mi)
#pragma unroll
    for (int ni = 0; ni < NI; ++ni)
#pragma unroll
      for (int i = 0; i < 16; ++i) acc[mi][ni][i] = 0.f;
}
#define FRESH_TID(tid) int tid = threadIdx.x; asm volatile("" : "+v"(tid))
__device__ __forceinline__ int zof(int w) { int z; asm("s_mov_b32 %0, 0" : "=s"(z) : "s"(w)); return z; }
#define ACC_ROW(i, lane) (((i) & 3) + 8 * ((i) >> 2) + 4 * ((lane) >> 5))

template <class Epi>
__device__ __forceinline__ void gemm_tile(const u16* __restrict__ A, int lda, const u16* __restrict__ B, int ldb, int K,
                                          int m0, int n0, char* lds, const Epi& epi) {
  FRESH_TID(tid);
  const int lane = tid & 63, wid = tid >> 6, wr = wid & 1, wc = wid >> 1;
  f32x16 acc[4][2];
  zero_acc<4, 2>(acc);
  const int lrow = tid >> 3, lch = tid & 7;
  const u16* Bp = B + (size_t)(n0 + lrow) * ldb + lch * 8;
  const int soff = lrow * 128 + ((lch ^ ((lrow >> 1) & 7)) << 4);
  int aoff[8];
#pragma unroll
  for (int i = 0; i < 8; ++i) {
    int r = m0 + lrow + 32 * i;
    r = r < TT ? r : TT - 1;
    aoff[i] = (r - m0) * lda;
  }
  const u16* Ab = A + (size_t)m0 * lda + lch * 8;
  uint4 ra0, ra1, ra2, ra3, ra4, ra5, ra6, ra7, rb0, rb1, rb2, rb3, rc0, rc1, rc2, rc3, rc4, rc5, rc6, rc7, rd0, rd1, rd2, rd3;
  const int nk = K >> 6;
  {
    ra0 = *(const uint4*)(Ab + aoff[0] + 0);
    ra1 = *(const uint4*)(Ab + aoff[1] + 0);
    ra2 = *(const uint4*)(Ab + aoff[2] + 0);
    ra3 = *(const uint4*)(Ab + aoff[3] + 0);
    ra4 = *(const uint4*)(Ab + aoff[4] + 0);
    ra5 = *(const uint4*)(Ab + aoff[5] + 0);
    ra6 = *(const uint4*)(Ab + aoff[6] + 0);
    ra7 = *(const uint4*)(Ab + aoff[7] + 0);
    rb0 = *(const uint4*)(Bp + (size_t)(0) * ldb + 0);
    rb1 = *(const uint4*)(Bp + (size_t)(32) * ldb + 0);
    rb2 = *(const uint4*)(Bp + (size_t)(64) * ldb + 0);
    rb3 = *(const uint4*)(Bp + (size_t)(96) * ldb + 0);
    rc0 = *(const uint4*)(Ab + aoff[0] + 64);
    rc1 = *(const uint4*)(Ab + aoff[1] + 64);
    rc2 = *(const uint4*)(Ab + aoff[2] + 64);
    rc3 = *(const uint4*)(Ab + aoff[3] + 64);
    rc4 = *(const uint4*)(Ab + aoff[4] + 64);
    rc5 = *(const uint4*)(Ab + aoff[5] + 64);
    rc6 = *(const uint4*)(Ab + aoff[6] + 64);
    rc7 = *(const uint4*)(Ab + aoff[7] + 64);
    rd0 = *(const uint4*)(Bp + (size_t)(0) * ldb + 64);
    rd1 = *(const uint4*)(Bp + (size_t)(32) * ldb + 64);
    rd2 = *(const uint4*)(Bp + (size_t)(64) * ldb + 64);
    rd3 = *(const uint4*)(Bp + (size_t)(96) * ldb + 64);
    *(uint4*)(lds + 0 + soff + 0) = ra0;
    *(uint4*)(lds + 0 + soff + 4096) = ra1;
    *(uint4*)(lds + 0 + soff + 8192) = ra2;
    *(uint4*)(lds + 0 + soff + 12288) = ra3;
    *(uint4*)(lds + 0 + soff + 16384) = ra4;
    *(uint4*)(lds + 0 + soff + 20480) = ra5;
    *(uint4*)(lds + 0 + soff + 24576) = ra6;
    *(uint4*)(lds + 0 + soff + 28672) = ra7;
    *(uint4*)(lds + 0 + 32768 + soff + 0) = rb0;
    *(uint4*)(lds + 0 + 32768 + soff + 4096) = rb1;
    *(uint4*)(lds + 0 + 32768 + soff + 8192) = rb2;
    *(uint4*)(lds + 0 + 32768 + soff + 12288) = rb3;
  }
  __syncthreads();
  const int r_ = lane & 31, h_ = lane >> 5;
  int arow[4], asw[4], brow[2], bsw[2];
#pragma unroll
  for (int mi = 0; mi < 4; ++mi) { int row = wr * 128 + mi * 32 + r_; arow[mi] = row * 128; asw[mi] = (row >> 1) & 7; }
#pragma unroll
  for (int ni = 0; ni < 2; ++ni) { int row = wc * 64 + ni * 32 + r_; brow[ni] = row * 128; bsw[ni] = (row >> 1) & 7; }
  for (int kt = 0; kt < nk; kt += 2) {
    {
    const int kk = (kt + 2 < nk ? kt + 2 : nk - 1) * 64;
    ra0 = *(const uint4*)(Ab + aoff[0] + kk);
    ra1 = *(const uint4*)(Ab + aoff[1] + kk);
    ra2 = *(const uint4*)(Ab + aoff[2] + kk);
    ra3 = *(const uint4*)(Ab + aoff[3] + kk);
    ra4 = *(const uint4*)(Ab + aoff[4] + kk);
    ra5 = *(const uint4*)(Ab + aoff[5] + kk);
    ra6 = *(const uint4*)(Ab + aoff[6] + kk);
    ra7 = *(const uint4*)(Ab + aoff[7] + kk);
    rb0 = *(const uint4*)(Bp + (size_t)(0) * ldb + kk);
    rb1 = *(const uint4*)(Bp + (size_t)(32) * ldb + kk);
    rb2 = *(const uint4*)(Bp + (size_t)(64) * ldb + kk);
    rb3 = *(const uint4*)(Bp + (size_t)(96) * ldb + kk);
    }
    SB();
    {
      bf16x8 fa[2][4], fb[2][2];
        { const int ch = 0 + h_;
#pragma unroll
          for (int mi = 0; mi < 4; ++mi) fa[0][mi] = *(const bf16x8*)(lds + 0 + arow[mi] + ((ch ^ asw[mi]) << 4));
#pragma unroll
          for (int ni = 0; ni < 2; ++ni) fb[0][ni] = *(const bf16x8*)(lds + 0 + 32768 + brow[ni] + ((ch ^ bsw[ni]) << 4));
        }
        { const int ch = 2 + h_;
#pragma unroll
          for (int mi = 0; mi < 4; ++mi) fa[1][mi] = *(const bf16x8*)(lds + 0 + arow[mi] + ((ch ^ asw[mi]) << 4));
#pragma unroll
          for (int ni = 0; ni < 2; ++ni) fb[1][ni] = *(const bf16x8*)(lds + 0 + 32768 + brow[ni] + ((ch ^ bsw[ni]) << 4));
        }
        SB();
#pragma unroll
        for (int mi = 0; mi < 4; ++mi)
#pragma unroll
          for (int ni = 0; ni < 2; ++ni) acc[mi][ni] = __builtin_amdgcn_mfma_f32_32x32x16_bf16(fa[0][mi], fb[0][ni], acc[mi][ni], 0, 0, 0);
        *(uint4*)(lds + 49152 + soff + 0) = rc0;
        *(uint4*)(lds + 49152 + soff + 4096) = rc1;
        *(uint4*)(lds + 49152 + soff + 8192) = rc2;
        SB();
        { const int ch = 4 + h_;
#pragma unroll
          for (int mi = 0; mi < 4; ++mi) fa[0][mi] = *(const bf16x8*)(lds + 0 + arow[mi] + ((ch ^ asw[mi]) << 4));
#pragma unroll
          for (int ni = 0; ni < 2; ++ni) fb[0][ni] = *(const bf16x8*)(lds + 0 + 32768 + brow[ni] + ((ch ^ bsw[ni]) << 4));
        }
        SB();
#pragma unroll
        for (int mi = 0; mi < 4; ++mi)
#pragma unroll
          for (int ni = 0; ni < 2; ++ni) acc[mi][ni] = __builtin_amdgcn_mfma_f32_32x32x16_bf16(fa[1][mi], fb[1][ni], acc[mi][ni], 0, 0, 0);
        *(uint4*)(lds + 49152 + soff + 12288) = rc3;
        *(uint4*)(lds + 49152 + soff + 16384) = rc4;
        *(uint4*)(lds + 49152 + soff + 20480) = rc5;
        SB();
        { const int ch = 6 + h_;
#pragma unroll
          for (int mi = 0; mi < 4; ++mi) fa[1][mi] = *(const bf16x8*)(lds + 0 + arow[mi] + ((ch ^ asw[mi]) << 4));
#pragma unroll
          for (int ni = 0; ni < 2; ++ni) fb[1][ni] = *(const bf16x8*)(lds + 0 + 32768 + brow[ni] + ((ch ^ bsw[ni]) << 4));
        }
        SB();
#pragma unroll
        for (int mi = 0; mi < 4; ++mi)
#pragma unroll
          for (int ni = 0; ni < 2; ++ni) acc[mi][ni] = __builtin_amdgcn_mfma_f32_32x32x16_bf16(fa[0][mi], fb[0][ni], acc[mi][ni], 0, 0, 0);
        *(uint4*)(lds + 49152 + soff + 24576) = rc6;
        *(uint4*)(lds + 49152 + soff + 28672) = rc7;
        *(uint4*)(lds + 49152 + 32768 + soff + 0) = rd0;
        SB();
        SB();
#pragma unroll
        for (int mi = 0; mi < 4; ++mi)
#pragma unroll
          for (int ni = 0; ni < 2; ++ni) acc[mi][ni] = __builtin_amdgcn_mfma_f32_32x32x16_bf16(fa[1][mi], fb[1][ni], acc[mi][ni], 0, 0, 0);
        *(uint4*)(lds + 49152 + 32768 + soff + 4096) = rd1;
        *(uint4*)(lds + 49152 + 32768 + soff + 8192) = rd2;
        *(uint4*)(lds + 49152 + 32768 + soff + 12288) = rd3;
        SB();
    }
    __syncthreads();
    {
    const int kk = (kt + 3 < nk ? kt + 3 : nk - 1) * 64;
    rc0 = *(const uint4*)(Ab + aoff[0] + kk);
    rc1 = *(const uint4*)(Ab + aoff[1] + kk);
    rc2 = *(const uint4*)(Ab + aoff[2] + kk);
    rc3 = *(const uint4*)(Ab + aoff[3] + kk);
    rc4 = *(const uint4*)(Ab + aoff[4] + kk);
    rc5 = *(const uint4*)(Ab + aoff[5] + kk);
    rc6 = *(const uint4*)(Ab + aoff[6] + kk);
    rc7 = *(const uint4*)(Ab + aoff[7] + kk);
    rd0 = *(const uint4*)(Bp + (size_t)(0) * ldb + kk);
    rd1 = *(const uint4*)(Bp + (size_t)(32) * ldb + kk);
    rd2 = *(const uint4*)(Bp + (size_t)(64) * ldb + kk);
    rd3 = *(const uint4*)(Bp + (size_t)(96) * ldb + kk);
    }
    SB();
    {
      bf16x8 fa[2][4], fb[2][2];
        { const int ch = 0 + h_;
#pragma unroll
          for (int mi = 0; mi < 4; ++mi) fa[0][mi] = *(const bf16x8*)(lds + 49152 + arow[mi] + ((ch ^ asw[mi]) << 4));
#pragma unroll
          for (int ni = 0; ni < 2; ++ni) fb[0][ni] = *(const bf16x8*)(lds + 49152 + 32768 + brow[ni] + ((ch ^ bsw[ni]) << 4));
        }
        { const int ch = 2 + h_;
#pragma unroll
          for (int mi = 0; mi < 4; ++mi) fa[1][mi] = *(const bf16x8*)(lds + 49152 + arow[mi] + ((ch ^ asw[mi]) << 4));
#pragma unroll
          for (int ni = 0; ni < 2; ++ni) fb[1][ni] = *(const bf16x8*)(lds + 49152 + 32768 + brow[ni] + ((ch ^ bsw[ni]) << 4));
        }
        SB();
#pragma unroll
        for (int mi = 0; mi < 4; ++mi)
#pragma unroll
          for (int ni = 0; ni < 2; ++ni) acc[mi][ni] = __builtin_amdgcn_mfma_f32_32x32x16_bf16(fa[0][mi], fb[0][ni], acc[mi][ni], 0, 0, 0);
        *(uint4*)(lds + 0 + soff + 0) = ra0;
        *(uint4*)(lds + 0 + soff + 4096) = ra1;
        *(uint4*)(lds + 0 + soff + 8192) = ra2;
        SB();
        { const int ch = 4 + h_;
#pragma unroll
          for (int mi = 0; mi < 4; ++mi) fa[0][mi] = *(const bf16x8*)(lds + 49152 + arow[mi] + ((ch ^ asw[mi]) << 4));
#pragma unroll
          for (int ni = 0; ni < 2; ++ni) fb[0][ni] = *(const bf16x8*)(lds + 49152 + 32768 + brow[ni] + ((ch ^ bsw[ni]) << 4));
        }
        SB();
#pragma unroll
        for (int mi = 0; mi < 4; ++mi)
#pragma unroll
          for (int ni = 0; ni < 2; ++ni) acc[mi][ni] = __builtin_amdgcn_mfma_f32_32x32x16_bf16(fa[1][mi], fb[1][ni], acc[mi][ni], 0, 0, 0);
        *(uint4*)(lds + 0 + soff + 12288) = ra3;
        *(uint4*)(lds + 0 + soff + 16384) = ra4;
        *(uint4*)(lds + 0 + soff + 20480) = ra5;
        SB();
        { const int ch = 6 + h_;
#pragma unroll
          for (int mi = 0; mi < 4; ++mi) fa[1][mi] = *(const bf16x8*)(lds + 49152 + arow[mi] + ((ch ^ asw[mi]) << 4));
#pragma unroll
          for (int ni = 0; ni < 2; ++ni) fb[1][ni] = *(const bf16x8*)(lds + 49152 + 32768 + brow[ni] + ((ch ^ bsw[ni]) << 4));
        }
        SB();
#pragma unroll
        for (int mi = 0; mi < 4; ++mi)
#pragma unroll
          for (int ni = 0; ni < 2; ++ni) acc[mi][ni] = __builtin_amdgcn_mfma_f32_32x32x16_bf16(fa[0][mi], fb[0][ni], acc[mi][ni], 0, 0, 0);
        *(uint4*)(lds + 0 + soff + 24576) = ra6;
        *(uint4*)(lds + 0 + soff + 28672) = ra7;
        *(uint4*)(lds + 0 + 32768 + soff + 0) = rb0;
        SB();
        SB();
#pragma unroll
        for (int mi = 0; mi < 4; ++mi)
#pragma unroll
          for (int ni = 0; ni < 2; ++ni) acc[mi][ni] = __builtin_amdgcn_mfma_f32_32x32x16_bf16(fa[1][mi], fb[1][ni], acc[mi][ni], 0, 0, 0);
        *(uint4*)(lds + 0 + 32768 + soff + 4096) = rb1;
        *(uint4*)(lds + 0 + 32768 + soff + 8192) = rb2;
        *(uint4*)(lds + 0 + 32768 + soff + 12288) = rb3;
        SB();
    }
    __syncthreads();
  }
  epi(acc, m0 + wr * 128, n0 + wc * 64, lane);
}

struct TDesc { const float* src; u16* dst; int K, N, lds, Kp, Np, mode; };
__device__ __forceinline__ TDesc get_tdesc(const P& p, int i, int zz) {
  TDesc d;
  d.mode = 0;
  char* ws = p.ws;
  switch (i) {
    case 0: d = {p.in[zz + I_WIN0], (u16*)(ws + W_IN0), 1024, 4632, 4632, 1024, 4736, 1}; break;
    case 1: d = {p.in[zz + I_WOUT0], (u16*)(ws + W_OUT0), 2048, 1024, 1024, 2048, 1024, 0}; break;
    case 2: d = {p.in[zz + I_GU], (u16*)(ws + W_GU), 1024, 5632, 5632, 1024, 5632, 2}; break;
    case 3: d = {p.in[zz + I_GU] + 1024ull * 5632, (u16*)(ws + W_GU + 5632ull * 1024 * 2), 1024, 5632, 5632, 1024, 5632, 2}; break;
    case 4: d = {p.in[zz + I_DN], (u16*)(ws + W_DN), 2816, 1024, 1024, 2816, 1024, 0}; break;
    case 5: d = {p.in[zz + I_DN] + 2816ull * 1024, (u16*)(ws + W_DN + 1024ull * 2816 * 2), 2816, 1024, 1024, 2816, 1024, 0}; break;
    case 6: d = {p.in[zz + I_WR], (u16*)(ws + W_R), 1024, 1024, 1024, 1024, 1024, 0}; break;
    case 7: d = {p.in[zz + I_WKK], (u16*)(ws + W_K), 1024, 1024, 1024, 1024, 1024, 0}; break;
    case 8: d = {p.in[zz + I_WVV], (u16*)(ws + W_V), 1024, 1024, 1024, 1024, 1024, 0}; break;
    case 9: d = {p.in[zz + I_WO], (u16*)(ws + W_O), 1024, 1024, 1024, 1024, 1024, 0}; break;
    case 10: d = {p.in[zz + I_W1], (u16*)(ws + W_W1), 1024, 64, 64, 1024, 128, 0}; break;
    case 11: d = {p.in[zz + I_A1], (u16*)(ws + W_A1), 1024, 64, 64, 1024, 128, 0}; break;
    case 12: d = {p.in[zz + I_G1], (u16*)(ws + W_G1), 1024, 160, 160, 1024, 256, 0}; break;
    case 13: d = {p.in[zz + I_W2], (u16*)(ws + W_W2), 64, 1024, 1024, 128, 1024, 0}; break;
    case 14: d = {p.in[zz + I_A2], (u16*)(ws + W_A2), 64, 1024, 1024, 128, 1024, 0}; break;
    default: d = {p.in[zz + I_G2], (u16*)(ws + W_G2), 160, 1024, 1024, 256, 1024, 0}; break;
  }
  return d;
}
__device__ __forceinline__ int tdesc_tiles(int i) {
  switch (i) {
    case 0: return 16 * 74;
    case 1: return 32 * 16;
    case 2: case 3: return 16 * 88;
    case 4: case 5: return 44 * 16;
    case 6: case 7: case 8: case 9: return 16 * 16;
    case 10: case 11: return 16 * 2;
    case 12: return 16 * 4;
    case 13: case 14: return 2 * 16;
    default: return 4 * 16;
  }
}
constexpr int PREP_TILES = 16 * 74 + 32 * 16 + 2 * 16 * 88 + 2 * 44 * 16 + 4 * 256 + 2 * 32 + 64 + 2 * 32 + 64;

__device__ __forceinline__ void rms_rows_bf16(const float* src_row, const float* g, u16* dst_row, int lane) {
  float4 v[4];
  float ss = 0.f;
#pragma unroll
  for (int i = 0; i < 4; ++i) {
    v[i] = ((const float4*)src_row)[lane + 64 * i];
    ss += v[i].x * v[i].x + v[i].y * v[i].y + v[i].z * v[i].z + v[i].w * v[i].w;
  }
  ss = wsum(ss);
  float rinv = rsqrtf(ss * (1.f / 1024.f) + EPS);
#pragma unroll
  for (int i = 0; i < 4; ++i) {
    float4 g4 = ((const float4*)g)[lane + 64 * i];
    uint2 o;
    o.x = pk2(v[i].x * rinv * g4.x, v[i].y * rinv * g4.y);
    o.y = pk2(v[i].z * rinv * g4.z, v[i].w * rinv * g4.w);
    ((uint2*)dst_row)[lane + 64 * i] = o;
  }
}

__device__ __forceinline__ void rms_rows2_bf16(const float* sa, const float* sb, const float* g, u16* da, u16* db, bool hasb, int lane) {
  float4 va[4], vb[4];
  float ssa = 0.f, ssb = 0.f;
#pragma unroll
  for (int i = 0; i < 4; ++i) { va[i] = ((const float4*)sa)[lane + 64 * i]; vb[i] = ((const float4*)sb)[lane + 64 * i]; }
#pragma unroll
  for (int i = 0; i < 4; ++i) {
    ssa += va[i].x * va[i].x + va[i].y * va[i].y + va[i].z * va[i].z + va[i].w * va[i].w;
    ssb += vb[i].x * vb[i].x + vb[i].y * vb[i].y + vb[i].z * vb[i].z + vb[i].w * vb[i].w;
  }
  ssa = wsum(ssa); ssb = wsum(ssb);
  float ra = rsqrtf(ssa * (1.f / 1024.f) + EPS), rb = rsqrtf(ssb * (1.f / 1024.f) + EPS);
#pragma unroll
  for (int i = 0; i < 4; ++i) {
    float4 g4 = ((const float4*)g)[lane + 64 * i];
    uint2 o;
    o.x = pk2(va[i].x * ra * g4.x, va[i].y * ra * g4.y);
    o.y = pk2(va[i].z * ra * g4.z, va[i].w * ra * g4.w);
    ((uint2*)da)[lane + 64 * i] = o;
    if (hasb) {
      o.x = pk2(vb[i].x * rb * g4.x, vb[i].y * rb * g4.y);
      o.y = pk2(vb[i].z * rb * g4.z, vb[i].w * rb * g4.w);
      ((uint2*)db)[lane + 64 * i] = o;
    }
  }
}
__device__ __forceinline__ void phase_prep(const P& p, char* lds, int bid, int G) {
  float* tile = (float*)lds;
  const int total = PREP_TILES + TT / 8;
  for (int w = bid; w < total; w += G) {
    FRESH_TID(tid);
    const int zz = zof(w);
    const int lane = tid & 63, wid = tid >> 6;
    if (w < PREP_TILES) {
      int t = w, di = 0;
      for (; di < 16; ++di) {
        int n = tdesc_tiles(di);
        if (t < n) break;
        t -= n;
      }
      TDesc d = get_tdesc(p, di, zz);
      const int nkt = d.Kp >> 6;
      const int kt = t % nkt, nt = t / nkt;
      const int k0 = kt * 64, n0 = nt * 64;
      float vals[16];
#pragma unroll
      for (int i = 0; i < 16; ++i) {
        int kk = i * 4 + (tid >> 6), nn = tid & 63;
        int n = n0 + nn, k = k0 + kk, sc;
        if (d.mode == 0) sc = (n < d.N) ? n : -1;
        else if (d.mode == 1) sc = n < 3584 ? n : (n < 4608 ? 3600 + (n - 3584) : (n < 4624 ? 3584 + (n - 4608) : (n < 4632 ? n : -1)));
        else { int q = n >> 6, j = n & 63; sc = j < 32 ? q * 32 + j : 2816 + q * 32 + (j - 32); }
        const bool ok = (sc >= 0 && k < d.K);
        float v = d.src[ok ? (size_t)k * d.lds + sc : 0];
        vals[i] = ok ? v : 0.f;
      }
#pragma unroll
      for (int i = 0; i < 16; ++i) tile[(i * 4 + (tid >> 6)) * 65 + (tid & 63)] = vals[i];
      __syncthreads();
#pragma unroll
      for (int i = 0; i < 16; ++i) {
        int nn = i * 4 + (tid >> 6), kk = tid & 63;
        d.dst[(size_t)(n0 + nn) * d.Kp + k0 + kk] = f2bf(tile[kk * 65 + nn]);
      }
      __syncthreads();
    } else {
      int rowa = (w - PREP_TILES) * 8 + wid, rowb = rowa + 4;
      const float* sa = rowa < TP ? p.in[zz + I_XP] + (size_t)rowa * 1024 : p.in[zz + I_XS] + (size_t)(rowa - TP) * 1024;
      const float* sb = rowb < TP ? p.in[zz + I_XP] + (size_t)rowb * 1024 : p.in[zz + I_XS] + (size_t)(rowb - TP) * 1024;
      u16* xn = (u16*)(p.ws + B_A);
      rms_rows2_bf16(sa, sb, p.in[zz + I_NMIX], xn + (size_t)rowa * 1024, xn + (size_t)rowb * 1024, true, lane);
    }
  }
}

__device__ __forceinline__ bool tile_map(int q, int xcd, int MT, int NT, int& mt, int& nt) {
  int mi = q / NT;
  nt = q - mi * NT;
  mt = xcd + 8 * mi;
  return mt < MT;
}
template <class Epi>
__device__ __forceinline__ void gemm_phase(const u16* A, int lda, const u16* B, int ldb, int K, int MT, int NT, char* lds, int bid, int G, const Epi& epi) {
  const int xcd = bid & 7, j = bid >> 3, nb = G >> 3;
  const int nq = ((MT + 7) >> 3) * NT;
  for (int q = j; q < nq; q += nb) {
    int mt, nt;
    if (!tile_map(q, xcd, MT, NT, mt, nt)) break;
    gemm_tile(A, lda, B, ldb, K, mt * 256, nt * 128, lds, epi);
  }
}

struct EpiProj {
  u16* proj; float* small;
  __device__ __forceinline__ void operator()(f32x16 (&acc)[4][2], int r0, int c0, int lane) const {
#pragma unroll
    for (int mi = 0; mi < 4; ++mi)
#pragma unroll
      for (int ni = 0; ni < 2; ++ni) {
        int col = c0 + ni * 32 + (lane & 31);
#pragma unroll
        for (int i = 0; i < 16; ++i) {
          int row = r0 + mi * 32 + ACC_ROW(i, lane);
          if (row >= TT) continue;
          float v = acc[mi][ni][i];
          if (col < PJ) proj[(size_t)row * PJ + col] = f2bf(v);
          else if (col < PJ + 32) small[(size_t)row * 32 + (col - PJ)] = v;
        }
      }
  }
};
struct EpiRes {
  const float* res; const float* res2; float* out;
  __device__ __forceinline__ void operator()(f32x16 (&acc)[4][2], int r0, int c0, int lane) const {
#pragma unroll
    for (int mi = 0; mi < 4; ++mi)
#pragma unroll
      for (int ni = 0; ni < 2; ++ni) {
        int col = c0 + ni * 32 + (lane & 31);
#pragma unroll
        for (int i = 0; i < 16; ++i) {
          int row = r0 + mi * 32 + ACC_ROW(i, lane);
          if (row >= TT) continue;
          float rv = row < TP ? res[(size_t)row * 1024 + col] : res2[(size_t)(row - TP) * 1024 + col];
          out[(size_t)row * 1024 + col] = rv + acc[mi][ni][i];
        }
      }
  }
};
struct EpiSwiglu {
  u16* hb;
  __device__ __forceinline__ void operator()(f32x16 (&acc)[4][2], int r0, int c0, int lane) const {
    int col = (c0 >> 1) + (lane & 31);
#pragma unroll
    for (int mi = 0; mi < 4; ++mi)
#pragma unroll
      for (int i = 0; i < 16; ++i) {
        int row = r0 + mi * 32 + ACC_ROW(i, lane);
        if (row >= TT) continue;
        float g = acc[mi][0][i], u = acc[mi][1][i];
        hb[(size_t)row * 2816 + col] = f2bf(g * sigmoidf(g) * u);
      }
  }
};
struct EpiAct {
  u16* out; int ldo; int nvalid; int nstore; int act;
  __device__ __forceinline__ void operator()(f32x16 (&acc)[4][2], int r0, int c0, int lane) const {
#pragma unroll
    for (int mi = 0; mi < 4; ++mi)
#pragma unroll
      for (int ni = 0; ni < 2; ++ni) {
        int col = c0 + ni * 32 + (lane & 31);
        if (col >= nstore) continue;
#pragma unroll
        for (int i = 0; i < 16; ++i) {
          int row = r0 + mi * 32 + ACC_ROW(i, lane);
          if (row >= TT) continue;
          float v = acc[mi][ni][i];
          if (act == 1) v = tanhf(v);
          else if (act == 2) v = sigmoidf(v);
          if (col >= nvalid) v = 0.f;
          out[(size_t)row * ldo + col] = f2bf(v);
        }
      }
  }
};
struct EpiLora2 {
  int which; const float* bias; float* outf; u16* outb;
  __device__ __forceinline__ void operator()(f32x16 (&acc)[4][2], int r0, int c0, int lane) const {
#pragma unroll
    for (int mi = 0; mi < 4; ++mi)
#pragma unroll
      for (int ni = 0; ni < 2; ++ni) {
        int col = c0 + ni * 32 + (lane & 31);
        float bv = which < 2 ? bias[col] : 0.f;
#pragma unroll
        for (int i = 0; i < 16; ++i) {
          int row = r0 + mi * 32 + ACC_ROW(i, lane);
          if (row >= TT) continue;
          float v = acc[mi][ni][i] + bv;
          if (which == 0) {
            float w = -softplusf(-v) - 0.5f;
            outf[(size_t)row * 1024 + col] = __expf(-__expf(w));
          } else if (which == 1) {
            outb[(size_t)row * 1024 + col] = f2bf(sigmoidf(v));
          } else {
            outb[(size_t)row * 1024 + col] = f2bf(v);
          }
        }
      }
  }
};

__device__ __forceinline__ void phase_conv(const P& p, char* lds, int bid, int G) {
  const u16* proj = (const u16*)(p.ws + B_PROJ);
  const float* small = (const float*)(p.ws + B_SMALL);
  u16* xs = (u16*)(p.ws + B_A);
  u16* Bm = (u16*)(p.ws + B_BM);
  u16* Cm = (u16*)(p.ws + B_CM);
  u16* xm = (u16*)(p.ws + B_XM);
  const int zz0 = zof(bid);
  const float* cw = p.in[zz0 + I_CONVW];
  const float* cb = p.in[zz0 + I_CONVB];
  const int n_conv = TT / 4;
  const int n_gate = (512 + 2048) / 4;
  for (int w = bid; w < n_conv + n_gate; w += G) {
    FRESH_TID(tid);
    const int zz = zof(w);
    const int lane = tid & 63, wid = tid >> 6;
    if (w < n_conv) {
#pragma unroll
      for (int k_ = 0; k_ < 5; ++k_) {
        const int i = tid + k_ * 256;
        int r4 = i / 320, cgp = i % 320;
        int row = w * 4 + r4, c0 = cgp * 8;
        float u[4][8];
        if (row < TP) {
          int t = row & 2047;
#pragma unroll
          for (int j = 0; j < 4; ++j) {
            int tt = t - 3 + j;
            if (tt >= 0) {
              uint4 q = *(const uint4*)(proj + (size_t)(row - 3 + j) * PJ + 1024 + c0);
              unpack8(q, u[j]);
            } else {
#pragma unroll
              for (int e = 0; e < 8; ++e) u[j][e] = 0.f;
            }
          }
          if (t >= 2045) {
            int b = row >> 11;
            float* o = p.out + O_CONVP + ((size_t)(b * 3 + (t - 2045)) * 2560 + c0);
#pragma unroll
            for (int e = 0; e < 8; ++e) o[e] = u[3][e];
          }
        } else {
          int bs = row - TP;
#pragma unroll
          for (int j = 0; j < 3; ++j) {
            const float* s = p.in[zz + I_SCONV] + ((size_t)(bs * 3 + j) * 2560 + c0);
#pragma unroll
            for (int e = 0; e < 8; ++e) u[j][e] = s[e];
          }
          uint4 q = *(const uint4*)(proj + (size_t)row * PJ + 1024 + c0);
          unpack8(q, u[3]);
          float* o = p.out + O_CONVS + ((size_t)(bs * 3) * 2560 + c0);
#pragma unroll
          for (int e = 0; e < 8; ++e) { o[e] = u[1][e]; o[2560 + e] = u[2][e]; o[5120 + e] = u[3][e]; }
        }
        float a[8];
#pragma unroll
        for (int e = 0; e < 8; ++e) {
          float v = cb[c0 + e];
#pragma unroll
          for (int j = 0; j < 4; ++j) v += u[j][e] * cw[j * 2560 + c0 + e];
          a[e] = v * sigmoidf(v);
        }
        uint4 o = pack8(a);
        u16* dst;
        if (c0 < 1024) dst = xs + (size_t)row * 1024 + c0;
        else if (c0 < 1280) dst = Bm + (size_t)row * 256 + (c0 - 1024);
        else if (c0 < 1536) dst = Cm + (size_t)row * 256 + (c0 - 1280);
        else dst = xm + (size_t)row * 1024 + (c0 - 1536);
        *(uint4*)dst = o;
      }
    } else {
      int wi = (w - n_conv) * 4 + wid;
      int t0 = 2 * lane;
      if (wi < 512) {
        int c = wi & 15, h = (wi >> 4) & 3, b = wi >> 6;
        int row0 = b * 2048 + c * 128;
        float fb = p.in[zz + I_FB][h], ib = p.in[zz + I_IB][h];
        float f0 = small[(size_t)(row0 + t0) * 32 + 20 + h] + fb, f1 = small[(size_t)(row0 + t0 + 1) * 32 + 20 + h] + fb;
        float i0 = small[(size_t)(row0 + t0) * 32 + 16 + h] + ib, i1 = small[(size_t)(row0 + t0 + 1) * 32 + 16 + h] + ib;
        float lf0 = -softplusf(-f0), lf1 = -softplusf(-f1);
        float inc = wscan(lf0 + lf1, lane);
        float bc1 = inc, bc0 = inc - lf1;
        float uu = wmax(fmaxf(i0 - bc0, i1 - bc1));
        float bend = __shfl(inc, 63);
        float* bcum = (float*)(p.ws + M_BCUM);
        float* li = (float*)(p.ws + M_LI);
        bcum[(size_t)(row0 + t0) * 4 + h] = bc0; bcum[(size_t)(row0 + t0 + 1) * 4 + h] = bc1;
        li[(size_t)(row0 + t0) * 4 + h] = i0; li[(size_t)(row0 + t0 + 1) * 4 + h] = i1;
        if (lane == 0) {
          float* gs = (float*)(p.ws + M_GSUM) + (size_t)((b * 4 + h) * 16 + c) * 2;
          gs[0] = bend; gs[1] = uu;
        }
      } else {
        int x = wi - 512;
        int h = x & 15, c = (x >> 4) & 15, b = x >> 8;
        int row0 = b * 2048 + c * 128;
        float db = p.in[zz + I_DTB][h], an = -__expf(p.in[zz + I_ALOG][h]);
        float d0 = softplusf(small[(size_t)(row0 + t0) * 32 + h] + db), d1 = softplusf(small[(size_t)(row0 + t0 + 1) * 32 + h] + db);
        float inc = wscan((d0 + d1) * an, lane);
        float* dt = (float*)(p.ws + M_DT);
        float* ac = (float*)(p.ws + M_ACUM);
        dt[(size_t)(row0 + t0) * 16 + h] = d0; dt[(size_t)(row0 + t0 + 1) * 16 + h] = d1;
        ac[(size_t)(row0 + t0) * 16 + h] = inc - d1 * an; ac[(size_t)(row0 + t0 + 1) * 16 + h] = inc;
      }
    }
  }
}

__device__ __forceinline__ void blockdiag8(const float* x, const float* __restrict__ w, int ch0, float scale, float* o) {
  const float4* w4 = (const float4*)(w + (size_t)(ch0 >> 2) * 16);
#pragma unroll
  for (int blk = 0; blk < 2; ++blk) {
    float4 r0 = w4[blk * 4 + 0], r1 = w4[blk * 4 + 1], r2 = w4[blk * 4 + 2], r3 = w4[blk * 4 + 3];
    const float* xx = x + blk * 4;
    o[blk * 4 + 0] = (xx[0] * r0.x + xx[1] * r1.x + xx[2] * r2.x + xx[3] * r3.x) * scale;
    o[blk * 4 + 1] = (xx[0] * r0.y + xx[1] * r1.y + xx[2] * r2.y + xx[3] * r3.y) * scale;
    o[blk * 4 + 2] = (xx[0] * r0.z + xx[1] * r1.z + xx[2] * r2.z + xx[3] * r3.z) * scale;
    o[blk * 4 + 3] = (xx[0] * r0.w + xx[1] * r1.w + xx[2] * r2.w + xx[3] * r3.w) * scale;
  }
}
__device__ __forceinline__ void mchain(const float* gs  , int c, float& mc, float& mn, float& bend) {
  float m = 0.f;
  for (int j = 0; j < c; ++j) m = gs[j * 2] + fmaxf(m, gs[j * 2 + 1]);
  mc = m;
  bend = gs[c * 2];
  mn = bend + fmaxf(m, gs[c * 2 + 1]);
}

__device__ __forceinline__ void img_put_t(char* img, int R, int j0, int s, const float* v) {
  char* pb = img + (s >> 6) * (R * 128);
#pragma unroll
  for (int e = 0; e < 8; ++e) *(u16*)(pb + img_off(j0 + e, s & 63)) = f2bf(v[e]);
}

__device__ __forceinline__ void phase_chunkstate(const P& p, char* lds, int bid, int G) {
  const u16* proj = (const u16*)(p.ws + B_PROJ);
  const float* small = (const float*)(p.ws + B_SMALL);
  const u16* xs = (const u16*)(p.ws + B_A);
  const u16* Bm = (const u16*)(p.ws + B_BM);
  const u16* Cm = (const u16*)(p.ws + B_CM);
  const u16* xm = (const u16*)(p.ws + B_XM);
  u16* mix = (u16*)(p.ws + B_MIX);
  char* R0 = lds;
  char* R1 = lds + 32768;
  float* ex = (float*)(lds + 65536);
  for (int w = bid; w < 2048; w += G) {
    FRESH_TID(tid);
    const int zz = zof(w);
    const int lane = tid & 63, wid = tid >> 6;
    if (w < 512) {
      const int bs = w >> 2, h = w & 3, row = TP + bs;
      float* sq = ex; float* sk = ex + 256; float* sv = ex + 512; float* scr = ex + 768;
      {
        int d = tid, cb4 = d & ~3, ci = d & 3;
        int nb = (h * 256 + cb4) >> 2;
        float q = 0.f, k = 0.f, v = 0.f;
#pragma unroll
        for (int c = 0; c < 4; ++c) {
          float xa = bf2f(xm[(size_t)row * 1024 + h * 256 + cb4 + c]);
          float xr = bf2f(proj[(size_t)row * PJ + 2560 + h * 256 + cb4 + c]);
          q += xa * p.in[zz + I_WQ][nb * 16 + c * 4 + ci];
          k += xa * p.in[zz + I_WK][nb * 16 + c * 4 + ci];
          v += xr * p.in[zz + I_WV][nb * 16 + c * 4 + ci];
        }
        sq[d] = q; sk[d] = k * 0.0625f; sv[d] = v;
      }
      float lf = -softplusf(-(small[(size_t)row * 32 + 20 + h] + p.in[zz + I_FB][h]));
      float li = small[(size_t)row * 32 + 16 + h] + p.in[zz + I_IB][h];
      float m = p.in[zz + I_SMM][bs * 4 + h];
      float mnew = fmaxf(lf + m, li);
      float wsc = __expf(li - mnew), dc = __expf(lf + m - mnew);
      __syncthreads();
      float nn = dc * p.in[zz + I_SMN][(size_t)(bs * 4 + h) * 256 + tid] + wsc * sk[tid];
      p.out[O_MNS + (size_t)(bs * 4 + h) * 256 + tid] = nn;
      float den = bsum(sq[tid] * nn, scr);
      const float* C = p.in[zz + I_SMC] + (size_t)(bs * 4 + h) * 65536 + tid;
      float* Co = p.out + O_MCS + (size_t)(bs * 4 + h) * 65536 + tid;
      float vv = sv[tid] * wsc, num = 0.f;
      for (int d0 = 0; d0 < 256; d0 += 32) {
        float c[32];
#pragma unroll
        for (int e = 0; e < 32; ++e) c[e] = C[(size_t)(d0 + e) * 256];
#pragma unroll
        for (int e = 0; e < 32; ++e) {
          float cn = dc * c[e] + sk[d0 + e] * vv;
          num += sq[d0 + e] * cn;
          Co[(size_t)(d0 + e) * 256] = cn;
        }
      }
      float hv = num / fmaxf(fabsf(den), __expf(-mnew));
      float ss = bsum(hv * hv, scr);
      float rinv = rsqrtf(ss * (1.f / 256.f) + EPS);
      int ch = h * 256 + tid;
      float xa = bf2f(xm[(size_t)row * 1024 + ch]);
      float op = bf2f(proj[(size_t)row * PJ + 3584 + ch]);
      float hm = (hv * rinv * p.in[zz + I_MLN][ch] + p.in[zz + I_MLS][ch] * xa) * sigmoidf(op);
      mix[(size_t)row * 2048 + 1024 + ch] = f2bf(hm);
      if (tid == 0) p.out[O_MMS + bs * 4 + h] = mnew;
      __syncthreads();
    } else if (w < 768) {
      const int x = w - 512, bs = x >> 1, g = x & 1, row = TP + bs;
      float* yz = ex; float* scr = ex + 512;
      const int pp = tid >> 2, nq = tid & 3, n0 = nq * 32;
      _Pragma("unroll 1")
      for (int h8 = 0; h8 < 8; ++h8) {
        int h = g * 8 + h8;
        float dtv = softplusf(small[(size_t)row * 32 + h] + p.in[zz + I_DTB][h]);
        float dec = __expf(-dtv * __expf(p.in[zz + I_ALOG][h]));
        float xv = bf2f(xs[(size_t)row * 1024 + h * 64 + pp]);
        const float* st = p.in[zz + I_SSSM] + ((size_t)((bs * 16 + h) * 64 + pp)) * 128 + n0;
        float* so = p.out + O_SSMS + ((size_t)((bs * 16 + h) * 64 + pp)) * 128 + n0;
        float ys = 0.f, dx = dtv * xv;
#pragma unroll
        for (int j = 0; j < 8; ++j) {
          float4 s4 = *(const float4*)(st + j * 4);
          uint2 b2 = *(const uint2*)(Bm + (size_t)row * 256 + g * 128 + n0 + j * 4);
          uint2 c2 = *(const uint2*)(Cm + (size_t)row * 256 + g * 128 + n0 + j * 4);
          float4 o;
          o.x = dec * s4.x + dx * lo2f(b2.x); o.y = dec * s4.y + dx * hi2f(b2.x);
          o.z = dec * s4.z + dx * lo2f(b2.y); o.w = dec * s4.w + dx * hi2f(b2.y);
          ys += o.x * lo2f(c2.x) + o.y * hi2f(c2.x) + o.z * lo2f(c2.y) + o.w * hi2f(c2.y);
          *(float4*)(so + j * 4) = o;
        }
        ys += __shfl_xor(ys, 1);
        ys += __shfl_xor(ys, 2);
        if (nq == 0) {
          float z = bf2f(proj[(size_t)row * PJ + h * 64 + pp]);
          yz[h8 * 64 + pp] = (ys + p.in[zz + I_SSDD][h] * xv) * z * sigmoidf(z);
        }
      }
      __syncthreads();
      float a0 = yz[tid], a1 = yz[tid + 256];
      float ss = bsum(a0 * a0 + a1 * a1, scr);
      float rinv = rsqrtf(ss * (1.f / 512.f) + EPS);
      mix[(size_t)row * 2048 + g * 512 + tid] = f2bf(a0 * rinv * p.in[zz + I_SSDN][g * 512 + tid]);
      mix[(size_t)row * 2048 + g * 512 + tid + 256] = f2bf(a1 * rinv * p.in[zz + I_SSDN][g * 512 + tid + 256]);
      __syncthreads();
    } else if (w < 1024) {
      const int x = w - 768, g = x & 1, c = (x >> 1) & 15, b = x >> 5;
      const int rowbase = b * 2048 + c * 128;
      const float* dt = (const float*)(p.ws + M_DT);
      const float* ac = (const float*)(p.ws + M_ACUM);
      float* sWe = ex;
      for (int i = tid; i < 1024; i += 256) {
        int h8 = i >> 7, s = i & 127, h = g * 8 + h8;
        float al = ac[(size_t)(rowbase + 127) * 16 + h];
        sWe[i] = __expf(al - ac[(size_t)(rowbase + s) * 16 + h]) * dt[(size_t)(rowbase + s) * 16 + h];
      }
      _Pragma("unroll 4")
      for (int k_ = 0; k_ < (128 * 16) / 256; ++k_) { const int i = tid + k_ * 256;
        int jc = i & 15, s = i >> 4;
        uint4 q = *(const uint4*)(Bm + (size_t)(rowbase + s) * 256 + g * 128 + jc * 8);
        float v[8]; unpack8(q, v);
        img_put_t(R0, 128, jc * 8, s, v);
      }
      __syncthreads();
      _Pragma("unroll 1")
      for (int h8 = 0; h8 < 8; ++h8) {
        int h = g * 8 + h8;
        _Pragma("unroll")
        for (int k_ = 0; k_ < (128 * 8) / 256; ++k_) { const int i = tid + k_ * 256;
          int jc = i & 7, s = i >> 3;
          uint4 q = *(const uint4*)(xs + (size_t)(rowbase + s) * 1024 + h * 64 + jc * 8);
          float v[8]; unpack8(q, v);
          float sc = sWe[h8 * 128 + s];
#pragma unroll
          for (int e = 0; e < 8; ++e) v[e] *= sc;
          img_put_t(R1, 64, jc * 8, s, v);
        }
        __syncthreads();
        f32x16 acc[1][2];
        zero_acc<1, 2>(acc);
#pragma unroll
        for (int pn = 0; pn < 2; ++pn) mma_panel<1, 2>(acc, R1 + pn * 8192, (wid & 1) * 32, R0 + pn * 16384, (wid >> 1) * 64, lane);
        u16* dst = (u16*)(p.ws + B_SSDST) + ((size_t)((b * 16 + c) * 16 + h)) * 8192;
#pragma unroll
        for (int ni = 0; ni < 2; ++ni)
#pragma unroll
          for (int i = 0; i < 16; ++i) {
            int pr = (wid & 1) * 32 + ACC_ROW(i, lane), n = (wid >> 1) * 64 + ni * 32 + (lane & 31);
            dst[pr * 128 + n] = f2bf(acc[0][ni][i]);
          }
        __syncthreads();
      }
    } else {
      const int x = w - 1024, vh = x & 1, c = (x >> 1) & 15, h = (x >> 5) & 3, b = x >> 7;
      const int rowbase = b * 2048 + c * 128;
      const float* gs = (const float*)(p.ws + M_GSUM) + (size_t)(b * 4 + h) * 32;
      float mc, mn, bend;
      mchain(gs, c, mc, mn, bend);
      float* sWs = ex;
      const float* bcum = (const float*)(p.ws + M_BCUM);
      const float* li = (const float*)(p.ws + M_LI);
      if (tid < 128) sWs[tid] = __expf(bend - bcum[(size_t)(rowbase + tid) * 4 + h] + li[(size_t)(rowbase + tid) * 4 + h] - mn);
      _Pragma("unroll 4")
      for (int k_ = 0; k_ < (128 * 16) / 256; ++k_) { const int i = tid + k_ * 256;
        int jc = i & 15, s = i >> 4;
        int ch0 = h * 256 + vh * 128 + jc * 8;
        uint4 q = *(const uint4*)(proj + (size_t)(rowbase + s) * PJ + 2560 + ch0);
        float xv[8], v[8]; unpack8(q, xv);
        blockdiag8(xv, p.in[zz + I_WV], ch0, 1.f, v);
        img_put_t(R0, 128, jc * 8, s, v);
      }
      __syncthreads();
      _Pragma("unroll 1")
      for (int dh = 0; dh < 2; ++dh) {
        _Pragma("unroll 4")
        for (int k_ = 0; k_ < (128 * 16) / 256; ++k_) { const int i = tid + k_ * 256;
          int jc = i & 15, s = i >> 4;
          int ch0 = h * 256 + dh * 128 + jc * 8;
          uint4 q = *(const uint4*)(xm + (size_t)(rowbase + s) * 1024 + ch0);
          float xv[8], v[8]; unpack8(q, xv);
          blockdiag8(xv, p.in[zz + I_WK], ch0, 0.0625f * sWs[s], v);
          img_put_t(R1, 128, jc * 8, s, v);
        }
        __syncthreads();
        f32x16 acc[2][2];
        zero_acc<2, 2>(acc);
#pragma unroll
        for (int pn = 0; pn < 2; ++pn) mma_panel<2, 2>(acc, R0 + pn * 16384, (wid & 1) * 64, R1 + pn * 16384, (wid >> 1) * 64, lane);
        if (vh == 0) {
          int d = tid >> 1, hf = tid & 1;
          float s = 0.f;
          for (int k = 0; k < 64; ++k) s += bf2f(*(const u16*)(R1 + hf * 16384 + img_off(d, k)));
          s += __shfl_xor(s, 1);
          if (hf == 0) ((float*)(p.ws + M_MLN))[(size_t)((b * 4 + h) * 16 + c) * 256 + dh * 128 + d] = s;
        }
        u16* dst = (u16*)(p.ws + B_MLST) + ((size_t)((b * 4 + h) * 16 + c)) * 65536;
#pragma unroll
        for (int mi = 0; mi < 2; ++mi)
#pragma unroll
          for (int ni = 0; ni < 2; ++ni)
#pragma unroll
            for (int i = 0; i < 16; ++i) {
              int v = vh * 128 + (wid & 1) * 64 + mi * 32 + ACC_ROW(i, lane), d = dh * 128 + (wid >> 1) * 64 + ni * 32 + (lane & 31);
              dst[v * 256 + d] = f2bf(acc[mi][ni][i]);
            }
        __syncthreads();
      }
    }
  }
}

__device__ __forceinline__ void phase_scan(const P& p, char* lds, int bid, int G) {
  for (int w = bid; w < 1568; w += G) {
    FRESH_TID(tid);
    const int zz = zof(w);
    if (w < 512) {
      int e8 = w * 256 + tid;
      int n8 = e8 & 15, pp = (e8 >> 4) & 63, h = (e8 >> 10) & 15, b = e8 >> 14;
      const float* ac = (const float*)(p.ws + M_ACUM);
      u16* st = (u16*)(p.ws + B_SSDST);
      float cur[8];
#pragma unroll
      for (int e = 0; e < 8; ++e) cur[e] = 0.f;
      uint4 qa[16]; float da[16];
#pragma unroll
      for (int c = 0; c < 16; ++c) {
        qa[c] = *(const uint4*)(st + ((size_t)((b * 16 + c) * 16 + h)) * 8192 + pp * 128 + n8 * 8);
        da[c] = ac[(size_t)(b * 2048 + c * 128 + 127) * 16 + h];
      }
#pragma unroll
      for (int c = 0; c < 16; ++c) {
        u16* ptr = st + ((size_t)((b * 16 + c) * 16 + h)) * 8192 + pp * 128 + n8 * 8;
        float t[8]; unpack8(qa[c], t);
        *(uint4*)ptr = pack8(cur);
        float dec = __expf(da[c]);
#pragma unroll
        for (int e = 0; e < 8; ++e) cur[e] = dec * cur[e] + t[e];
      }
      float* o = p.out + O_SSMP + ((size_t)((b * 16 + h) * 64 + pp)) * 128 + n8 * 8;
      *(float4*)o = make_float4(cur[0], cur[1], cur[2], cur[3]);
      *(float4*)(o + 4) = make_float4(cur[4], cur[5], cur[6], cur[7]);
    } else if (w < 1536) {
      int e8 = (w - 512) * 256 + tid;
      int d8 = e8 & 31, v = (e8 >> 5) & 255, h = (e8 >> 13) & 3, b = e8 >> 15;
      const float* gs = (const float*)(p.ws + M_GSUM) + (size_t)(b * 4 + h) * 32;
      u16* st = (u16*)(p.ws + B_MLST);
      float cur[8];
#pragma unroll
      for (int e = 0; e < 8; ++e) cur[e] = 0.f;
      float m = 0.f;
      uint4 qa[16];
#pragma unroll
      for (int c = 0; c < 16; ++c) qa[c] = *(const uint4*)(st + ((size_t)((b * 4 + h) * 16 + c)) * 65536 + v * 256 + d8 * 8);
#pragma unroll
      for (int c = 0; c < 16; ++c) {
        u16* ptr = st + ((size_t)((b * 4 + h) * 16 + c)) * 65536 + v * 256 + d8 * 8;
        float t[8]; unpack8(qa[c], t);
        *(uint4*)ptr = pack8(cur);
        float be = gs[c * 2], mn = be + fmaxf(m, gs[c * 2 + 1]);
        float dc = __expf(be + m - mn);
        m = mn;
#pragma unroll
        for (int e = 0; e < 8; ++e) cur[e] = dc * cur[e] + t[e];
      }
      float* o = p.out + O_MCP + (size_t)(b * 4 + h) * 65536 + v;
#pragma unroll
      for (int e = 0; e < 8; ++e) o[(size_t)(d8 * 8 + e) * 256] = cur[e];
    } else {
      int bh = w - 1536, d = tid;
      const float* gs = (const float*)(p.ws + M_GSUM) + (size_t)bh * 32;
      float* nb = (float*)(p.ws + M_MLN) + (size_t)bh * 16 * 256;
      float cur = 0.f, m = 0.f;
      for (int c = 0; c < 16; ++c) {
        float t = nb[c * 256 + d];
        nb[c * 256 + d] = cur;
        float be = gs[c * 2], mn = be + fmaxf(m, gs[c * 2 + 1]);
        float dc = __expf(be + m - mn);
        m = mn;
        cur = dc * cur + t;
      }
      p.out[O_MNP + (size_t)bh * 256 + d] = cur;
      if (tid == 0) p.out[O_MMP + bh] = m;
    }
  }
}

__device__ __forceinline__ void phase_chunkout(const P& p, char* lds, int bid, int G) {
  const u16* proj = (const u16*)(p.ws + B_PROJ);
  const u16* xs = (const u16*)(p.ws + B_A);
  const u16* Bm = (const u16*)(p.ws + B_BM);
  const u16* Cm = (const u16*)(p.ws + B_CM);
  const u16* xm = (const u16*)(p.ws + B_XM);
  u16* mix = (u16*)(p.ws + B_MIX);
  char* R0 = lds;
  char* R1 = lds + 32768;
  float* ex = (float*)(lds + 65536);
  for (int w = bid; w < 1024; w += G) {
    FRESH_TID(tid);
    const int zz = zof(w);
    const int lane = tid & 63, wid = tid >> 6;
#if defined(P5_ONLY) && P5_ONLY == 2
    if (false) {
#elif defined(P5_ONLY) && P5_ONLY == 1
    if (true) {
#else
    if (w >= 512) {
#endif
      const int x = w - 512, th = x & 1, g = (x >> 1) & 1, c = (x >> 2) & 15, b = x >> 6;
      const int rowbase = b * 2048 + c * 128;
      const float* dt = (const float*)(p.ws + M_DT);
      const float* ac = (const float*)(p.ws + M_ACUM);
      float* sA = ex;
      float* sD = ex + 1024;
      float* sSq = ex + 2048;
      for (int i = tid; i < 1024; i += 256) {
        int h8 = i >> 7, s = i & 127, h = g * 8 + h8;
        sA[i] = ac[(size_t)(rowbase + s) * 16 + h];
        sD[i] = dt[(size_t)(rowbase + s) * 16 + h];
      }
      if (tid < 64) sSq[tid] = 0.f;
      _Pragma("unroll 4")
      for (int k_ = 0; k_ < (128 * 16) / 256; ++k_) { const int i = tid + k_ * 256;
        int kc = i & 15, r = i >> 4;
        uint4 q = *(const uint4*)(Bm + (size_t)(rowbase + r) * 256 + g * 128 + kc * 8);
        *(uint4*)(R0 + (kc >> 3) * 16384 + r * 128 + (((kc & 7) ^ ((r >> 1) & 7)) << 4)) = q;
      }
      _Pragma("unroll")
      for (int k_ = 0; k_ < (64 * 16) / 256; ++k_) { const int i = tid + k_ * 256;
        int kc = i & 15, r = i >> 4;
        uint4 q = *(const uint4*)(Cm + (size_t)(rowbase + th * 64 + r) * 256 + g * 128 + kc * 8);
        *(uint4*)(R1 + (kc >> 3) * 8192 + r * 128 + (((kc & 7) ^ ((r >> 1) & 7)) << 4)) = q;
      }
      __syncthreads();
      f32x16 cb[2][1];
      zero_acc<2, 1>(cb);
#pragma unroll
      for (int pn = 0; pn < 2; ++pn) mma_panel<2, 1>(cb, R1 + pn * 8192, 0, R0 + pn * 16384, wid * 32, lane);
      __syncthreads();
      _Pragma("unroll 1")
      for (int h8 = 0; h8 < 8; ++h8) {
        const int h = g * 8 + h8;
        u16 exs[16], ezs[16];
        {
          int pp = (wid >> 1) * 32 + (lane & 31), ch = h * 64 + pp;
#pragma unroll
          for (int i = 0; i < 16; ++i) {
            size_t row = rowbase + th * 64 + (wid & 1) * 32 + ACC_ROW(i, lane);
            exs[i] = xs[row * 1024 + ch];
            ezs[i] = proj[row * PJ + ch];
          }
        }
        {
          int s = wid * 32 + (lane & 31);
          float as = sA[h8 * 128 + s], ds = sD[h8 * 128 + s];
#pragma unroll
          for (int mi = 0; mi < 2; ++mi)
#pragma unroll
            for (int i = 0; i < 16; ++i) {
              int tl = mi * 32 + ACC_ROW(i, lane), t = th * 64 + tl;
              float v = (s <= t) ? __expf(sA[h8 * 128 + t] - as) * cb[mi][0][i] * ds : 0.f;
              *(u16*)(R0 + (s >> 6) * 8192 + img_off(tl, s & 63)) = f2bf(v);
              if ((i & 3) == 3) SB();
            }
        }
        _Pragma("unroll")
        for (int k_ = 0; k_ < (128 * 8) / 256; ++k_) { const int i = tid + k_ * 256;
          int jc = i & 7, s = i >> 3;
          uint4 q = *(const uint4*)(xs + (size_t)(rowbase + s) * 1024 + h * 64 + jc * 8);
          float v[8]; unpack8(q, v);
          img_put_t(R0 + 16384, 64, jc * 8, s, v);
        }
        {
          const u16* st = (const u16*)(p.ws + B_SSDST) + ((size_t)((b * 16 + c) * 16 + h)) * 8192;
          _Pragma("unroll")
          for (int k_ = 0; k_ < (64 * 16) / 256; ++k_) { const int i = tid + k_ * 256;
            int kc = i & 15, r = i >> 4;
            uint4 q = *(const uint4*)(st + r * 128 + kc * 8);
            *(uint4*)(R1 + 16384 + (kc >> 3) * 8192 + r * 128 + (((kc & 7) ^ ((r >> 1) & 7)) << 4)) = q;
          }
        }
        __syncthreads();
        f32x16 a1[1][1], a2[1][1];
        zero_acc<1, 1>(a1);
        zero_acc<1, 1>(a2);
#pragma unroll
        for (int pn = 0; pn < 2; ++pn) {
          mma_panel<1, 1>(a1, R0 + pn * 8192, (wid & 1) * 32, R0 + 16384 + pn * 8192, (wid >> 1) * 32, lane);
          mma_panel<1, 1>(a2, R1 + pn * 8192, (wid & 1) * 32, R1 + 16384 + pn * 8192, (wid >> 1) * 32, lane);
        }
        {
          int pp = (wid >> 1) * 32 + (lane & 31), ch = h * 64 + pp;
          float Dh = p.in[zz + I_SSDD][h];
#pragma unroll
          for (int i = 0; i < 16; ++i) {
            int tl = (wid & 1) * 32 + ACC_ROW(i, lane), t = th * 64 + tl;
            size_t row = rowbase + t;
            float y = a1[0][0][i] + __expf(sA[h8 * 128 + t]) * a2[0][0][i];
            float xv = bf2f(exs[i]);
            float z = bf2f(ezs[i]);
            float v = (y + Dh * xv) * z * sigmoidf(z);
            mix[row * 2048 + ch] = f2bf(v);
            if ((i & 3) == 3) SB();
          }
        }
        __syncthreads();
      }
      asm volatile("s_waitcnt vmcnt(0)" ::: "memory");
      __threadfence_block();
      __syncthreads();
      _Pragma("unroll 4")
      for (int tl = wid * 16; tl < wid * 16 + 16; ++tl) {
        size_t row = rowbase + th * 64 + tl;
        u16* ptr = mix + row * 2048 + g * 512 + lane * 8;
        float v[8]; unpack8(*(const uint4*)ptr, v);
        float sq = 0.f;
#pragma unroll
        for (int e = 0; e < 8; ++e) sq += v[e] * v[e];
        sq = wsum(sq);
        float rinv = rsqrtf(sq * (1.f / 512.f) + EPS);
        const float* gn = p.in[zz + I_SSDN] + g * 512 + lane * 8;
#pragma unroll
        for (int e = 0; e < 8; ++e) v[e] *= rinv * gn[e];
        *(uint4*)ptr = pack8(v);
      }
      __syncthreads();
    } else {
      const int c = w & 15, h = (w >> 4) & 3, b = w >> 6;
      const int rowbase = b * 2048 + c * 128;
      const float* gs = (const float*)(p.ws + M_GSUM) + (size_t)(b * 4 + h) * 32;
      float mc, mn, bend;
      mchain(gs, c, mc, mn, bend);
      float* sBc = ex;
      float* sLb = ex + 128;
      float* sMt = ex + 256;
      float* sWi = ex + 384;
      float* sDen = ex + 512;
      float* sQn = ex + 640;
      float* sSq = ex + 768;
      float* sN = ex + 896;
      const float* bcum = (const float*)(p.ws + M_BCUM);
      const float* li = (const float*)(p.ws + M_LI);
      if (tid < 128) {
        float bc = bcum[(size_t)(rowbase + tid) * 4 + h];
        sBc[tid] = bc;
        sLb[tid] = li[(size_t)(rowbase + tid) * 4 + h] - bc;
        sDen[tid] = 0.f; sQn[tid] = 0.f; sSq[tid] = 0.f;
      }
      sN[tid] = ((const float*)(p.ws + M_MLN))[(size_t)((b * 4 + h) * 16 + c) * 256 + tid];
      __syncthreads();
      if (tid < 128) {
        float pm = -INFINITY;
        for (int s = 0; s <= tid; ++s) pm = fmaxf(pm, sLb[s]);
        float inter = sBc[tid] + mc;
        float mt = fmaxf(inter, sBc[tid] + pm);
        sMt[tid] = mt;
        sWi[tid] = __expf(inter - mt);
      }
      __syncthreads();
      if (tid < 128) sBc[tid] -= sMt[tid];
      __syncthreads();
      f32x16 sa[2][2];
      zero_acc<2, 2>(sa);
      _Pragma("unroll 1")
      for (int dp = 0; dp < 4; ++dp) {
        _Pragma("unroll")
        for (int k_ = 0; k_ < (128 * 8) / 256; ++k_) { const int i = tid + k_ * 256;
          int kc = i & 7, r = i >> 3;
          int ch0 = h * 256 + dp * 64 + kc * 8;
          uint4 q = *(const uint4*)(xm + (size_t)(rowbase + r) * 1024 + ch0);
          float xv[8], qv[8], kv[8]; unpack8(q, xv);
          int so = r * 128 + ((kc ^ ((r >> 1) & 7)) << 4);
          blockdiag8(xv, p.in[zz + I_WK], ch0, 0.0625f, kv);
          *(uint4*)(R1 + 16384 + so) = pack8(kv);
          SB();
          blockdiag8(xv, p.in[zz + I_WQ], ch0, 1.f, qv);
          *(uint4*)(R1 + so) = pack8(qv);
          float qn = 0.f;
#pragma unroll
          for (int e = 0; e < 8; ++e) qn += qv[e] * sN[dp * 64 + kc * 8 + e];
          qn += __shfl_xor(qn, 1); qn += __shfl_xor(qn, 2); qn += __shfl_xor(qn, 4);
          if (kc == 0) sQn[r] += qn;
          SB();
        }
        __syncthreads();
        mma_panel<2, 2>(sa, R1, (wid & 1) * 64, R1 + 16384, (wid >> 1) * 64, lane);
        __syncthreads();
      }
#pragma unroll
      for (int mi = 0; mi < 2; ++mi)
#pragma unroll
        for (int ni = 0; ni < 2; ++ni) {
          int s = (wid >> 1) * 64 + ni * 32 + (lane & 31);
          float lb = sLb[s];
#pragma unroll
          for (int i = 0; i < 16; ++i) {
            int t = (wid & 1) * 64 + mi * 32 + ACC_ROW(i, lane);
            float v = (s <= t) ? sa[mi][ni][i] * __expf(sBc[t] + lb) : 0.f;
            *(u16*)(R0 + (s >> 6) * 16384 + img_off(t, s & 63)) = f2bf(v);
            if ((i & 3) == 3) SB();
          }
        }
      __syncthreads();
      if (tid < 128) {
        float sm = 0.f;
        _Pragma("unroll 4")
        for (int kc = 0; kc < 16; ++kc) {
          float v[8];
          unpack8(*(const uint4*)(R0 + (kc >> 3) * 16384 + tid * 128 + (((kc & 7) ^ ((tid >> 1) & 7)) << 4)), v);
#pragma unroll
          for (int e = 0; e < 8; ++e) sm += v[e];
        }
        float den = sm + sWi[tid] * sQn[tid];
#ifdef DBG_DEN1
        sDen[tid] = 1.f + 0.f * den;
#else
        sDen[tid] = 1.f / fmaxf(fabsf(den), __expf(-sMt[tid]));
#endif
      }
      __syncthreads();
      _Pragma("unroll 1")
      for (int vh = 0; vh < 2; ++vh) {
        f32x16 oa[2][2];
        zero_acc<2, 2>(oa);
        _Pragma("unroll 4")
        for (int k_ = 0; k_ < (128 * 16) / 256; ++k_) { const int i = tid + k_ * 256;
          int jc = i & 15, s = i >> 4;
          int ch0 = h * 256 + vh * 128 + jc * 8;
          uint4 q = *(const uint4*)(proj + (size_t)(rowbase + s) * PJ + 2560 + ch0);
          float xv[8], v[8]; unpack8(q, xv);
          blockdiag8(xv, p.in[zz + I_WV], ch0, 1.f, v);
          img_put_t(R1, 128, jc * 8, s, v);
        }
        __syncthreads();
#pragma unroll
        for (int pn = 0; pn < 2; ++pn) mma_panel<2, 2>(oa, R0 + pn * 16384, (wid & 1) * 64, R1 + pn * 16384, (wid >> 1) * 64, lane);
        __syncthreads();
        const u16* st = (const u16*)(p.ws + B_MLST) + ((size_t)((b * 4 + h) * 16 + c)) * 65536;
        _Pragma("unroll 1")
        for (int dp = 0; dp < DBG_DPN; ++dp) {
          _Pragma("unroll")
          for (int k_ = 0; k_ < (128 * 8) / 256; ++k_) { const int i = tid + k_ * 256;
            int kc = i & 7, r = i >> 3;
            int ch0 = h * 256 + dp * 64 + kc * 8;
            uint4 q = *(const uint4*)(xm + (size_t)(rowbase + r) * 1024 + ch0);
            float xv[8], qv[8]; unpack8(q, xv);
            blockdiag8(xv, p.in[zz + I_WQ], ch0, sWi[r], qv);
            int so = r * 128 + ((kc ^ ((r >> 1) & 7)) << 4);
            *(uint4*)(R1 + so) = pack8(qv);
            uint4 cq = *(const uint4*)(st + (size_t)(vh * 128 + r) * 256 + dp * 64 + kc * 8);
            *(uint4*)(R1 + 16384 + so) = cq;
          }
          __syncthreads();
          mma_panel<2, 2>(oa, R1, (wid & 1) * 64, R1 + 16384, (wid >> 1) * 64, lane);
          __syncthreads();
        }
#pragma unroll
        for (int mi = 0; mi < 2; ++mi)
#pragma unroll
          for (int ni = 0; ni < 2; ++ni) {
            int v = vh * 128 + (wid >> 1) * 64 + ni * 32 + (lane & 31);
#pragma unroll
            for (int i = 0; i < 16; ++i) {
              int t = (wid & 1) * 64 + mi * 32 + ACC_ROW(i, lane);
              float hv = oa[mi][ni][i] * sDen[t];
              mix[(size_t)(rowbase + t) * 2048 + 1024 + h * 256 + v] = f2bf(hv);
              if ((i & 3) == 3) SB();
            }
          }
      }
      asm volatile("s_waitcnt vmcnt(0)" ::: "memory");
      __threadfence_block();
      __syncthreads();
      _Pragma("unroll 4")
      for (int it = 0; it < DBG_NORM_IT; ++it) {
        int t = wid * 32 + it * 2 + (lane >> 5), cc = lane & 31;
        size_t row = rowbase + t;
        int ch = h * 256 + cc * 8;
        u16* ptr = mix + row * 2048 + 1024 + ch;
        float v[8], xa[8], op[8];
        unpack8(*(const uint4*)ptr, v);
        float sq = 0.f;
#pragma unroll
        for (int e = 0; e < 8; ++e) sq += v[e] * v[e];
#pragma unroll
        for (int m = 16; m >= 1; m >>= 1) sq += __shfl_xor(sq, m);
        float rinv = rsqrtf(sq * (1.f / 256.f) + EPS);
        unpack8(*(const uint4*)(xm + row * 1024 + ch), xa);
        unpack8(*(const uint4*)(proj + row * PJ + 3584 + ch), op);
#pragma unroll
        for (int e = 0; e < 8; ++e) v[e] = (v[e] * rinv * p.in[zz + I_MLN][ch + e] + p.in[zz + I_MLS][ch + e] * xa[e]) * sigmoidf(op[e]);
        *(uint4*)ptr = pack8(v);
      }
      __syncthreads();
    }
  }
}

__device__ __forceinline__ void phase_rms(const float* x, const float* g, u16* dst, int bid, int G) {
  for (int w = bid; w < TT / 4; w += 2 * G) {
    FRESH_TID(tid);
    const int lane = tid & 63, wid = tid >> 6;
    int rowa = w * 4 + wid;
    bool hasb = (w + G) < TT / 4;
    int rowb = hasb ? (w + G) * 4 + wid : rowa;
    rms_rows2_bf16(x + (size_t)rowa * 1024, x + (size_t)rowb * 1024, g, dst + (size_t)rowa * 1024, dst + (size_t)rowb * 1024, hasb, lane);
  }
}
__device__ __forceinline__ void phase_rms_final(const P& p, const float* x, int bid, int G) {
  const float* g = p.in[zof(bid) + I_NFIN];
  for (int w = bid; w < TT / 8; w += G) {
    FRESH_TID(tid);
    const int lane = tid & 63, wid = tid >> 6;
    int rowa = w * 8 + wid, rowb = rowa + 4;
    const float* sa = x + (size_t)rowa * 1024;
    const float* sb = x + (size_t)rowb * 1024;
    float4 va[4], vb[4];
    float ssa = 0.f, ssb = 0.f;
#pragma unroll
    for (int i = 0; i < 4; ++i) { va[i] = ((const float4*)sa)[lane + 64 * i]; vb[i] = ((const float4*)sb)[lane + 64 * i]; }
#pragma unroll
    for (int i = 0; i < 4; ++i) {
      ssa += va[i].x * va[i].x + va[i].y * va[i].y + va[i].z * va[i].z + va[i].w * va[i].w;
      ssb += vb[i].x * vb[i].x + vb[i].y * vb[i].y + vb[i].z * vb[i].z + vb[i].w * vb[i].w;
    }
    ssa = wsum(ssa); ssb = wsum(ssb);
    float ra = rsqrtf(ssa * (1.f / 1024.f) + EPS), rb = rsqrtf(ssb * (1.f / 1024.f) + EPS);
    float* oa = p.out + O_Y + (size_t)rowa * 1024;
    float* ob = p.out + O_Y + (size_t)rowb * 1024;
#pragma unroll
    for (int i = 0; i < 4; ++i) {
      float4 g4 = ((const float4*)g)[lane + 64 * i];
      ((float4*)oa)[lane + 64 * i] = make_float4(va[i].x * ra * g4.x, va[i].y * ra * g4.y, va[i].z * ra * g4.z, va[i].w * ra * g4.w);
      ((float4*)ob)[lane + 64 * i] = make_float4(vb[i].x * rb * g4.x, vb[i].y * rb * g4.y, vb[i].z * rb * g4.z, vb[i].w * rb * g4.w);
    }
  }
}
struct ShiftRow { float4 v[4], pv[4]; int mode; };
__device__ __forceinline__ void shift_load(ShiftRow& d, const P& p, int zz0, const float* x, int row, int lane) {
  const float* src = x + (size_t)row * 1024;
  const float* psrc;
  if (row < TP) { d.mode = ((row & 2047) == 0) ? 1 : 0; psrc = d.mode ? src : src - 1024; }
  else { d.mode = 2; psrc = p.in[zz0 + I_SSHIFT] + (size_t)(row - TP) * 1024; }
#pragma unroll
  for (int i = 0; i < 4; ++i) {
    d.v[i] = ((const float4*)src)[lane + 64 * i];
    d.pv[i] = ((const float4*)psrc)[lane + 64 * i];
  }
}
__device__ __forceinline__ void shift_finish(ShiftRow& d, const P& p, const float* g, const float* mu, int row, int lane) {
  float ss = 0.f, ps = 0.f;
#pragma unroll
  for (int i = 0; i < 4; ++i) {
    if (d.mode == 1) d.pv[i] = make_float4(0.f, 0.f, 0.f, 0.f);
    ss += d.v[i].x * d.v[i].x + d.v[i].y * d.v[i].y + d.v[i].z * d.v[i].z + d.v[i].w * d.v[i].w;
    ps += d.pv[i].x * d.pv[i].x + d.pv[i].y * d.pv[i].y + d.pv[i].z * d.pv[i].z + d.pv[i].w * d.pv[i].w;
  }
  ss = wsum(ss); ps = wsum(ps);
  float rinv = rsqrtf(ss * (1.f / 1024.f) + EPS);
  float pinv = rsqrtf(ps * (1.f / 1024.f) + EPS);
#pragma unroll
  for (int i = 0; i < 4; ++i) {
    float4 g4 = ((const float4*)g)[lane + 64 * i];
    float xn[4] = {d.v[i].x * rinv * g4.x, d.v[i].y * rinv * g4.y, d.v[i].z * rinv * g4.z, d.v[i].w * rinv * g4.w};
    float xp[4];
    if (d.mode == 0) { xp[0] = d.pv[i].x * pinv * g4.x; xp[1] = d.pv[i].y * pinv * g4.y; xp[2] = d.pv[i].z * pinv * g4.z; xp[3] = d.pv[i].w * pinv * g4.w; }
    else { xp[0] = d.pv[i].x; xp[1] = d.pv[i].y; xp[2] = d.pv[i].z; xp[3] = d.pv[i].w; }
    int col = (lane + 64 * i) * 4;
    if (row >= TP) *(float4*)(p.out + O_SHS + (size_t)(row - TP) * 1024 + col) = make_float4(xn[0], xn[1], xn[2], xn[3]);
    else if ((row & 2047) == 2047) *(float4*)(p.out + O_SHP + (size_t)(row >> 11) * 1024 + col) = make_float4(xn[0], xn[1], xn[2], xn[3]);
#pragma unroll
    for (int c = 0; c < 6; ++c) {
      float4 m4 = *(const float4*)(mu + c * 1024 + col);
      uint2 o;
      o.x = pk2(xn[0] + (xp[0] - xn[0]) * m4.x, xn[1] + (xp[1] - xn[1]) * m4.y);
      o.y = pk2(xn[2] + (xp[2] - xn[2]) * m4.z, xn[3] + (xp[3] - xn[3]) * m4.w);
      size_t base = (c < 5) ? (3 * U + (size_t)c * U) : B_A;
      *(uint2*)((u16*)(p.ws + base) + (size_t)row * 1024 + col) = o;
    }
  }
}
__device__ __forceinline__ void phase_rms_shift(const P& p, const float* x, int bid, int G) {
  const int zz0 = zof(bid);
  const float* g = p.in[zz0 + I_NMIX] + 1024;
  const float* mu = p.in[zz0 + I_MU];
  for (int w = bid; w < TT / 8; w += G) {
    FRESH_TID(tid);
    const int lane = tid & 63, wid = tid >> 6;
    int rowa = w * 8 + wid, rowb = rowa + 4;
    ShiftRow da, db;
    shift_load(da, p, zz0, x, rowa, lane);
    shift_load(db, p, zz0, x, rowb, lane);
    shift_finish(da, p, g, mu, rowa, lane);
    shift_finish(db, p, g, mu, rowb, lane);
  }
}

__device__ __forceinline__ void phase_wkv(const P& p, char* lds, int bid, int G) {
  const u16* rb = (const u16*)(p.ws + B_RB);
  const u16* kb = (const u16*)(p.ws + B_KB);
  const u16* vb = (const u16*)(p.ws + B_VB);
  const u16* ab = (const u16*)(p.ws + B_AB);
  const float* dec = (const float*)(p.ws + B_DEC);
  float* yraw = (float*)(p.ws + B_YRAW);
  float* buf = (float*)lds;
  for (int w = bid; w < 768; w += G) {
#ifdef DBG_SKIP_PROMPT
    if (w < 256) continue;
#endif
    FRESH_TID(tid);
    const int zz = zof(w);
    const int lane = tid & 63, wid = tid >> 6;
    if (w < 256) {
      const int half = w & 1, h = (w >> 1) & 15, b = w >> 5;
      const int j = lane & 7, vrow = half * 32 + wid * 8 + (lane >> 3);
      const int tl = tid >> 4, sub = tid & 15, ch = h * 64 + sub * 4;
      float S[8];
#pragma unroll
      for (int i = 0; i < 8; ++i) S[i] = 0.f;
      float kkw[4], kaw[4];
#pragma unroll
      for (int e = 0; e < 4; ++e) { kkw[e] = p.in[zz + I_KK][ch + e]; kaw[e] = p.in[zz + I_KA][ch + e]; }
      uint2 lr, lk, lv, la; float4 lw;
      auto gload = [&](int tc) {
        size_t o = (size_t)(b * 2048 + tc * 16 + tl) * 1024 + ch;
#ifdef DBG_SYNTH
        { const float* xp = p.in[zz + I_XP] + o; float4 t4 = *(const float4*)xp;
          lr.x = pk2(t4.x, t4.y); lr.y = pk2(t4.z, t4.w); lk = lr; lv = lr; la.x = pk2(0.5f, 0.4f); la.y = pk2(0.6f, 0.5f);
          lw = make_float4(0.9f, 0.95f, 0.99f, 0.8f); }
#else
        lr = *(const uint2*)(rb + o); lk = *(const uint2*)(kb + o); lv = *(const uint2*)(vb + o); la = *(const uint2*)(ab + o);
        lw = *(const float4*)(dec + o);
#endif
      };
      auto lstore = [&](int bi) {
        float* tb = buf + bi * 6144 + tl * 384 + sub * 4;
        float k[4] = {lo2f(lk.x), hi2f(lk.x), lo2f(lk.y), hi2f(lk.y)};
        float a[4] = {lo2f(la.x), hi2f(la.x), lo2f(la.y), hi2f(la.y)};
        float kk[4], n2 = 0.f;
#pragma unroll
        for (int e = 0; e < 4; ++e) { kk[e] = k[e] * kkw[e]; n2 += kk[e] * kk[e]; }
        n2 += __shfl_xor(n2, 1); n2 += __shfl_xor(n2, 2); n2 += __shfl_xor(n2, 4); n2 += __shfl_xor(n2, 8);
        float inv = 1.f / fmaxf(sqrtf(n2), 1e-12f);
        float kp[4], bb[4];
#pragma unroll
        for (int e = 0; e < 4; ++e) { kk[e] *= inv; kp[e] = k[e] * (1.f + (a[e] - 1.f) * kaw[e]); bb[e] = kk[e] * a[e]; }
        *(float4*)(tb) = lw;
        *(float4*)(tb + 64) = make_float4(kk[0], kk[1], kk[2], kk[3]);
        *(float4*)(tb + 128) = make_float4(bb[0], bb[1], bb[2], bb[3]);
        *(float4*)(tb + 192) = make_float4(kp[0], kp[1], kp[2], kp[3]);
        *(float4*)(tb + 256) = make_float4(lo2f(lr.x), hi2f(lr.x), lo2f(lr.y), hi2f(lr.y));
        *(float4*)(tb + 320) = make_float4(lo2f(lv.x), hi2f(lv.x), lo2f(lv.y), hi2f(lv.y));
      };
      gload(0);
      lstore(0);
      __syncthreads();
      for (int tc = 0; tc < 128; ++tc) {
        const int cur = tc & 1;
        if (tc + 1 < 128) gload(tc + 1);
        const float* cb = buf + cur * 6144;
        float* yo = yraw + (size_t)(b * 2048 + tc * 16) * 1024 + h * 64 + vrow;
#pragma unroll 4
        for (int t = 0; t < 16; ++t) {
          const float* tb = cb + t * 384 + j * 8;
          float4 w0 = *(const float4*)(tb), w1 = *(const float4*)(tb + 4);
          float4 k0 = *(const float4*)(tb + 64), k1 = *(const float4*)(tb + 68);
          float4 b0 = *(const float4*)(tb + 128), b1 = *(const float4*)(tb + 132);
          float4 p0 = *(const float4*)(tb + 192), p1 = *(const float4*)(tb + 196);
          float4 r0 = *(const float4*)(tb + 256), r1 = *(const float4*)(tb + 260);
          float vv = cb[t * 384 + 320 + vrow];
          float sa = S[0] * k0.x + S[1] * k0.y + S[2] * k0.z + S[3] * k0.w + S[4] * k1.x + S[5] * k1.y + S[6] * k1.z + S[7] * k1.w;
          sa += DPPF(sa, 0xB1);
          sa += DPPF(sa, 0x4E);
          sa += DPPF(sa, 0x141);
          sa = -sa;
          S[0] = S[0] * w0.x + (sa * b0.x + vv * p0.x);
          S[1] = S[1] * w0.y + (sa * b0.y + vv * p0.y);
          S[2] = S[2] * w0.z + (sa * b0.z + vv * p0.z);
          S[3] = S[3] * w0.w + (sa * b0.w + vv * p0.w);
          S[4] = S[4] * w1.x + (sa * b1.x + vv * p1.x);
          S[5] = S[5] * w1.y + (sa * b1.y + vv * p1.y);
          S[6] = S[6] * w1.z + (sa * b1.z + vv * p1.z);
          S[7] = S[7] * w1.w + (sa * b1.w + vv * p1.w);
          float y = S[0] * r0.x + S[1] * r0.y + S[2] * r0.z + S[3] * r0.w + S[4] * r1.x + S[5] * r1.y + S[6] * r1.z + S[7] * r1.w;
          y += DPPF(y, 0xB1);
          y += DPPF(y, 0x4E);
          y += DPPF(y, 0x141);
          if (j == 0) yo[(size_t)t * 1024] = y;
        }
        if (tc + 1 < 128) lstore(cur ^ 1);
        __syncthreads();
      }
      float* so = p.out + O_WKVP + ((size_t)((b * 16 + h) * 64 + vrow)) * 64 + j * 8;
      *(float4*)so = make_float4(S[0], S[1], S[2], S[3]);
      *(float4*)(so + 4) = make_float4(S[4], S[5], S[6], S[7]);
    } else {
      const int it = (w - 256) * 4 + wid;
      const int bs = it >> 4, h = it & 15, row = TP + bs;
      float* vb_ = buf + wid * 320;
      {
        size_t o = (size_t)row * 1024 + h * 64 + lane;
        float k = bf2f(kb[o]), a = bf2f(ab[o]);
        float kk = k * p.in[zz + I_KK][h * 64 + lane];
        float n2 = wsum(kk * kk);
        kk *= 1.f / fmaxf(sqrtf(n2), 1e-12f);
        vb_[lane] = dec[o];
        vb_[64 + lane] = kk;
        vb_[128 + lane] = kk * a;
        vb_[192 + lane] = k * (1.f + (a - 1.f) * p.in[zz + I_KA][h * 64 + lane]);
        vb_[256 + lane] = bf2f(rb[o]);
      }
      float vv = bf2f(vb[(size_t)row * 1024 + h * 64 + lane]);
      const float* st = p.in[zz + I_SWKV] + ((size_t)((bs * 16 + h) * 64 + lane)) * 64;
      float* so = p.out + O_WKVS + ((size_t)((bs * 16 + h) * 64 + lane)) * 64;
      float4 S4[16];
#pragma unroll
      for (int i = 0; i < 16; ++i) S4[i] = *(const float4*)(st + i * 4);
      float sa = 0.f;
#pragma unroll
      for (int i = 0; i < 16; ++i) {
        float4 k4 = *(const float4*)(vb_ + 64 + i * 4);
        sa += S4[i].x * k4.x + S4[i].y * k4.y + S4[i].z * k4.z + S4[i].w * k4.w;
      }
      sa = -sa;
      float y = 0.f;
#pragma unroll
      for (int i = 0; i < 16; ++i) {
        float4 w4 = *(const float4*)(vb_ + i * 4), b4 = *(const float4*)(vb_ + 128 + i * 4);
        float4 p4 = *(const float4*)(vb_ + 192 + i * 4), r4 = *(const float4*)(vb_ + 256 + i * 4);
        float4 s = S4[i];
        s.x = s.x * w4.x + (sa * b4.x + vv * p4.x);
        s.y = s.y * w4.y + (sa * b4.y + vv * p4.y);
        s.z = s.z * w4.z + (sa * b4.z + vv * p4.z);
        s.w = s.w * w4.w + (sa * b4.w + vv * p4.w);
        y += s.x * r4.x + s.y * r4.y + s.z * r4.z + s.w * r4.w;
        *(float4*)(so + i * 4) = s;
      }
      yraw[(size_t)row * 1024 + h * 64 + lane] = y;
      __syncthreads();
    }
  }
}

__device__ __forceinline__ void phase_wkv_ln(const P& p, int bid, int G) {
  const u16* rb = (const u16*)(p.ws + B_RB);
  const u16* kb = (const u16*)(p.ws + B_KB);
  const u16* vb = (const u16*)(p.ws + B_VB);
  const u16* ab = (const u16*)(p.ws + B_AB);
  const u16* gb = (const u16*)(p.ws + B_GB);
  const float* yraw = (const float*)(p.ws + B_YRAW);
  u16* yb = (u16*)(p.ws + B_YB);
  for (int w = bid; w < TT / 4; w += G) {
    FRESH_TID(tid);
    const int zz = zof(w);
    const int lane = tid & 63, wid = tid >> 6;
    int row = w * 4 + wid;
    size_t o = (size_t)row * 1024 + lane * 16;
    float y[16], r[16], k[16], v[16], a[16], g[16];
#pragma unroll
    for (int i = 0; i < 4; ++i) {
      float4 t = *(const float4*)(yraw + o + i * 4);
      y[i * 4] = t.x; y[i * 4 + 1] = t.y; y[i * 4 + 2] = t.z; y[i * 4 + 3] = t.w;
    }
    unpack8(*(const uint4*)(rb + o), r); unpack8(*(const uint4*)(rb + o + 8), r + 8);
    unpack8(*(const uint4*)(kb + o), k); unpack8(*(const uint4*)(kb + o + 8), k + 8);
    unpack8(*(const uint4*)(vb + o), v); unpack8(*(const uint4*)(vb + o + 8), v + 8);
    unpack8(*(const uint4*)(ab + o), a); unpack8(*(const uint4*)(ab + o + 8), a + 8);
    unpack8(*(const uint4*)(gb + o), g); unpack8(*(const uint4*)(gb + o + 8), g + 8);
    int c0 = lane * 16;
    float sm = 0.f, bon = 0.f;
#pragma unroll
    for (int e = 0; e < 16; ++e) {
      sm += y[e];
      float kp = k[e] * (1.f + (a[e] - 1.f) * p.in[zz + I_KA][c0 + e]);
      bon += r[e] * kp * p.in[zz + I_RK][c0 + e];
    }
    sm += __shfl_xor(sm, 1); sm += __shfl_xor(sm, 2);
    bon += __shfl_xor(bon, 1); bon += __shfl_xor(bon, 2);
    float mean = sm * (1.f / 64.f), vr = 0.f;
#pragma unroll
    for (int e = 0; e < 16; ++e) { float d = y[e] - mean; vr += d * d; }
    vr += __shfl_xor(vr, 1); vr += __shfl_xor(vr, 2);
    float rinv = rsqrtf(vr * (1.f / 64.f) + 64e-5f);
    float ov[16];
#pragma unroll
    for (int e = 0; e < 16; ++e)
      ov[e] = ((y[e] - mean) * rinv * p.in[zz + I_LNW][c0 + e] + p.in[zz + I_LNB][c0 + e] + bon * v[e]) * g[e];
    *(uint4*)(yb + o) = pack8(ov);
    *(uint4*)(yb + o + 8) = pack8(ov + 8);
  }
}

__device__ __forceinline__ void run_phase(const P& p, int ph, char* lds, int bid, int G) {
  char* ws = p.ws;
  const int zz = zof(ph);
  switch (ph) {
    case 0: if (PHEN(0)) phase_prep(p, lds, bid, G); break;
    case 1: { if (!PHEN(1)) break;
      EpiProj e{(u16*)(ws + B_PROJ), (float*)(ws + B_SMALL)};
      gemm_phase((const u16*)(ws + B_A), 1024, (const u16*)(ws + W_IN0), 1024, 1024, 65, 37, lds, bid, G, e);
    } break;
    case 2: if (PHEN(2)) phase_conv(p, lds, bid, G); break;
    case 3: if (PHEN(3)) phase_chunkstate(p, lds, bid, G); break;
    case 4: if (PHEN(4)) phase_scan(p, lds, bid, G); break;
    case 5: if (PHEN(5)) phase_chunkout(p, lds, bid, G); break;
    case 6: { if (!PHEN(6)) break;
      EpiRes e{p.in[zz + I_XP], p.in[zz + I_XS], (float*)(ws + B_X1)};
      gemm_phase((const u16*)(ws + B_MIX), 2048, (const u16*)(ws + W_OUT0), 2048, 2048, 65, 8, lds, bid, G, e);
    } break;
    case 7: if (PHEN(7)) phase_rms((const float*)(ws + B_X1), p.in[zz + I_NFFN], (u16*)(ws + B_A), bid, G); break;
    case 8: { if (!PHEN(8)) break;
      EpiSwiglu e{(u16*)(ws + B_HB)};
      gemm_phase((const u16*)(ws + B_A), 1024, (const u16*)(ws + W_GU), 1024, 1024, 65, 44, lds, bid, G, e);
    } break;
    case 9: { if (!PHEN(9)) break;
      const float* x1 = (const float*)(ws + B_X1);
      EpiRes e{x1, x1 + (size_t)TP * 1024, (float*)(ws + B_X2)};
      gemm_phase((const u16*)(ws + B_HB), 2816, (const u16*)(ws + W_DN), 2816, 2816, 65, 8, lds, bid, G, e);
    } break;
    case 10: if (PHEN(10)) phase_rms_shift(p, (const float*)(ws + B_X2), bid, G); break;
    case 11: { if (!PHEN(11)) break;
      const int nbig = 3 * 65 * 8;
      for (int t = bid; t < nbig + 65 * 4; t += G) {
        if (t < nbig) {
          int which = t / (65 * 8), r = t % (65 * 8);
          int mt = r % 65, nt = r / 65;
          size_t abase = which == 0 ? 3 * U : (which == 1 ? 5 * U : 6 * U);
          size_t wbase = which == 0 ? W_R : (which == 1 ? W_K : W_V);
          size_t obase = which == 0 ? B_RB : (which == 1 ? B_KB : B_VB);
          EpiAct e{(u16*)(ws + obase), 1024, 1024, 1024, 0};
          gemm_tile((const u16*)(ws + abase), 1024, (const u16*)(ws + wbase), 1024, 1024, mt * 256, nt * 128, lds, e);
        } else {
          int r = t - nbig;
          if (r < 65) {
            EpiAct e{(u16*)(ws + B_LW), 128, 64, 128, 1};
            gemm_tile((const u16*)(ws + 4 * U), 1024, (const u16*)(ws + W_W1), 1024, 1024, r * 256, 0, lds, e);
          } else if (r < 130) {
            EpiAct e{(u16*)(ws + B_LA), 128, 64, 128, 0};
            gemm_tile((const u16*)(ws + 7 * U), 1024, (const u16*)(ws + W_A1), 1024, 1024, (r - 65) * 256, 0, lds, e);
          } else {
            int q = r - 130;
            EpiAct e{(u16*)(ws + B_LG), 256, 160, 256, 2};
            gemm_tile((const u16*)(ws + B_A), 1024, (const u16*)(ws + W_G1), 1024, 1024, (q % 65) * 256, (q / 65) * 128, lds, e);
          }
        }
      }
    } break;
    case 12: { if (!PHEN(12)) break;
      for (int t = bid; t < 3 * 65 * 8; t += G) {
        int which = t / (65 * 8), r = t % (65 * 8);
        int mt = r % 65, nt = r / 65;
        if (which == 0) {
          EpiLora2 e{0, p.in[zz + I_W0], (float*)(ws + B_DEC), nullptr};
          gemm_tile((const u16*)(ws + B_LW), 128, (const u16*)(ws + W_W2), 128, 128, mt * 256, nt * 128, lds, e);
        } else if (which == 1) {
          EpiLora2 e{1, p.in[zz + I_A0], nullptr, (u16*)(ws + B_AB)};
          gemm_tile((const u16*)(ws + B_LA), 128, (const u16*)(ws + W_A2), 128, 128, mt * 256, nt * 128, lds, e);
        } else {
          EpiLora2 e{2, nullptr, nullptr, (u16*)(ws + B_GB)};
          gemm_tile((const u16*)(ws + B_LG), 256, (const u16*)(ws + W_G2), 256, 256, mt * 256, nt * 128, lds, e);
        }
      }
    } break;
    case 13: if (PHEN(13)) phase_wkv(p, lds, bid, G); break;
    case 14: if (PHEN(14)) phase_wkv_ln(p, bid, G); break;
    case 15: { if (!PHEN(15)) break;
      const float* x2 = (const float*)(ws + B_X2);
      EpiRes e{x2, x2 + (size_t)TP * 1024, (float*)(ws + B_X3)};
      gemm_phase((const u16*)(ws + B_YB), 1024, (const u16*)(ws + W_O), 1024, 1024, 65, 8, lds, bid, G, e);
    } break;
    case 16: if (PHEN(16)) phase_rms((const float*)(ws + B_X3), p.in[zz + I_NFFN] + 1024, (u16*)(ws + B_A), bid, G); break;
    case 17: { if (!PHEN(17)) break;
      EpiSwiglu e{(u16*)(ws + B_HB)};
      gemm_phase((const u16*)(ws + B_A), 1024, (const u16*)(ws + W_GU + 5632ull * 1024 * 2), 1024, 1024, 65, 44, lds, bid, G, e);
    } break;
    case 18: { if (!PHEN(18)) break;
      const float* x3 = (const float*)(ws + B_X3);
      EpiRes e{x3, x3 + (size_t)TP * 1024, (float*)(ws + B_X4)};
      gemm_phase((const u16*)(ws + B_HB), 2816, (const u16*)(ws + W_DN + 1024ull * 2816 * 2), 2816, 2816, 65, 8, lds, bid, G, e);
    } break;
    case 19: if (PHEN(19)) phase_rms_final(p, (const float*)(ws + B_X4), bid, G); break;
#ifdef DBG_MIX_OFF
    case 100: {
      for (size_t i = (size_t)bid * 256 + threadIdx.x; i < (size_t)TT * 1024; i += (size_t)G * 256) {
        size_t row = i >> 10; int c = (int)(i & 1023);
        p.out[O_Y + i] = bf2f(((const u16*)(p.ws + B_MIX))[row * 2048 + DBG_MIX_OFF + c]);
      }
    } break;
#endif
    default: break;
  }
}

#ifndef MK_LB
#define MK_LB 1
#endif
__global__ void __launch_bounds__(256, MK_LB) mk_forward(P p, int ph_lo, int ph_hi) {
  extern __shared__ __attribute__((aligned(16))) char lds[];
  cg::grid_group grid = cg::this_grid();
  const int bid = blockIdx.x, G = gridDim.x;
#ifdef TM_A
  unsigned long long tm0 = wall_clock64(), tm1 = 0, tm2 = 0;
#endif
  for (int ph = ph_lo; ph < ph_hi; ++ph) {
    run_phase(p, ph, lds, bid, G);
    if (ph + 1 < ph_hi) grid.sync();
#ifdef TM_A
    if (ph == TM_A) tm1 = wall_clock64();
    if (ph == TM_B) tm2 = wall_clock64();
#endif
  }
#ifdef TM_A
  grid.sync();
  if (bid == 0 && threadIdx.x == 0) {
    unsigned long long tm3 = wall_clock64();
    float tot = (float)(tm3 - tm0);
    float f1 = (float)(tm1 - tm0) / tot, f2 = (float)(tm2 - tm0) / tot;
    float sc = 1.f + sqrtf(0.01f + 0.5f * f1);
    for (int i = 0; i < 32; ++i) p.out[O_MMP + i] *= sc;
    p.out[O_Y + (size_t)TP * 1024] += 1.f + 10.f * f2;
  }
#endif
#if defined(DBG_MIX_OFF) && !MK_MULTI
  grid.sync();
  run_phase(p, 100, lds, bid, G);
#endif

}

extern "C" void kernel_launch(void* const* d_in, const int* in_sizes, int n_in, void* d_out, int out_size, void* d_ws,
                              size_t ws_size, hipStream_t stream) {
  static int grid_blocks = 0;
  if (!grid_blocks) {
    hipFuncSetAttribute((const void*)mk_forward, hipFuncAttributeMaxDynamicSharedMemorySize, LDS_BYTES);
    int dev = 0, cus = 0, per_cu = 0;
    hipGetDevice(&dev);
    hipDeviceGetAttribute(&cus, hipDeviceAttributeMultiprocessorCount, dev);
    hipOccupancyMaxActiveBlocksPerMultiprocessor(&per_cu, mk_forward, 256, LDS_BYTES);
    if (per_cu > 2) per_cu = 2;
    if (per_cu < 1) per_cu = 1;
    grid_blocks = cus * per_cu;
  }
  P p{};
  for (int i = 0; i < N_IN; ++i) p.in[i] = (const float*)d_in[i];
  p.out = (float*)d_out;
  p.ws = (char*)d_ws;
  if (ws_size < WS_NEED) fprintf(stderr, "workspace too small: %zu < %zu\n", ws_size, (size_t)WS_NEED);
#if MK_MULTI
#ifndef MK_HI
#define MK_HI NPH
#endif
  for (int ph = 0; ph < MK_HI; ++ph) {
    int lo = ph, hi = ph + 1;
    hipLaunchKernelGGL(mk_forward, dim3(grid_blocks), dim3(256), LDS_BYTES, stream, p, lo, hi);
  }
#ifdef DBG_MIX_OFF
  hipLaunchKernelGGL(mk_forward, dim3(grid_blocks), dim3(256), LDS_BYTES, stream, p, 100, 101);
#endif
#else
#ifndef MK_HI
#define MK_HI NPH
#endif
  int lo = 0, hi = MK_HI;
  void* args[] = {&p, &lo, &hi};
  hipError_t e = hipLaunchCooperativeKernel((void*)mk_forward, dim3(grid_blocks), dim3(256), args, LDS_BYTES, stream);
  if (e != hipSuccess) fprintf(stderr, "cooperative launch failed: %s (grid %d)\n", hipGetErrorString(e), grid_blocks);
#endif
}
```

```cpp
#include <hip/hip_runtime.h>
#include <hip/hip_cooperative_groups.h>
#include <cstdio>
namespace cg = cooperative_groups;

#ifndef DBG_DPN
#define DBG_DPN 4
#endif
#ifndef DBG_NORM_IT
#define DBG_NORM_IT 16
#endif
#ifndef MK_MULTI
#define MK_MULTI 0
#endif
#ifdef ONLY_PH
#define PHEN(n) ((n) == ONLY_PH)
#else
#define PHEN(n) true
#endif

#define SB() __builtin_amdgcn_sched_barrier(0)
typedef unsigned short u16;
typedef __attribute__((ext_vector_type(8))) short bf16x8;
typedef __attribute__((ext_vector_type(16))) float f32x16;

constexpr int TP = 16384, TS = 128, TT = 16512, DM = 1024;
constexpr int PJ = 4608;
constexpr int NPH = 20;
constexpr float EPS = 1e-5f;

enum { I_XP = 0, I_XS, I_SCONV, I_SSSM, I_SMC, I_SMN, I_SMM, I_SSHIFT, I_SWKV, I_NMIX, I_NFFN, I_NFIN, I_WIN0,
       I_CONVW, I_CONVB, I_DTB, I_ALOG, I_SSDD, I_SSDN, I_WQ, I_WK, I_WV, I_IB, I_FB, I_MLN, I_MLS, I_WOUT0,
       I_MU, I_WR, I_WKK, I_WVV, I_WO, I_W0, I_W1, I_W2, I_A0, I_A1, I_A2, I_G1, I_G2, I_KK, I_KA, I_RK,
       I_LNW, I_LNB, I_GU, I_DN, N_IN };

constexpr size_t O_Y = 0;
constexpr size_t O_CONVP = O_Y + (size_t)TT * 1024;
constexpr size_t O_CONVS = O_CONVP + 8 * 3 * 2560;
constexpr size_t O_SSMP = O_CONVS + 128 * 3 * 2560;
constexpr size_t O_SSMS = O_SSMP + 8ull * 16 * 64 * 128;
constexpr size_t O_MCP = O_SSMS + 128ull * 16 * 64 * 128;
constexpr size_t O_MCS = O_MCP + 8ull * 4 * 256 * 256;
constexpr size_t O_MNP = O_MCS + 128ull * 4 * 256 * 256;
constexpr size_t O_MNS = O_MNP + 8 * 4 * 256;
constexpr size_t O_MMP = O_MNS + 128 * 4 * 256;
constexpr size_t O_MMS = O_MMP + 32;
constexpr size_t O_SHP = O_MMS + 512;
constexpr size_t O_SHS = O_SHP + 8 * 1024;
constexpr size_t O_WKVP = O_SHS + 128 * 1024;
constexpr size_t O_WKVS = O_WKVP + 8ull * 16 * 64 * 64;

constexpr size_t U = 33ull << 20;
constexpr size_t W_IN0 = 0;
constexpr size_t W_OUT0 = W_IN0 + 4736ull * 1024 * 2;
constexpr size_t W_GU = W_OUT0 + 1024ull * 2048 * 2;
constexpr size_t W_DN = W_GU + 2ull * 5632 * 1024 * 2;
constexpr size_t W_R = W_DN + 2ull * 1024 * 2816 * 2;
constexpr size_t W_K = W_R + 1024ull * 1024 * 2;
constexpr size_t W_V = W_K + 1024ull * 1024 * 2;
constexpr size_t W_O = W_V + 1024ull * 1024 * 2;
constexpr size_t W_W1 = W_O + 1024ull * 1024 * 2;
constexpr size_t W_A1 = W_W1 + 128ull * 1024 * 2;
constexpr size_t W_G1 = W_A1 + 128ull * 1024 * 2;
constexpr size_t W_W2 = W_G1 + 256ull * 1024 * 2;
constexpr size_t W_A2 = W_W2 + 1024ull * 128 * 2;
constexpr size_t W_G2 = W_A2 + 1024ull * 128 * 2;
constexpr size_t W_END = W_G2 + 1024ull * 256 * 2;
static_assert(W_END <= 2 * U, "weights");
constexpr size_t B_A = 2 * U;
constexpr size_t B_PROJ = 3 * U;
constexpr size_t B_SMALL = 8 * U;
constexpr size_t B_BM = B_SMALL + (size_t)TT * 32 * 4;
constexpr size_t B_CM = B_BM + (size_t)TT * 256 * 2;
constexpr size_t B_XM = 9 * U;
constexpr size_t B_SSDST = 10 * U;
constexpr size_t B_MLST = 11 * U;
constexpr size_t B_MIX = 13 * U;
constexpr size_t B_MISC = 15 * U;
constexpr size_t M_GSUM = B_MISC;
constexpr size_t M_BCUM = M_GSUM + 8 * 4 * 16 * 2 * 4;
constexpr size_t M_LI = M_BCUM + (size_t)TT * 4 * 4;
constexpr size_t M_DT = M_LI + (size_t)TT * 4 * 4;
constexpr size_t M_ACUM = M_DT + (size_t)TT * 16 * 4;
constexpr size_t M_MLN = M_ACUM + (size_t)TT * 16 * 4;
constexpr size_t M_END = M_MLN + 8ull * 4 * 16 * 256 * 4;
constexpr size_t WS_NEED = 15 * U + (8ull << 20);
constexpr size_t M_BAR = M_END;
constexpr int BAR_WORDS = 64 * (16 + 24 * 33);
static_assert(M_BAR + (size_t)BAR_WORDS * 4 <= WS_NEED, "bar");
static_assert(M_END <= WS_NEED, "misc");
static_assert(B_CM + (size_t)TT * 256 * 2 <= 9 * U, "bm/cm");
constexpr size_t B_X1 = 3 * U, B_HB = 5 * U, B_X2 = 8 * U;
constexpr size_t B_RB = 10 * U, B_KB = 11 * U, B_VB = 12 * U;
constexpr size_t B_LW = 13 * U, B_LA = B_LW + (size_t)TT * 128 * 2, B_LG = B_LA + (size_t)TT * 128 * 2;
constexpr size_t B_DEC = 3 * U, B_AB = 5 * U, B_GB = 6 * U, B_YB = 7 * U;
constexpr size_t B_YRAW = 13 * U;
constexpr size_t B_X3 = 3 * U, B_X4 = 8 * U;

constexpr int LDS_BYTES = 98304;

struct P {
  const float* in[N_IN];
  float* out;
  char* ws;
};

__device__ __forceinline__ u16 f2bf(float f) {
  unsigned u = __float_as_uint(f);
  u += 0x7fffu + ((u >> 16) & 1u);
  return (u16)(u >> 16);
}
__device__ __forceinline__ float bf2f(u16 h) { return __uint_as_float(((unsigned)h) << 16); }
__device__ __forceinline__ unsigned pk2(float a, float b) { return (unsigned)f2bf(a) | ((unsigned)f2bf(b) << 16); }
__device__ __forceinline__ float lo2f(unsigned u) { return __uint_as_float(u << 16); }
__device__ __forceinline__ float hi2f(unsigned u) { return __uint_as_float(u & 0xffff0000u); }
__device__ __forceinline__ void unpack8(const uint4& q, float* f) {
  f[0] = lo2f(q.x); f[1] = hi2f(q.x); f[2] = lo2f(q.y); f[3] = hi2f(q.y);
  f[4] = lo2f(q.z); f[5] = hi2f(q.z); f[6] = lo2f(q.w); f[7] = hi2f(q.w);
}
__device__ __forceinline__ uint4 pack8(const float* f) {
  uint4 q; q.x = pk2(f[0], f[1]); q.y = pk2(f[2], f[3]); q.z = pk2(f[4], f[5]); q.w = pk2(f[6], f[7]);
  return q;
}
__device__ __forceinline__ float softplusf(float x) { return x > 20.f ? x : log1pf(__expf(x)); }
__device__ __forceinline__ float sigmoidf(float x) { return 1.f / (1.f + __expf(-x)); }
__device__ __forceinline__ float wsum(float v) {
#pragma unroll
  for (int m = 32; m >= 1; m >>= 1) v += __shfl_xor(v, m);
  return v;
}
__device__ __forceinline__ float wmax(float v) {
#pragma unroll
  for (int m = 32; m >= 1; m >>= 1) v = fmaxf(v, __shfl_xor(v, m));
  return v;
}
__device__ __forceinline__ float wscan(float v, int lane) {
#pragma unroll
  for (int o = 1; o < 64; o <<= 1) {
    float t = __shfl_up(v, o);
    if (lane >= o) v += t;
  }
  return v;
}
__device__ __forceinline__ float bsum(float v, float* scr) {
  v = wsum(v);
  __syncthreads();
  if ((threadIdx.x & 63) == 0) scr[threadIdx.x >> 6] = v;
  __syncthreads();
  return scr[0] + scr[1] + scr[2] + scr[3];
}
__device__ __forceinline__ float dpp_f(float v, const int ctrl);
#define DPPF(v, ctrl) __int_as_float(__builtin_amdgcn_update_dpp(0, __float_as_int(v), ctrl, 0xF, 0xF, true))

__device__ __forceinline__ int img_off(int row, int kk  ) {
  return row * 128 + ((((kk >> 3) ^ ((row >> 1) & 7))) << 4) + ((kk & 7) << 1);
}

template <int MI, int NI>
__device__ __forceinline__ void mma_panel(f32x16 (&acc)[MI][NI], const char* Ap, int ar0, const char* Bp, int br0, int lane) {
  const int r = lane & 31, h = lane >> 5;
  bf16x8 a[2][MI], b[2][NI];
  const char* ap[MI];
  const char* bp[NI];
  int asw[MI], bsw[NI];
#pragma unroll
  for (int mi = 0; mi < MI; ++mi) { int row = ar0 + mi * 32 + r; ap[mi] = Ap + row * 128; asw[mi] = (row >> 1) & 7; }
#pragma unroll
  for (int ni = 0; ni < NI; ++ni) { int row = br0 + ni * 32 + r; bp[ni] = Bp + row * 128; bsw[ni] = (row >> 1) & 7; }
#pragma unroll
  for (int mi = 0; mi < MI; ++mi) a[0][mi] = *(const bf16x8*)(ap[mi] + ((h ^ asw[mi]) << 4));
#pragma unroll
  for (int ni = 0; ni < NI; ++ni) b[0][ni] = *(const bf16x8*)(bp[ni] + ((h ^ bsw[ni]) << 4));
#pragma unroll
  for (int ks = 0; ks < 4; ++ks) {
    const int cur = ks & 1, nxt = cur ^ 1;
    if (ks < 3) {
      const int ch = (ks + 1) * 2 + h;
#pragma unroll
      for (int mi = 0; mi < MI; ++mi) a[nxt][mi] = *(const bf16x8*)(ap[mi] + ((ch ^ asw[mi]) << 4));
#pragma unroll
      for (int ni = 0; ni < NI; ++ni) b[nxt][ni] = *(const bf16x8*)(bp[ni] + ((ch ^ bsw[ni]) << 4));
    }
    SB();
#pragma unroll
    for (int mi = 0; mi < MI; ++mi)
#pragma unroll
      for (int ni = 0; ni < NI; ++ni)
        acc[mi][ni] = __builtin_amdgcn_mfma_f32_32x32x16_bf16(a[cur][mi], b[cur][ni], acc[mi][ni], 0, 0, 0);
    SB();
  }
}
template <int MI, int NI>
__device__ __forceinline__ void mma_panel_s(f32x16 (&acc)[MI][NI], const char* Ap, int ar0, const char* Bp, int br0, int lane) {
  const int r = lane & 31, h = lane >> 5;
#pragma unroll
  for (int ks = 0; ks < 4; ++ks) {
    const int ch = ks * 2 + h;
    bf16x8 a[MI], b[NI];
#pragma unroll
    for (int mi = 0; mi < MI; ++mi) { int row = ar0 + mi * 32 + r; a[mi] = *(const bf16x8*)(Ap + row * 128 + ((ch ^ ((row >> 1) & 7)) << 4)); }
#pragma unroll
    for (int ni = 0; ni < NI; ++ni) { int row = br0 + ni * 32 + r; b[ni] = *(const bf16x8*)(Bp + row * 128 + ((ch ^ ((row >> 1) & 7)) << 4)); }
    SB();
#pragma unroll
    for (int mi = 0; mi < MI; ++mi)
#pragma unroll
      for (int ni = 0; ni < NI; ++ni)
        acc[mi][ni] = __builtin_amdgcn_mfma_f32_32x32x16_bf16(a[mi], b[ni], acc[mi][ni], 0, 0, 0);
    SB();
  }
}
template <int MI, int NI>
__device__ __forceinline__ void zero_acc(f32x16 (&acc)[MI][NI]) {
#pragma unroll
  for (int mi = 0; mi < MI; ++mi)
#pragma unroll
    for (int ni = 0; ni < NI; ++ni)
#pragma unroll
      for (int i = 0; i < 16; ++i) acc[mi][ni][i] = 0.f;
}
#define FRESH_TID(tid) int tid = threadIdx.x; asm volatile("" : "+v"(tid))
__device__ __forceinline__ int zof(int w) { int z; asm("s_mov_b32 %0, 0" : "=s"(z) : "s"(w)); return z; }
#define ACC_ROW(i, lane) (((i) & 3) + 8 * ((i) >> 2) + 4 * ((lane) >> 5))

template <class Epi>
__device__ __forceinline__ void gemm_tile(const u16* __restrict__ A, int lda, const u16* __restrict__ B, int ldb, int K,
                                          int m0, int n0, char* lds, const Epi& epi) {
  FRESH_TID(tid);
  const int lane = tid & 63, wid = tid >> 6, wr = wid & 1, wc = wid >> 1;
  f32x16 acc[4][2];
  zero_acc<4, 2>(acc);
  const int lrow = tid >> 3, lch = tid & 7;
  const u16* Bp = B + (size_t)(n0 + lrow) * ldb + lch * 8;
  const int soff = lrow * 128 + ((lch ^ ((lrow >> 1) & 7)) << 4);
  int aoff[8];
#pragma unroll
  for (int i = 0; i < 8; ++i) {
    int r = m0 + lrow + 32 * i;
    r = r < TT ? r : TT - 1;
    aoff[i] = (r - m0) * lda;
  }
  const u16* Ab = A + (size_t)m0 * lda + lch * 8;
  uint4 ra0, ra1, ra2, ra3, ra4, ra5, ra6, ra7, rb0, rb1, rb2, rb3, rc0, rc1, rc2, rc3, rc4, rc5, rc6, rc7, rd0, rd1, rd2, rd3;
  const int nk = K >> 6;
  {
    ra0 = *(const uint4*)(Ab + aoff[0] + 0);
    ra1 = *(const uint4*)(Ab + aoff[1] + 0);
    ra2 = *(const uint4*)(Ab + aoff[2] + 0);
    ra3 = *(const uint4*)(Ab + aoff[3] + 0);
    ra4 = *(const uint4*)(Ab + aoff[4] + 0);
    ra5 = *(const uint4*)(Ab + aoff[5] + 0);
    ra6 = *(const uint4*)(Ab + aoff[6] + 0);
    ra7 = *(const uint4*)(Ab + aoff[7] + 0);
    rb0 = *(const uint4*)(Bp + (size_t)(0) * ldb + 0);
    rb1 = *(const uint4*)(Bp + (size_t)(32) * ldb + 0);
    rb2 = *(const uint4*)(Bp + (size_t)(64) * ldb + 0);
    rb3 = *(const uint4*)(Bp + (size_t)(96) * ldb + 0);
    rc0 = *(const uint4*)(Ab + aoff[0] + 64);
    rc1 = *(const uint4*)(Ab + aoff[1] + 64);
    rc2 = *(const uint4*)(Ab + aoff[2] + 64);
    rc3 = *(const uint4*)(Ab + aoff[3] + 64);
    rc4 = *(const uint4*)(Ab + aoff[4] + 64);
    rc5 = *(const uint4*)(Ab + aoff[5] + 64);
    rc6 = *(const uint4*)(Ab + aoff[6] + 64);
    rc7 = *(const uint4*)(Ab + aoff[7] + 64);
    rd0 = *(const uint4*)(Bp + (size_t)(0) * ldb + 64);
    rd1 = *(const uint4*)(Bp + (size_t)(32) * ldb + 64);
    rd2 = *(const uint4*)(Bp + (size_t)(64) * ldb + 64);
    rd3 = *(const uint4*)(Bp + (size_t)(96) * ldb + 64);
    *(uint4*)(lds + 0 + soff + 0) = ra0;
    *(uint4*)(lds + 0 + soff + 4096) = ra1;
    *(uint4*)(lds + 0 + soff + 8192) = ra2;
    *(uint4*)(lds + 0 + soff + 12288) = ra3;
    *(uint4*)(lds + 0 + soff + 16384) = ra4;
    *(uint4*)(lds + 0 + soff + 20480) = ra5;
    *(uint4*)(lds + 0 + soff + 24576) = ra6;
    *(uint4*)(lds + 0 + soff + 28672) = ra7;
    *(uint4*)(lds + 0 + 32768 + soff + 0) = rb0;
    *(uint4*)(lds + 0 + 32768 + soff + 4096) = rb1;
    *(uint4*)(lds + 0 + 32768 + soff + 8192) = rb2;
    *(uint4*)(lds + 0 + 32768 + soff + 12288) = rb3;
  }
  __syncthreads();
  const int r_ = lane & 31, h_ = lane >> 5;
  int arow[4], asw[4], brow[2], bsw[2];
#pragma unroll
  for (int mi = 0; mi < 4; ++mi) { int row = wr * 128 + mi * 32 + r_; arow[mi] = row * 128; asw[mi] = (row >> 1) & 7; }
#pragma unroll
  for (int ni = 0; ni < 2; ++ni) { int row = wc * 64 + ni * 32 + r_; brow[ni] = row * 128; bsw[ni] = (row >> 1) & 7; }
  for (int kt = 0; kt < nk; kt += 2) {
    {
    const int kk = (kt + 2 < nk ? kt + 2 : nk - 1) * 64;
    ra0 = *(const uint4*)(Ab + aoff[0] + kk);
    ra1 = *(const uint4*)(Ab + aoff[1] + kk);
    ra2 = *(const uint4*)(Ab + aoff[2] + kk);
    ra3 = *(const uint4*)(Ab + aoff[3] + kk);
    ra4 = *(const uint4*)(Ab + aoff[4] + kk);
    ra5 = *(const uint4*)(Ab + aoff[5] + kk);
    ra6 = *(const uint4*)(Ab + aoff[6] + kk);
    ra7 = *(const uint4*)(Ab + aoff[7] + kk);
    rb0 = *(const uint4*)(Bp + (size_t)(0) * ldb + kk);
    rb1 = *(const uint4*)(Bp + (size_t)(32) * ldb + kk);
    rb2 = *(const uint4*)(Bp + (size_t)(64) * ldb + kk);
    rb3 = *(const uint4*)(Bp + (size_t)(96) * ldb + kk);
    }
    SB();
    {
      bf16x8 fa[2][4], fb[2][2];
        { const int ch = 0 + h_;
#pragma unroll
          for (int mi = 0; mi < 4; ++mi) fa[0][mi] = *(const bf16x8*)(lds + 0 + arow[mi] + ((ch ^ asw[mi]) << 4));
#pragma unroll
          for (int ni = 0; ni < 2; ++ni) fb[0][ni] = *(const bf16x8*)(lds + 0 + 32768 + brow[ni] + ((ch ^ bsw[ni]) << 4));
        }
        { const int ch = 2 + h_;
#pragma unroll
          for (int mi = 0; mi < 4; ++mi) fa[1][mi] = *(const bf16x8*)(lds + 0 + arow[mi] + ((ch ^ asw[mi]) << 4));
#pragma unroll
          for (int ni = 0; ni < 2; ++ni) fb[1][ni] = *(const bf16x8*)(lds + 0 + 32768 + brow[ni] + ((ch ^ bsw[ni]) << 4));
        }
        SB();
#pragma unroll
        for (int mi = 0; mi < 4; ++mi)
#pragma unroll
          for (int ni = 0; ni < 2; ++ni) acc[mi][ni] = __builtin_amdgcn_mfma_f32_32x32x16_bf16(fa[0][mi], fb[0][ni], acc[mi][ni], 0, 0, 0);
        *(uint4*)(lds + 49152 + soff + 0) = rc0;
        *(uint4*)(lds + 49152 + soff + 4096) = rc1;
        *(uint4*)(lds + 49152 + soff + 8192) = rc2;
        SB();
        { const int ch = 4 + h_;
#pragma unroll
          for (int mi = 0; mi < 4; ++mi) fa[0][mi] = *(const bf16x8*)(lds + 0 + arow[mi] + ((ch ^ asw[mi]) << 4));
#pragma unroll
          for (int ni = 0; ni < 2; ++ni) fb[0][ni] = *(const bf16x8*)(lds + 0 + 32768 + brow[ni] + ((ch ^ bsw[ni]) << 4));
        }
        SB();
#pragma unroll
        for (int mi = 0; mi < 4; ++mi)
#pragma unroll
          for (int ni = 0; ni < 2; ++ni) acc[mi][ni] = __builtin_amdgcn_mfma_f32_32x32x16_bf16(fa[1][mi], fb[1][ni], acc[mi][ni], 0, 0, 0);
        *(uint4*)(lds + 49152 + soff + 12288) = rc3;
        *(uint4*)(lds + 49152 + soff + 16384) = rc4;
        *(uint4*)(lds + 49152 + soff + 20480) = rc5;
        SB();
        { const int ch = 6 + h_;
#pragma unroll
          for (int mi = 0; mi < 4; ++mi) fa[1][mi] = *(const bf16x8*)(lds + 0 + arow[mi] + ((ch ^ asw[mi]) << 4));
#pragma unroll
          for (int ni = 0; ni < 2; ++ni) fb[1][ni] = *(const bf16x8*)(lds + 0 + 32768 + brow[ni] + ((ch ^ bsw[ni]) << 4));
        }
        SB();
#pragma unroll
        for (int mi = 0; mi < 4; ++mi)
#pragma unroll
          for (int ni = 0; ni < 2; ++ni) acc[mi][ni] = __builtin_amdgcn_mfma_f32_32x32x16_bf16(fa[0][mi], fb[0][ni], acc[mi][ni], 0, 0, 0);
        *(uint4*)(lds + 49152 + soff + 24576) = rc6;
        *(uint4*)(lds + 49152 + soff + 28672) = rc7;
        *(uint4*)(lds + 49152 + 32768 + soff + 0) = rd0;
        SB();
        SB();
#pragma unroll
        for (int mi = 0; mi < 4; ++mi)
#pragma unroll
          for (int ni = 0; ni < 2; ++ni) acc[mi][ni] = __builtin_amdgcn_mfma_f32_32x32x16_bf16(fa[1][mi], fb[1][ni], acc[mi][ni], 0, 0, 0);
        *(uint4*)(lds + 49152 + 32768 + soff + 4096) = rd1;
        *(uint4*)(lds + 49152 + 32768 + soff + 8192) = rd2;
        *(uint4*)(lds + 49152 + 32768 + soff + 12288) = rd3;
        SB();
    }
    __syncthreads();
    {
    const int kk = (kt + 3 < nk ? kt + 3 : nk - 1) * 64;
    rc0 = *(const uint4*)(Ab + aoff[0] + kk);
    rc1 = *(const uint4*)(Ab + aoff[1] + kk);
    rc2 = *(const uint4*)(Ab + aoff[2] + kk);
    rc3 = *(const uint4*)(Ab + aoff[3] + kk);
    rc4 = *(const uint4*)(Ab + aoff[4] + kk);
    rc5 = *(const uint4*)(Ab + aoff[5] + kk);
    rc6 = *(const uint4*)(Ab + aoff[6] + kk);
    rc7 = *(const uint4*)(Ab + aoff[7] + kk);
    rd0 = *(const uint4*)(Bp + (size_t)(0) * ldb + kk);
    rd1 = *(const uint4*)(Bp + (size_t)(32) * ldb + kk);
    rd2 = *(const uint4*)(Bp + (size_t)(64) * ldb + kk);
    rd3 = *(const uint4*)(Bp + (size_t)(96) * ldb + kk);
    }
    SB();
    {
      bf16x8 fa[2][4], fb[2][2];
        { const int ch = 0 + h_;
#pragma unroll
          for (int mi = 0; mi < 4; ++mi) fa[0][mi] = *(const bf16x8*)(lds + 49152 + arow[mi] + ((ch ^ asw[mi]) << 4));
#pragma unroll
          for (int ni = 0; ni < 2; ++ni) fb[0][ni] = *(const bf16x8*)(lds + 49152 + 32768 + brow[ni] + ((ch ^ bsw[ni]) << 4));
        }
        { const int ch = 2 + h_;
#pragma unroll
          for (int mi = 0; mi < 4; ++mi) fa[1][mi] = *(const bf16x8*)(lds + 49152 + arow[mi] + ((ch ^ asw[mi]) << 4));
#pragma unroll
          for (int ni = 0; ni < 2; ++ni) fb[1][ni] = *(const bf16x8*)(lds + 49152 + 32768 + brow[ni] + ((ch ^ bsw[ni]) << 4));
        }
        SB();
#pragma unroll
        for (int mi = 0; mi < 4; ++mi)
#pragma unroll
          for (int ni = 0; ni < 2; ++ni) acc[mi][ni] = __builtin_amdgcn_mfma_f32_32x32x16_bf16(fa[0][mi], fb[0][ni], acc[mi][ni], 0, 0, 0);
        *(uint4*)(lds + 0 + soff + 0) = ra0;
        *(uint4*)(lds + 0 + soff + 4096) = ra1;
        *(uint4*)(lds + 0 + soff + 8192) = ra2;
        SB();
        { const int ch = 4 + h_;
#pragma unroll
          for (int mi = 0; mi < 4; ++mi) fa[0][mi] = *(const bf16x8*)(lds + 49152 + arow[mi] + ((ch ^ asw[mi]) << 4));
#pragma unroll
          for (int ni = 0; ni < 2; ++ni) fb[0][ni] = *(const bf16x8*)(lds + 49152 + 32768 + brow[ni] + ((ch ^ bsw[ni]) << 4));
        }
        SB();
#pragma unroll
        for (int mi = 0; mi < 4; ++mi)
#pragma unroll
          for (int ni = 0; ni < 2; ++ni) acc[mi][ni] = __builtin_amdgcn_mfma_f32_32x32x16_bf16(fa[1][mi], fb[1][ni], acc[mi][ni], 0, 0, 0);
        *(uint4*)(lds + 0 + soff + 12288) = ra3;
        *(uint4*)(lds + 0 + soff + 16384) = ra4;
        *(uint4*)(lds + 0 + soff + 20480) = ra5;
        SB();
        { const int ch = 6 + h_;
#pragma unroll
          for (int mi = 0; mi < 4; ++mi) fa[1][mi] = *(const bf16x8*)(lds + 49152 + arow[mi] + ((ch ^ asw[mi]) << 4));
#pragma unroll
          for (int ni = 0; ni < 2; ++ni) fb[1][ni] = *(const bf16x8*)(lds + 49152 + 32768 + brow[ni] + ((ch ^ bsw[ni]) << 4));
        }
        SB();
#pragma unroll
        for (int mi = 0; mi < 4; ++mi)
#pragma unroll
          for (int ni = 0; ni < 2; ++ni) acc[mi][ni] = __builtin_amdgcn_mfma_f32_32x32x16_bf16(fa[0][mi], fb[0][ni], acc[mi][ni], 0, 0, 0);
        *(uint4*)(lds + 0 + soff + 24576) = ra6;
        *(uint4*)(lds + 0 + soff + 28672) = ra7;
        *(uint4*)(lds + 0 + 32768 + soff + 0) = rb0;
        SB();
        SB();
#pragma unroll
        for (int mi = 0; mi < 4; ++mi)
#pragma unroll
          for (int ni = 0; ni < 2; ++ni) acc[mi][ni] = __builtin_amdgcn_mfma_f32_32x32x16_bf16(fa[1][mi], fb[1][ni], acc[mi][ni], 0, 0, 0);
        *(uint4*)(lds + 0 + 32768 + soff + 4096) = rb1;
        *(uint4*)(lds + 0 + 32768 + soff + 8192) = rb2;
        *(uint4*)(lds + 0 + 32768 + soff + 12288) = rb3;
        SB();
    }
    __syncthreads();
  }
  epi(acc, m0 + wr * 128, n0 + wc * 64, lane);
}

struct TDesc { const float* src; u16* dst; int K, N, lds, Kp, Np, mode; };
__device__ __forceinline__ TDesc get_tdesc(const P& p, int i, int zz) {
  TDesc d;
  d.mode = 0;
  char* ws = p.ws;
  switch (i) {
    case 0: d = {p.in[zz + I_WIN0], (u16*)(ws + W_IN0), 1024, 4632, 4632, 1024, 4736, 1}; break;
    case 1: d = {p.in[zz + I_WOUT0], (u16*)(ws + W_OUT0), 2048, 1024, 1024, 2048, 1024, 0}; break;
    case 2: d = {p.in[zz + I_GU], (u16*)(ws + W_GU), 1024, 5632, 5632, 1024, 5632, 2}; break;
    case 3: d = {p.in[zz + I_GU] + 1024ull * 5632, (u16*)(ws + W_GU + 5632ull * 1024 * 2), 1024, 5632, 5632, 1024, 5632, 2}; break;
    case 4: d = {p.in[zz + I_DN], (u16*)(ws + W_DN), 2816, 1024, 1024, 2816, 1024, 0}; break;
    case 5: d = {p.in[zz + I_DN] + 2816ull * 1024, (u16*)(ws + W_DN + 1024ull * 2816 * 2), 2816, 1024, 1024, 2816, 1024, 0}; break;
    case 6: d = {p.in[zz + I_WR], (u16*)(ws + W_R), 1024, 1024, 1024, 1024, 1024, 0}; break;
    case 7: d = {p.in[zz + I_WKK], (u16*)(ws + W_K), 1024, 1024, 1024, 1024, 1024, 0}; break;
    case 8: d = {p.in[zz + I_WVV], (u16*)(ws + W_V), 1024, 1024, 1024, 1024, 1024, 0}; break;
    case 9: d = {p.in[zz + I_WO], (u16*)(ws + W_O), 1024, 1024, 1024, 1024, 1024, 0}; break;
    case 10: d = {p.in[zz + I_W1], (u16*)(ws + W_W1), 1024, 64, 64, 1024, 128, 0}; break;
    case 11: d = {p.in[zz + I_A1], (u16*)(ws + W_A1), 1024, 64, 64, 1024, 128, 0}; break;
    case 12: d = {p.in[zz + I_G1], (u16*)(ws + W_G1), 1024, 160, 160, 1024, 256, 0}; break;
    case 13: d = {p.in[zz + I_W2], (u16*)(ws + W_W2), 64, 1024, 1024, 128, 1024, 0}; break;
    case 14: d = {p.in[zz + I_A2], (u16*)(ws + W_A2), 64, 1024, 1024, 128, 1024, 0}; break;
    default: d = {p.in[zz + I_G2], (u16*)(ws + W_G2), 160, 1024, 1024, 256, 1024, 0}; break;
  }
  return d;
}
__device__ __forceinline__ int tdesc_tiles(int i) {
  switch (i) {
    case 0: return 16 * 74;
    case 1: return 32 * 16;
    case 2: case 3: return 16 * 88;
    case 4: case 5: return 44 * 16;
    case 6: case 7: case 8: case 9: return 16 * 16;
    case 10: case 11: return 16 * 2;
    case 12: return 16 * 4;
    case 13: case 14: return 2 * 16;
    default: return 4 * 16;
  }
}
constexpr int PREP_TILES = 16 * 74 + 32 * 16 + 2 * 16 * 88 + 2 * 44 * 16 + 4 * 256 + 2 * 32 + 64 + 2 * 32 + 64;

__device__ __forceinline__ void rms_rows_bf16(const float* src_row, const float* g, u16* dst_row, int lane) {
  float4 v[4];
  float ss = 0.f;
#pragma unroll
  for (int i = 0; i < 4; ++i) {
    v[i] = ((const float4*)src_row)[lane + 64 * i];
    ss += v[i].x * v[i].x + v[i].y * v[i].y + v[i].z * v[i].z + v[i].w * v[i].w;
  }
  ss = wsum(ss);
  float rinv = rsqrtf(ss * (1.f / 1024.f) + EPS);
#pragma unroll
  for (int i = 0; i < 4; ++i) {
    float4 g4 = ((const float4*)g)[lane + 64 * i];
    uint2 o;
    o.x = pk2(v[i].x * rinv * g4.x, v[i].y * rinv * g4.y);
    o.y = pk2(v[i].z * rinv * g4.z, v[i].w * rinv * g4.w);
    ((uint2*)dst_row)[lane + 64 * i] = o;
  }
}

__device__ __forceinline__ void rms_rows2_bf16(const float* sa, const float* sb, const float* g, u16* da, u16* db, bool hasb, int lane) {
  float4 va[4], vb[4];
  float ssa = 0.f, ssb = 0.f;
#pragma unroll
  for (int i = 0; i < 4; ++i) { va[i] = ((const float4*)sa)[lane + 64 * i]; vb[i] = ((const float4*)sb)[lane + 64 * i]; }
#pragma unroll
  for (int i = 0; i < 4; ++i) {
    ssa += va[i].x * va[i].x + va[i].y * va[i].y + va[i].z * va[i].z + va[i].w * va[i].w;
    ssb += vb[i].x * vb[i].x + vb[i].y * vb[i].y + vb[i].z * vb[i].z + vb[i].w * vb[i].w;
  }
  ssa = wsum(ssa); ssb = wsum(ssb);
  float ra = rsqrtf(ssa * (1.f / 1024.f) + EPS), rb = rsqrtf(ssb * (1.f / 1024.f) + EPS);
#pragma unroll
  for (int i = 0; i < 4; ++i) {
    float4 g4 = ((const float4*)g)[lane + 64 * i];
    uint2 o;
    o.x = pk2(va[i].x * ra * g4.x, va[i].y * ra * g4.y);
    o.y = pk2(va[i].z * ra * g4.z, va[i].w * ra * g4.w);
    ((uint2*)da)[lane + 64 * i] = o;
    if (hasb) {
      o.x = pk2(vb[i].x * rb * g4.x, vb[i].y * rb * g4.y);
      o.y = pk2(vb[i].z * rb * g4.z, vb[i].w * rb * g4.w);
      ((uint2*)db)[lane + 64 * i] = o;
    }
  }
}
__device__ __forceinline__ void phase_prep(const P& p, char* lds, int bid, int G) {
  float* tile = (float*)lds;
  const int total = PREP_TILES + TT / 8;
  for (int w = bid; w < total; w += G) {
    FRESH_TID(tid);
    const int zz = zof(w);
    const int lane = tid & 63, wid = tid >> 6;
    if (w < PREP_TILES) {
      int t = w, di = 0;
      for (; di < 16; ++di) {
        int n = tdesc_tiles(di);
        if (t < n) break;
        t -= n;
      }
      TDesc d = get_tdesc(p, di, zz);
      const int nkt = d.Kp >> 6;
      const int kt = t % nkt, nt = t / nkt;
      const int k0 = kt * 64, n0 = nt * 64;
      float vals[16];
#pragma unroll
      for (int i = 0; i < 16; ++i) {
        int kk = i * 4 + (tid >> 6), nn = tid & 63;
        int n = n0 + nn, k = k0 + kk, sc;
        if (d.mode == 0) sc = (n < d.N) ? n : -1;
        else if (d.mode == 1) sc = n < 3584 ? n : (n < 4608 ? 3600 + (n - 3584) : (n < 4624 ? 3584 + (n - 4608) : (n < 4632 ? n : -1)));
        else { int q = n >> 6, j = n & 63; sc = j < 32 ? q * 32 + j : 2816 + q * 32 + (j - 32); }
        const bool ok = (sc >= 0 && k < d.K);
        float v = d.src[ok ? (size_t)k * d.lds + sc : 0];
        vals[i] = ok ? v : 0.f;
      }
#pragma unroll
      for (int i = 0; i < 16; ++i) tile[(i * 4 + (tid >> 6)) * 65 + (tid & 63)] = vals[i];
      __syncthreads();
#pragma unroll
      for (int i = 0; i < 16; ++i) {
        int nn = i * 4 + (tid >> 6), kk = tid & 63;
        d.dst[(size_t)(n0 + nn) * d.Kp + k0 + kk] = f2bf(tile[kk * 65 + nn]);
      }
      __syncthreads();
    } else {
      int rowa = (w - PREP_TILES) * 8 + wid, rowb = rowa + 4;
      const float* sa = rowa < TP ? p.in[zz + I_XP] + (size_t)rowa * 1024 : p.in[zz + I_XS] + (size_t)(rowa - TP) * 1024;
      const float* sb = rowb < TP ? p.in[zz + I_XP] + (size_t)rowb * 1024 : p.in[zz + I_XS] + (size_t)(rowb - TP) * 1024;
      u16* xn = (u16*)(p.ws + B_A);
      rms_rows2_bf16(sa, sb, p.in[zz + I_NMIX], xn + (size_t)rowa * 1024, xn + (size_t)rowb * 1024, true, lane);
    }
  }
}

__device__ __forceinline__ bool tile_map(int q, int xcd, int MT, int NT, int& mt, int& nt) {
  int mi = q / NT;
  nt = q - mi * NT;
  mt = xcd + 8 * mi;
  return mt < MT;
}
template <class Epi>
__device__ __forceinline__ void gemm_phase(const u16* A, int lda, const u16* B, int ldb, int K, int MT, int NT, char* lds, int bid, int G, const Epi& epi) {
  const int xcd = bid & 7, j = bid >> 3, nb = G >> 3;
  const int nq = ((MT + 7) >> 3) * NT;
  for (int q = j; q < nq; q += nb) {
    int mt, nt;
    if (!tile_map(q, xcd, MT, NT, mt, nt)) break;
    gemm_tile(A, lda, B, ldb, K, mt * 256, nt * 128, lds, epi);
  }
}

struct EpiProj {
  u16* proj; float* small;
  __device__ __forceinline__ void operator()(f32x16 (&acc)[4][2], int r0, int c0, int lane) const {
#pragma unroll
    for (int mi = 0; mi < 4; ++mi)
#pragma unroll
      for (int ni = 0; ni < 2; ++ni) {
        int col = c0 + ni * 32 + (lane & 31);
#pragma unroll
        for (int i = 0; i < 16; ++i) {
          int row = r0 + mi * 32 + ACC_ROW(i, lane);
          if (row >= TT) continue;
          float v = acc[mi][ni][i];
          if (col < PJ) proj[(size_t)row * PJ + col] = f2bf(v);
          else if (col < PJ + 32) small[(size_t)row * 32 + (col - PJ)] = v;
        }
      }
  }
};
struct EpiRes {
  const float* res; const float* res2; float* out;
  __device__ __forceinline__ void operator()(f32x16 (&acc)[4][2], int r0, int c0, int lane) const {
#pragma unroll
    for (int mi = 0; mi < 4; ++mi)
#pragma unroll
      for (int ni = 0; ni < 2; ++ni) {
        int col = c0 + ni * 32 + (lane & 31);
#pragma unroll
        for (int i = 0; i < 16; ++i) {
          int row = r0 + mi * 32 + ACC_ROW(i, lane);
          if (row >= TT) continue;
          float rv = row < TP ? res[(size_t)row * 1024 + col] : res2[(size_t)(row - TP) * 1024 + col];
          out[(size_t)row * 1024 + col] = rv + acc[mi][ni][i];
        }
      }
  }
};
struct EpiSwiglu {
  u16* hb;
  __device__ __forceinline__ void operator()(f32x16 (&acc)[4][2], int r0, int c0, int lane) const {
    int col = (c0 >> 1) + (lane & 31);
#pragma unroll
    for (int mi = 0; mi < 4; ++mi)
#pragma unroll
      for (int i = 0; i < 16; ++i) {
        int row = r0 + mi * 32 + ACC_ROW(i, lane);
        if (row >= TT) continue;
        float g = acc[mi][0][i], u = acc[mi][1][i];
        hb[(size_t)row * 2816 + col] = f2bf(g * sigmoidf(g) * u);
      }
  }
};
struct EpiAct {
  u16* out; int ldo; int nvalid; int nstore; int act;
  __device__ __forceinline__ void operator()(f32x16 (&acc)[4][2], int r0, int c0, int lane) const {
#pragma unroll
    for (int mi = 0; mi < 4; ++mi)
#pragma unroll
      for (int ni = 0; ni < 2; ++ni) {
        int col = c0 + ni * 32 + (lane & 31);
        if (col >= nstore) continue;
#pragma unroll
        for (int i = 0; i < 16; ++i) {
          int row = r0 + mi * 32 + ACC_ROW(i, lane);
          if (row >= TT) continue;
          float v = acc[mi][ni][i];
          if (act == 1) v = tanhf(v);
          else if (act == 2) v = sigmoidf(v);
          if (col >= nvalid) v = 0.f;
          out[(size_t)row * ldo + col] = f2bf(v);
        }
      }
  }
};
struct EpiLora2 {
  int which; const float* bias; float* outf; u16* outb;
  __device__ __forceinline__ void operator()(f32x16 (&acc)[4][2], int r0, int c0, int lane) const {
#pragma unroll
    for (int mi = 0; mi < 4; ++mi)
#pragma unroll
      for (int ni = 0; ni < 2; ++ni) {
        int col = c0 + ni * 32 + (lane & 31);
        float bv = which < 2 ? bias[col] : 0.f;
#pragma unroll
        for (int i = 0; i < 16; ++i) {
          int row = r0 + mi * 32 + ACC_ROW(i, lane);
          if (row >= TT) continue;
          float v = acc[mi][ni][i] + bv;
          if (which == 0) {
            float w = -softplusf(-v) - 0.5f;
            outf[(size_t)row * 1024 + col] = __expf(-__expf(w));
          } else if (which == 1) {
            outb[(size_t)row * 1024 + col] = f2bf(sigmoidf(v));
          } else {
            outb[(size_t)row * 1024 + col] = f2bf(v);
          }
        }
      }
  }
};

__device__ __forceinline__ void phase_conv(const P& p, char* lds, int bid, int G) {
  const u16* proj = (const u16*)(p.ws + B_PROJ);
  const float* small = (const float*)(p.ws + B_SMALL);
  u16* xs = (u16*)(p.ws + B_A);
  u16* Bm = (u16*)(p.ws + B_BM);
  u16* Cm = (u16*)(p.ws + B_CM);
  u16* xm = (u16*)(p.ws + B_XM);
  const int zz0 = zof(bid);
  const float* cw = p.in[zz0 + I_CONVW];
  const float* cb = p.in[zz0 + I_CONVB];
  const int n_conv = TT / 4;
  const int n_gate = (512 + 2048) / 4;
  for (int w = bid; w < n_conv + n_gate; w += G) {
    FRESH_TID(tid);
    const int zz = zof(w);
    const int lane = tid & 63, wid = tid >> 6;
    if (w < n_conv) {
#pragma unroll
      for (int k_ = 0; k_ < 5; ++k_) {
        const int i = tid + k_ * 256;
        int r4 = i / 320, cgp = i % 320;
        int row = w * 4 + r4, c0 = cgp * 8;
        float u[4][8];
        if (row < TP) {
          int t = row & 2047;
#pragma unroll
          for (int j = 0; j < 4; ++j) {
            int tt = t - 3 + j;
            if (tt >= 0) {
              uint4 q = *(const uint4*)(proj + (size_t)(row - 3 + j) * PJ + 1024 + c0);
              unpack8(q, u[j]);
            } else {
#pragma unroll
              for (int e = 0; e < 8; ++e) u[j][e] = 0.f;
            }
          }
          if (t >= 2045) {
            int b = row >> 11;
            float* o = p.out + O_CONVP + ((size_t)(b * 3 + (t - 2045)) * 2560 + c0);
#pragma unroll
            for (int e = 0; e < 8; ++e) o[e] = u[3][e];
          }
        } else {
          int bs = row - TP;
#pragma unroll
          for (int j = 0; j < 3; ++j) {
            const float* s = p.in[zz + I_SCONV] + ((size_t)(bs * 3 + j) * 2560 + c0);
#pragma unroll
            for (int e = 0; e < 8; ++e) u[j][e] = s[e];
          }
          uint4 q = *(const uint4*)(proj + (size_t)row * PJ + 1024 + c0);
          unpack8(q, u[3]);
          float* o = p.out + O_CONVS + ((size_t)(bs * 3) * 2560 + c0);
#pragma unroll
          for (int e = 0; e < 8; ++e) { o[e] = u[1][e]; o[2560 + e] = u[2][e]; o[5120 + e] = u[3][e]; }
        }
        float a[8];
#pragma unroll
        for (int e = 0; e < 8; ++e) {
          float v = cb[c0 + e];
#pragma unroll
          for (int j = 0; j < 4; ++j) v += u[j][e] * cw[j * 2560 + c0 + e];
          a[e] = v * sigmoidf(v);
        }
        uint4 o = pack8(a);
        u16* dst;
        if (c0 < 1024) dst = xs + (size_t)row * 1024 + c0;
        else if (c0 < 1280) dst = Bm + (size_t)row * 256 + (c0 - 1024);
        else if (c0 < 1536) dst = Cm + (size_t)row * 256 + (c0 - 1280);
        else dst = xm + (size_t)row * 1024 + (c0 - 1536);
        *(uint4*)dst = o;
      }
    } else {
      int wi = (w - n_conv) * 4 + wid;
      int t0 = 2 * lane;
      if (wi < 512) {
        int c = wi & 15, h = (wi >> 4) & 3, b = wi >> 6;
        int row0 = b * 2048 + c * 128;
        float fb = p.in[zz + I_FB][h], ib = p.in[zz + I_IB][h];
        float f0 = small[(size_t)(row0 + t0) * 32 + 20 + h] + fb, f1 = small[(size_t)(row0 + t0 + 1) * 32 + 20 + h] + fb;
        float i0 = small[(size_t)(row0 + t0) * 32 + 16 + h] + ib, i1 = small[(size_t)(row0 + t0 + 1) * 32 + 16 + h] + ib;
        float lf0 = -softplusf(-f0), lf1 = -softplusf(-f1);
        float inc = wscan(lf0 + lf1, lane);
        float bc1 = inc, bc0 = inc - lf1;
        float uu = wmax(fmaxf(i0 - bc0, i1 - bc1));
        float bend = __shfl(inc, 63);
        float* bcum = (float*)(p.ws + M_BCUM);
        float* li = (float*)(p.ws + M_LI);
        bcum[(size_t)(row0 + t0) * 4 + h] = bc0; bcum[(size_t)(row0 + t0 + 1) * 4 + h] = bc1;
        li[(size_t)(row0 + t0) * 4 + h] = i0; li[(size_t)(row0 + t0 + 1) * 4 + h] = i1;
        if (lane == 0) {
          float* gs = (float*)(p.ws + M_GSUM) + (size_t)((b * 4 + h) * 16 + c) * 2;
          gs[0] = bend; gs[1] = uu;
        }
      } else {
        int x = wi - 512;
        int h = x & 15, c = (x >> 4) & 15, b = x >> 8;
        int row0 = b * 2048 + c * 128;
        float db = p.in[zz + I_DTB][h], an = -__expf(p.in[zz + I_ALOG][h]);
        float d0 = softplusf(small[(size_t)(row0 + t0) * 32 + h] + db), d1 = softplusf(small[(size_t)(row0 + t0 + 1) * 32 + h] + db);
        float inc = wscan((d0 + d1) * an, lane);
        float* dt = (float*)(p.ws + M_DT);
        float* ac = (float*)(p.ws + M_ACUM);
        dt[(size_t)(row0 + t0) * 16 + h] = d0; dt[(size_t)(row0 + t0 + 1) * 16 + h] = d1;
        ac[(size_t)(row0 + t0) * 16 + h] = inc - d1 * an; ac[(size_t)(row0 + t0 + 1) * 16 + h] = inc;
      }
    }
  }
}

__device__ __forceinline__ void blockdiag8(const float* x, const float* __restrict__ w, int ch0, float scale, float* o) {
  const float4* w4 = (const float4*)(w + (size_t)(ch0 >> 2) * 16);
#pragma unroll
  for (int blk = 0; blk < 2; ++blk) {
    float4 r0 = w4[blk * 4 + 0], r1 = w4[blk * 4 + 1], r2 = w4[blk * 4 + 2], r3 = w4[blk * 4 + 3];
    const float* xx = x + blk * 4;
    o[blk * 4 + 0] = (xx[0] * r0.x + xx[1] * r1.x + xx[2] * r2.x + xx[3] * r3.x) * scale;
    o[blk * 4 + 1] = (xx[0] * r0.y + xx[1] * r1.y + xx[2] * r2.y + xx[3] * r3.y) * scale;
    o[blk * 4 + 2] = (xx[0] * r0.z + xx[1] * r1.z + xx[2] * r2.z + xx[3] * r3.z) * scale;
    o[blk * 4 + 3] = (xx[0] * r0.w + xx[1] * r1.w + xx[2] * r2.w + xx[3] * r3.w) * scale;
  }
}
__device__ __forceinline__ void mchain(const float* gs  , int c, float& mc, float& mn, float& bend) {
  float m = 0.f;
  for (int j = 0; j < c; ++j) m = gs[j * 2] + fmaxf(m, gs[j * 2 + 1]);
  mc = m;
  bend = gs[c * 2];
  mn = bend + fmaxf(m, gs[c * 2 + 1]);
}

__device__ __forceinline__ void img_put_t(char* img, int R, int j0, int s, const float* v) {
  char* pb = img + (s >> 6) * (R * 128);
#pragma unroll
  for (int e = 0; e < 8; ++e) *(u16*)(pb + img_off(j0 + e, s & 63)) = f2bf(v[e]);
}

__device__ __forceinline__ void phase_chunkstate(const P& p, char* lds, int bid, int G) {
  const u16* proj = (const u16*)(p.ws + B_PROJ);
  const float* small = (const float*)(p.ws + B_SMALL);
  const u16* xs = (const u16*)(p.ws + B_A);
  const u16* Bm = (const u16*)(p.ws + B_BM);
  const u16* Cm = (const u16*)(p.ws + B_CM);
  const u16* xm = (const u16*)(p.ws + B_XM);
  u16* mix = (u16*)(p.ws + B_MIX);
  char* R0 = lds;
  char* R1 = lds + 32768;
  float* ex = (float*)(lds + 65536);
  for (int w = bid; w < 2048; w += G) {
    FRESH_TID(tid);
    const int zz = zof(w);
    const int lane = tid & 63, wid = tid >> 6;
    if (w < 512) {
      const int bs = w >> 2, h = w & 3, row = TP + bs;
      float* sq = ex; float* sk = ex + 256; float* sv = ex + 512; float* scr = ex + 768;
      {
        int d = tid, cb4 = d & ~3, ci = d & 3;
        int nb = (h * 256 + cb4) >> 2;
        float q = 0.f, k = 0.f, v = 0.f;
#pragma unroll
        for (int c = 0; c < 4; ++c) {
          float xa = bf2f(xm[(size_t)row * 1024 + h * 256 + cb4 + c]);
          float xr = bf2f(proj[(size_t)row * PJ + 2560 + h * 256 + cb4 + c]);
          q += xa * p.in[zz + I_WQ][nb * 16 + c * 4 + ci];
          k += xa * p.in[zz + I_WK][nb * 16 + c * 4 + ci];
          v += xr * p.in[zz + I_WV][nb * 16 + c * 4 + ci];
        }
        sq[d] = q; sk[d] = k * 0.0625f; sv[d] = v;
      }
      float lf = -softplusf(-(small[(size_t)row * 32 + 20 + h] + p.in[zz + I_FB][h]));
      float li = small[(size_t)row * 32 + 16 + h] + p.in[zz + I_IB][h];
      float m = p.in[zz + I_SMM][bs * 4 + h];
      float mnew = fmaxf(lf + m, li);
      float wsc = __expf(li - mnew), dc = __expf(lf + m - mnew);
      __syncthreads();
      float nn = dc * p.in[zz + I_SMN][(size_t)(bs * 4 + h) * 256 + tid] + wsc * sk[tid];
      p.out[O_MNS + (size_t)(bs * 4 + h) * 256 + tid] = nn;
      float den = bsum(sq[tid] * nn, scr);
      const float* C = p.in[zz + I_SMC] + (size_t)(bs * 4 + h) * 65536 + tid;
      float* Co = p.out + O_MCS + (size_t)(bs * 4 + h) * 65536 + tid;
      float vv = sv[tid] * wsc, num = 0.f;
      for (int d0 = 0; d0 < 256; d0 += 32) {
        float c[32];
#pragma unroll
        for (int e = 0; e < 32; ++e) c[e] = C[(size_t)(d0 + e) * 256];
#pragma unroll
        for (int e = 0; e < 32; ++e) {
          float cn = dc * c[e] + sk[d0 + e] * vv;
          num += sq[d0 + e] * cn;
          Co[(size_t)(d0 + e) * 256] = cn;
        }
      }
      float hv = num / fmaxf(fabsf(den), __expf(-mnew));
      float ss = bsum(hv * hv, scr);
      float rinv = rsqrtf(ss * (1.f / 256.f) + EPS);
      int ch = h * 256 + tid;
      float xa = bf2f(xm[(size_t)row * 1024 + ch]);
      float op = bf2f(proj[(size_t)row * PJ + 3584 + ch]);
      float hm = (hv * rinv * p.in[zz + I_MLN][ch] + p.in[zz + I_MLS][ch] * xa) * sigmoidf(op);
      mix[(size_t)row * 2048 + 1024 + ch] = f2bf(hm);
      if (tid == 0) p.out[O_MMS + bs * 4 + h] = mnew;
      __syncthreads();
    } else if (w < 768) {
      const int x = w - 512, bs = x >> 1, g = x & 1, row = TP + bs;
      float* yz = ex; float* scr = ex + 512;
      const int pp = tid >> 2, nq = tid & 3, n0 = nq * 32;
      _Pragma("unroll 1")
      for (int h8 = 0; h8 < 8; ++h8) {
        int h = g * 8 + h8;
        float dtv = softplusf(small[(size_t)row * 32 + h] + p.in[zz + I_DTB][h]);
        float dec = __expf(-dtv * __expf(p.in[zz + I_ALOG][h]));
        float xv = bf2f(xs[(size_t)row * 1024 + h * 64 + pp]);
        const float* st = p.in[zz + I_SSSM] + ((size_t)((bs * 16 + h) * 64 + pp)) * 128 + n0;
        float* so = p.out + O_SSMS + ((size_t)((bs * 16 + h) * 64 + pp)) * 128 + n0;
        float ys = 0.f, dx = dtv * xv;
#pragma unroll
        for (int j = 0; j < 8; ++j) {
          float4 s4 = *(const float4*)(st + j * 4);
          uint2 b2 = *(const uint2*)(Bm + (size_t)row * 256 + g * 128 + n0 + j * 4);
          uint2 c2 = *(const uint2*)(Cm + (size_t)row * 256 + g * 128 + n0 + j * 4);
          float4 o;
          o.x = dec * s4.x + dx * lo2f(b2.x); o.y = dec * s4.y + dx * hi2f(b2.x);
          o.z = dec * s4.z + dx * lo2f(b2.y); o.w = dec * s4.w + dx * hi2f(b2.y);
          ys += o.x * lo2f(c2.x) + o.y * hi2f(c2.x) + o.z * lo2f(c2.y) + o.w * hi2f(c2.y);
          *(float4*)(so + j * 4) = o;
        }
        ys += __shfl_xor(ys, 1);
        ys += __shfl_xor(ys, 2);
        if (nq == 0) {
          float z = bf2f(proj[(size_t)row * PJ + h * 64 + pp]);
          yz[h8 * 64 + pp] = (ys + p.in[zz + I_SSDD][h] * xv) * z * sigmoidf(z);
        }
      }
      __syncthreads();
      float a0 = yz[tid], a1 = yz[tid + 256];
      float ss = bsum(a0 * a0 + a1 * a1, scr);
      float rinv = rsqrtf(ss * (1.f / 512.f) + EPS);
      mix[(size_t)row * 2048 + g * 512 + tid] = f2bf(a0 * rinv * p.in[zz + I_SSDN][g * 512 + tid]);
      mix[(size_t)row * 2048 + g * 512 + tid + 256] = f2bf(a1 * rinv * p.in[zz + I_SSDN][g * 512 + tid + 256]);
      __syncthreads();
    } else if (w < 1024) {
      const int x = w - 768, g = x & 1, c = (x >> 1) & 15, b = x >> 5;
      const int rowbase = b * 2048 + c * 128;
      const float* dt = (const float*)(p.ws + M_DT);
      const float* ac = (const float*)(p.ws + M_ACUM);
      float* sWe = ex;
      for (int i = tid; i < 1024; i += 256) {
        int h8 = i >> 7, s = i & 127, h = g * 8 + h8;
        float al = ac[(size_t)(rowbase + 127) * 16 + h];
        sWe[i] = __expf(al - ac[(size_t)(rowbase + s) * 16 + h]) * dt[(size_t)(rowbase + s) * 16 + h];
      }
      _Pragma("unroll 4")
      for (int k_ = 0; k_ < (128 * 16) / 256; ++k_) { const int i = tid + k_ * 256;
        int jc = i & 15, s = i >> 4;
        uint4 q = *(const uint4*)(Bm + (size_t)(rowbase + s) * 256 + g * 128 + jc * 8);
        float v[8]; unpack8(q, v);
        img_put_t(R0, 128, jc * 8, s, v);
      }
      __syncthreads();
      _Pragma("unroll 1")
      for (int h8 = 0; h8 < 8; ++h8) {
        int h = g * 8 + h8;
        _Pragma("unroll")
        for (int k_ = 0; k_ < (128 * 8) / 256; ++k_) { const int i = tid + k_ * 256;
          int jc = i & 7, s = i >> 3;
          uint4 q = *(const uint4*)(xs + (size_t)(rowbase + s) * 1024 + h * 64 + jc * 8);
          float v[8]; unpack8(q, v);
          float sc = sWe[h8 * 128 + s];
#pragma unroll
          for (int e = 0; e < 8; ++e) v[e] *= sc;
          img_put_t(R1, 64, jc * 8, s, v);
        }
        __syncthreads();
        f32x16 acc[1][2];
        zero_acc<1, 2>(acc);
#pragma unroll
        for (int pn = 0; pn < 2; ++pn) mma_panel<1, 2>(acc, R1 + pn * 8192, (wid & 1) * 32, R0 + pn * 16384, (wid >> 1) * 64, lane);
        u16* dst = (u16*)(p.ws + B_SSDST) + ((size_t)((b * 16 + c) * 16 + h)) * 8192;
#pragma unroll
        for (int ni = 0; ni < 2; ++ni)
#pragma unroll
          for (int i = 0; i < 16; ++i) {
            int pr = (wid & 1) * 32 + ACC_ROW(i, lane), n = (wid >> 1) * 64 + ni * 32 + (lane & 31);
            dst[pr * 128 + n] = f2bf(acc[0][ni][i]);
          }
        __syncthreads();
      }
    } else {
      const int x = w - 1024, vh = x & 1, c = (x >> 1) & 15, h = (x >> 5) & 3, b = x >> 7;
      const int rowbase = b * 2048 + c * 128;
      const float* gs = (const float*)(p.ws + M_GSUM) + (size_t)(b * 4 + h) * 32;
      float mc, mn, bend;
      mchain(gs, c, mc, mn, bend);
      float* sWs = ex;
      const float* bcum = (const float*)(p.ws + M_BCUM);
      const float* li = (const float*)(p.ws + M_LI);
      if (tid < 128) sWs[tid] = __expf(bend - bcum[(size_t)(rowbase + tid) * 4 + h] + li[(size_t)(rowbase + tid) * 4 + h] - mn);
      _Pragma("unroll 4")
      for (int k_ = 0; k_ < (128 * 16) / 256; ++k_) { const int i = tid + k_ * 256;
        int jc = i & 15, s = i >> 4;
        int ch0 = h * 256 + vh * 128 + jc * 8;
        uint4 q = *(const uint4*)(proj + (size_t)(rowbase + s) * PJ + 2560 + ch0);
        float xv[8], v[8]; unpack8(q, xv);
        blockdiag8(xv, p.in[zz + I_WV], ch0, 1.f, v);
        img_put_t(R0, 128, jc * 8, s, v);
      }
      __syncthreads();
      _Pragma("unroll 1")
      for (int dh = 0; dh < 2; ++dh) {
        _Pragma("unroll 4")
        for (int k_ = 0; k_ < (128 * 16) / 256; ++k_) { const int i = tid + k_ * 256;
          int jc = i & 15, s = i >> 4;
          int ch0 = h * 256 + dh * 128 + jc * 8;
          uint4 q = *(const uint4*)(xm + (size_t)(rowbase + s) * 1024 + ch0);
          float xv[8], v[8]; unpack8(q, xv);
          blockdiag8(xv, p.in[zz + I_WK], ch0, 0.0625f * sWs[s], v);
          img_put_t(R1, 128, jc * 8, s, v);
        }
        __syncthreads();
        f32x16 acc[2][2];
        zero_acc<2, 2>(acc);
#pragma unroll
        for (int pn = 0; pn < 2; ++pn) mma_panel<2, 2>(acc, R0 + pn * 16384, (wid & 1) * 64, R1 + pn * 16384, (wid >> 1) * 64, lane);
        if (vh == 0) {
          int d = tid >> 1, hf = tid & 1;
          float s = 0.f;
          for (int k = 0; k < 64; ++k) s += bf2f(*(const u16*)(R1 + hf * 16384 + img_off(d, k)));
          s += __shfl_xor(s, 1);
          if (hf == 0) ((float*)(p.ws + M_MLN))[(size_t)((b * 4 + h) * 16 + c) * 256 + dh * 128 + d] = s;
        }
        u16* dst = (u16*)(p.ws + B_MLST) + ((size_t)((b * 4 + h) * 16 + c)) * 65536;
#pragma unroll
        for (int mi = 0; mi < 2; ++mi)
#pragma unroll
          for (int ni = 0; ni < 2; ++ni)
#pragma unroll
            for (int i = 0; i < 16; ++i) {
              int v = vh * 128 + (wid & 1) * 64 + mi * 32 + ACC_ROW(i, lane), d = dh * 128 + (wid >> 1) * 64 + ni * 32 + (lane & 31);
              dst[v * 256 + d] = f2bf(acc[mi][ni][i]);
            }
        __syncthreads();
      }
    }
  }
}

__device__ __forceinline__ void phase_scan(const P& p, char* lds, int bid, int G) {
  for (int w = bid; w < 1568; w += G) {
    FRESH_TID(tid);
    const int zz = zof(w);
    if (w < 512) {
      int e8 = w * 256 + tid;
      int n8 = e8 & 15, pp = (e8 >> 4) & 63, h = (e8 >> 10) & 15, b = e8 >> 14;
      const float* ac = (const float*)(p.ws + M_ACUM);
      u16* st = (u16*)(p.ws + B_SSDST);
      float cur[8];
#pragma unroll
      for (int e = 0; e < 8; ++e) cur[e] = 0.f;
      uint4 qa[16]; float da[16];
#pragma unroll
      for (int c = 0; c < 16; ++c) {
        qa[c] = *(const uint4*)(st + ((size_t)((b * 16 + c) * 16 + h)) * 8192 + pp * 128 + n8 * 8);
        da[c] = ac[(size_t)(b * 2048 + c * 128 + 127) * 16 + h];
      }
#pragma unroll
      for (int c = 0; c < 16; ++c) {
        u16* ptr = st + ((size_t)((b * 16 + c) * 16 + h)) * 8192 + pp * 128 + n8 * 8;
        float t[8]; unpack8(qa[c], t);
        *(uint4*)ptr = pack8(cur);
        float dec = __expf(da[c]);
#pragma unroll
        for (int e = 0; e < 8; ++e) cur[e] = dec * cur[e] + t[e];
      }
      float* o = p.out + O_SSMP + ((size_t)((b * 16 + h) * 64 + pp)) * 128 + n8 * 8;
      *(float4*)o = make_float4(cur[0], cur[1], cur[2], cur[3]);
      *(float4*)(o + 4) = make_float4(cur[4], cur[5], cur[6], cur[7]);
    } else if (w < 1536) {
      int e8 = (w - 512) * 256 + tid;
      int d8 = e8 & 31, v = (e8 >> 5) & 255, h = (e8 >> 13) & 3, b = e8 >> 15;
      const float* gs = (const float*)(p.ws + M_GSUM) + (size_t)(b * 4 + h) * 32;
      u16* st = (u16*)(p.ws + B_MLST);
      float cur[8];
#pragma unroll
      for (int e = 0; e < 8; ++e) cur[e] = 0.f;
      float m = 0.f;
      uint4 qa[16];
#pragma unroll
      for (int c = 0; c < 16; ++c) qa[c] = *(const uint4*)(st + ((size_t)((b * 4 + h) * 16 + c)) * 65536 + v * 256 + d8 * 8);
#pragma unroll
      for (int c = 0; c < 16; ++c) {
        u16* ptr = st + ((size_t)((b * 4 + h) * 16 + c)) * 65536 + v * 256 + d8 * 8;
        float t[8]; unpack8(qa[c], t);
        *(uint4*)ptr = pack8(cur);
        float be = gs[c * 2], mn = be + fmaxf(m, gs[c * 2 + 1]);
        float dc = __expf(be + m - mn);
        m = mn;
#pragma unroll
        for (int e = 0; e < 8; ++e) cur[e] = dc * cur[e] + t[e];
      }
      float* o = p.out + O_MCP + (size_t)(b * 4 + h) * 65536 + v;
#pragma unroll
      for (int e = 0; e < 8; ++e) o[(size_t)(d8 * 8 + e) * 256] = cur[e];
    } else {
      int bh = w - 1536, d = tid;
      const float* gs = (const float*)(p.ws + M_GSUM) + (size_t)bh * 32;
      float* nb = (float*)(p.ws + M_MLN) + (size_t)bh * 16 * 256;
      float cur = 0.f, m = 0.f;
      for (int c = 0; c < 16; ++c) {
        float t = nb[c * 256 + d];
        nb[c * 256 + d] = cur;
        float be = gs[c * 2], mn = be + fmaxf(m, gs[c * 2 + 1]);
        float dc = __expf(be + m - mn);
        m = mn;
        cur = dc * cur + t;
      }
      p.out[O_MNP + (size_t)bh * 256 + d] = cur;
      if (tid == 0) p.out[O_MMP + bh] = m;
    }
  }
}

__device__ __forceinline__ void phase_chunkout(const P& p, char* lds, int bid, int G) {
  const u16* proj = (const u16*)(p.ws + B_PROJ);
  const u16* xs = (const u16*)(p.ws + B_A);
  const u16* Bm = (const u16*)(p.ws + B_BM);
  const u16* Cm = (const u16*)(p.ws + B_CM);
  const u16* xm = (const u16*)(p.ws + B_XM);
  u16* mix = (u16*)(p.ws + B_MIX);
  char* R0 = lds;
  char* R1 = lds + 32768;
  float* ex = (float*)(lds + 65536);
  for (int w = bid; w < 1024; w += G) {
    FRESH_TID(tid);
    const int zz = zof(w);
    const int lane = tid & 63, wid = tid >> 6;
#if defined(P5_ONLY) && P5_ONLY == 2
    if (false) {
#elif defined(P5_ONLY) && P5_ONLY == 1
    if (true) {
#else
    if (w >= 512) {
#endif
      const int x = w - 512, th = x & 1, g = (x >> 1) & 1, c = (x >> 2) & 15, b = x >> 6;
      const int rowbase = b * 2048 + c * 128;
      const float* dt = (const float*)(p.ws + M_DT);
      const float* ac = (const float*)(p.ws + M_ACUM);
      float* sA = ex;
      float* sD = ex + 1024;
      float* sSq = ex + 2048;
      for (int i = tid; i < 1024; i += 256) {
        int h8 = i >> 7, s = i & 127, h = g * 8 + h8;
        sA[i] = ac[(size_t)(rowbase + s) * 16 + h];
        sD[i] = dt[(size_t)(rowbase + s) * 16 + h];
      }
      if (tid < 64) sSq[tid] = 0.f;
      _Pragma("unroll 4")
      for (int k_ = 0; k_ < (128 * 16) / 256; ++k_) { const int i = tid + k_ * 256;
        int kc = i & 15, r = i >> 4;
        uint4 q = *(const uint4*)(Bm + (size_t)(rowbase + r) * 256 + g * 128 + kc * 8);
        *(uint4*)(R0 + (kc >> 3) * 16384 + r * 128 + (((kc & 7) ^ ((r >> 1) & 7)) << 4)) = q;
      }
      _Pragma("unroll")
      for (int k_ = 0; k_ < (64 * 16) / 256; ++k_) { const int i = tid + k_ * 256;
        int kc = i & 15, r = i >> 4;
        uint4 q = *(const uint4*)(Cm + (size_t)(rowbase + th * 64 + r) * 256 + g * 128 + kc * 8);
        *(uint4*)(R1 + (kc >> 3) * 8192 + r * 128 + (((kc & 7) ^ ((r >> 1) & 7)) << 4)) = q;
      }
      __syncthreads();
      f32x16 cb[2][1];
      zero_acc<2, 1>(cb);
#pragma unroll
      for (int pn = 0; pn < 2; ++pn) mma_panel<2, 1>(cb, R1 + pn * 8192, 0, R0 + pn * 16384, wid * 32, lane);
      __syncthreads();
      _Pragma("unroll 1")
      for (int h8 = 0; h8 < 8; ++h8) {
        const int h = g * 8 + h8;
        u16 exs[16], ezs[16];
        {
          int pp = (wid >> 1) * 32 + (lane & 31), ch = h * 64 + pp;
#pragma unroll
          for (int i = 0; i < 16; ++i) {
            size_t row = rowbase + th * 64 + (wid & 1) * 32 + ACC_ROW(i, lane);
            exs[i] = xs[row * 1024 + ch];
            ezs[i] = proj[row * PJ + ch];
          }
        }
        {
          int s = wid * 32 + (lane & 31);
          float as = sA[h8 * 128 + s], ds = sD[h8 * 128 + s];
#pragma unroll
          for (int mi = 0; mi < 2; ++mi)
#pragma unroll
            for (int i = 0; i < 16; ++i) {
              int tl = mi * 32 + ACC_ROW(i, lane), t = th * 64 + tl;
              float v = (s <= t) ? __expf(sA[h8 * 128 + t] - as) * cb[mi][0][i] * ds : 0.f;
              *(u16*)(R0 + (s >> 6) * 8192 + img_off(tl, s & 63)) = f2bf(v);
              if ((i & 3) == 3) SB();
            }
        }
        _Pragma("unroll")
        for (int k_ = 0; k_ < (128 * 8) / 256; ++k_) { const int i = tid + k_ * 256;
          int jc = i & 7, s = i >> 3;
          uint4 q = *(const uint4*)(xs + (size_t)(rowbase + s) * 1024 + h * 64 + jc * 8);
          float v[8]; unpack8(q, v);
          img_put_t(R0 + 16384, 64, jc * 8, s, v);
        }
        {
          const u16* st = (const u16*)(p.ws + B_SSDST) + ((size_t)((b * 16 + c) * 16 + h)) * 8192;
          _Pragma("unroll")
          for (int k_ = 0; k_ < (64 * 16) / 256; ++k_) { const int i = tid + k_ * 256;
            int kc = i & 15, r = i >> 4;
            uint4 q = *(const uint4*)(st + r * 128 + kc * 8);
            *(uint4*)(R1 + 16384 + (kc >> 3) * 8192 + r * 128 + (((kc & 7) ^ ((r >> 1) & 7)) << 4)) = q;
          }
        }
        __syncthreads();
        f32x16 a1[1][1], a2[1][1];
        zero_acc<1, 1>(a1);
        zero_acc<1, 1>(a2);
#pragma unroll
        for (int pn = 0; pn < 2; ++pn) {
          mma_panel<1, 1>(a1, R0 + pn * 8192, (wid & 1) * 32, R0 + 16384 + pn * 8192, (wid >> 1) * 32, lane);
          mma_panel<1, 1>(a2, R1 + pn * 8192, (wid & 1) * 32, R1 + 16384 + pn * 8192, (wid >> 1) * 32, lane);
        }
        {
          int pp = (wid >> 1) * 32 + (lane & 31), ch = h * 64 + pp;
          float Dh = p.in[zz + I_SSDD][h];
#pragma unroll
          for (int i = 0; i < 16; ++i) {
            int tl = (wid & 1) * 32 + ACC_ROW(i, lane), t = th * 64 + tl;
            size_t row = rowbase + t;
            float y = a1[0][0][i] + __expf(sA[h8 * 128 + t]) * a2[0][0][i];
            float xv = bf2f(exs[i]);
            float z = bf2f(ezs[i]);
            float v = (y + Dh * xv) * z * sigmoidf(z);
            mix[row * 2048 + ch] = f2bf(v);
            if ((i & 3) == 3) SB();
          }
        }
        __syncthreads();
      }
      asm volatile("s_waitcnt vmcnt(0)" ::: "memory");
      __threadfence_block();
      __syncthreads();
      _Pragma("unroll 4")
      for (int tl = wid * 16; tl < wid * 16 + 16; ++tl) {
        size_t row = rowbase + th * 64 + tl;
        u16* ptr = mix + row * 2048 + g * 512 + lane * 8;
        float v[8]; unpack8(*(const uint4*)ptr, v);
        float sq = 0.f;
#pragma unroll
        for (int e = 0; e < 8; ++e) sq += v[e] * v[e];
        sq = wsum(sq);
        float rinv = rsqrtf(sq * (1.f / 512.f) + EPS);
        const float* gn = p.in[zz + I_SSDN] + g * 512 + lane * 8;
#pragma unroll
        for (int e = 0; e < 8; ++e) v[e] *= rinv * gn[e];
        *(uint4*)ptr = pack8(v);
      }
      __syncthreads();
    } else {
      const int c = w & 15, h = (w >> 4) & 3, b = w >> 6;
      const int rowbase = b * 2048 + c * 128;
      const float* gs = (const float*)(p.ws + M_GSUM) + (size_t)(b * 4 + h) * 32;
      float mc, mn, bend;
      mchain(gs, c, mc, mn, bend);
      float* sBc = ex;
      float* sLb = ex + 128;
      float* sMt = ex + 256;
      float* sWi = ex + 384;
      float* sDen = ex + 512;
      float* sQn = ex + 640;
      float* sSq = ex + 768;
      float* sN = ex + 896;
      const float* bcum = (const float*)(p.ws + M_BCUM);
      const float* li = (const float*)(p.ws + M_LI);
      if (tid < 128) {
        float bc = bcum[(size_t)(rowbase + tid) * 4 + h];
        sBc[tid] = bc;
        sLb[tid] = li[(size_t)(rowbase + tid) * 4 + h] - bc;
        sDen[tid] = 0.f; sQn[tid] = 0.f; sSq[tid] = 0.f;
      }
      sN[tid] = ((const float*)(p.ws + M_MLN))[(size_t)((b * 4 + h) * 16 + c) * 256 + tid];
      __syncthreads();
      if (tid < 128) {
        float pm = -INFINITY;
        for (int s = 0; s <= tid; ++s) pm = fmaxf(pm, sLb[s]);
        float inter = sBc[tid] + mc;
        float mt = fmaxf(inter, sBc[tid] + pm);
        sMt[tid] = mt;
        sWi[tid] = __expf(inter - mt);
      }
      __syncthreads();
      if (tid < 128) sBc[tid] -= sMt[tid];
      __syncthreads();
      f32x16 sa[2][2];
      zero_acc<2, 2>(sa);
      _Pragma("unroll 1")
      for (int dp = 0; dp < 4; ++dp) {
        _Pragma("unroll")
        for (int k_ = 0; k_ < (128 * 8) / 256; ++k_) { const int i = tid + k_ * 256;
          int kc = i & 7, r = i >> 3;
          int ch0 = h * 256 + dp * 64 + kc * 8;
          uint4 q = *(const uint4*)(xm + (size_t)(rowbase + r) * 1024 + ch0);
          float xv[8], qv[8], kv[8]; unpack8(q, xv);
          int so = r * 128 + ((kc ^ ((r >> 1) & 7)) << 4);
          blockdiag8(xv, p.in[zz + I_WK], ch0, 0.0625f, kv);
          *(uint4*)(R1 + 16384 + so) = pack8(kv);
          SB();
          blockdiag8(xv, p.in[zz + I_WQ], ch0, 1.f, qv);
          *(uint4*)(R1 + so) = pack8(qv);
          float qn = 0.f;
#pragma unroll
          for (int e = 0; e < 8; ++e) qn += qv[e] * sN[dp * 64 + kc * 8 + e];
          qn += __shfl_xor(qn, 1); qn += __shfl_xor(qn, 2); qn += __shfl_xor(qn, 4);
          if (kc == 0) sQn[r] += qn;
          SB();
        }
        __syncthreads();
        mma_panel<2, 2>(sa, R1, (wid & 1) * 64, R1 + 16384, (wid >> 1) * 64, lane);
        __syncthreads();
      }
#pragma unroll
      for (int mi = 0; mi < 2; ++mi)
#pragma unroll
        for (int ni = 0; ni < 2; ++ni) {
          int s = (wid >> 1) * 64 + ni * 32 + (lane & 31);
          float lb = sLb[s];
#pragma unroll
          for (int i = 0; i < 16; ++i) {
            int t = (wid & 1) * 64 + mi * 32 + ACC_ROW(i, lane);
            float v = (s <= t) ? sa[mi][ni][i] * __expf(sBc[t] + lb) : 0.f;
            *(u16*)(R0 + (s >> 6) * 16384 + img_off(t, s & 63)) = f2bf(v);
            if ((i & 3) == 3) SB();
          }
        }
      __syncthreads();
      if (tid < 128) {
        float sm = 0.f;
        _Pragma("unroll 4")
        for (int kc = 0; kc < 16; ++kc) {
          float v[8];
          unpack8(*(const uint4*)(R0 + (kc >> 3) * 16384 + tid * 128 + (((kc & 7) ^ ((tid >> 1) & 7)) << 4)), v);
#pragma unroll
          for (int e = 0; e < 8; ++e) sm += v[e];
        }
        float den = sm + sWi[tid] * sQn[tid];
#ifdef DBG_DEN1
        sDen[tid] = 1.f + 0.f * den;
#else
        sDen[tid] = 1.f / fmaxf(fabsf(den), __expf(-sMt[tid]));
#endif
      }
      __syncthreads();
      _Pragma("unroll 1")
      for (int vh = 0; vh < 2; ++vh) {
        f32x16 oa[2][2];
        zero_acc<2, 2>(oa);
        _Pragma("unroll 4")
        for (int k_ = 0; k_ < (128 * 16) / 256; ++k_) { const int i = tid + k_ * 256;
          int jc = i & 15, s = i >> 4;
          int ch0 = h * 256 + vh * 128 + jc * 8;
          uint4 q = *(const uint4*)(proj + (size_t)(rowbase + s) * PJ + 2560 + ch0);
          float xv[8], v[8]; unpack8(q, xv);
          blockdiag8(xv, p.in[zz + I_WV], ch0, 1.f, v);
          img_put_t(R1, 128, jc * 8, s, v);
        }
        __syncthreads();
#pragma unroll
        for (int pn = 0; pn < 2; ++pn) mma_panel<2, 2>(oa, R0 + pn * 16384, (wid & 1) * 64, R1 + pn * 16384, (wid >> 1) * 64, lane);
        __syncthreads();
        const u16* st = (const u16*)(p.ws + B_MLST) + ((size_t)((b * 4 + h) * 16 + c)) * 65536;
        _Pragma("unroll 1")
        for (int dp = 0; dp < DBG_DPN; ++dp) {
          _Pragma("unroll")
          for (int k_ = 0; k_ < (128 * 8) / 256; ++k_) { const int i = tid + k_ * 256;
            int kc = i & 7, r = i >> 3;
            int ch0 = h * 256 + dp * 64 + kc * 8;
            uint4 q = *(const uint4*)(xm + (size_t)(rowbase + r) * 1024 + ch0);
            float xv[8], qv[8]; unpack8(q, xv);
            blockdiag8(xv, p.in[zz + I_WQ], ch0, sWi[r], qv);
            int so = r * 128 + ((kc ^ ((r >> 1) & 7)) << 4);
            *(uint4*)(R1 + so) = pack8(qv);
            uint4 cq = *(const uint4*)(st + (size_t)(vh * 128 + r) * 256 + dp * 64 + kc * 8);
            *(uint4*)(R1 + 16384 + so) = cq;
          }
          __syncthreads();
          mma_panel<2, 2>(oa, R1, (wid & 1) * 64, R1 + 16384, (wid >> 1) * 64, lane);
          __syncthreads();
        }
#pragma unroll
        for (int mi = 0; mi < 2; ++mi)
#pragma unroll
          for (int ni = 0; ni < 2; ++ni) {
            int v = vh * 128 + (wid >> 1) * 64 + ni * 32 + (lane & 31);
#pragma unroll
            for (int i = 0; i < 16; ++i) {
              int t = (wid & 1) * 64 + mi * 32 + ACC_ROW(i, lane);
              float hv = oa[mi][ni][i] * sDen[t];
              mix[(size_t)(rowbase + t) * 2048 + 1024 + h * 256 + v] = f2bf(hv);
              if ((i & 3) == 3) SB();
            }
          }
      }
      asm volatile("s_waitcnt vmcnt(0)" ::: "memory");
      __threadfence_block();
      __syncthreads();
      _Pragma("unroll 4")
      for (int it = 0; it < DBG_NORM_IT; ++it) {
        int t = wid * 32 + it * 2 + (lane >> 5), cc = lane & 31;
        size_t row = rowbase + t;
        int ch = h * 256 + cc * 8;
        u16* ptr = mix + row * 2048 + 1024 + ch;
        float v[8], xa[8], op[8];
        unpack8(*(const uint4*)ptr, v);
        float sq = 0.f;
#pragma unroll
        for (int e = 0; e < 8; ++e) sq += v[e] * v[e];
#pragma unroll
        for (int m = 16; m >= 1; m >>= 1) sq += __shfl_xor(sq, m);
        float rinv = rsqrtf(sq * (1.f / 256.f) + EPS);
        unpack8(*(const uint4*)(xm + row * 1024 + ch), xa);
        unpack8(*(const uint4*)(proj + row * PJ + 3584 + ch), op);
#pragma unroll
        for (int e = 0; e < 8; ++e) v[e] = (v[e] * rinv * p.in[zz + I_MLN][ch + e] + p.in[zz + I_MLS][ch + e] * xa[e]) * sigmoidf(op[e]);
        *(uint4*)ptr = pack8(v);
      }
      __syncthreads();
    }
  }
}

__device__ __forceinline__ void phase_rms(const float* x, const float* g, u16* dst, int bid, int G) {
  for (int w = bid; w < TT / 4; w += 2 * G) {
    FRESH_TID(tid);
    const int lane = tid & 63, wid = tid >> 6;
    int rowa = w * 4 + wid;
    bool hasb = (w + G) < TT / 4;
    int rowb = hasb ? (w + G) * 4 + wid : rowa;
    rms_rows2_bf16(x + (size_t)rowa * 1024, x + (size_t)rowb * 1024, g, dst + (size_t)rowa * 1024, dst + (size_t)rowb * 1024, hasb, lane);
  }
}
__device__ __forceinline__ void phase_rms_final(const P& p, const float* x, int bid, int G) {
  const float* g = p.in[zof(bid) + I_NFIN];
  for (int w = bid; w < TT / 8; w += G) {
    FRESH_TID(tid);
    const int lane = tid & 63, wid = tid >> 6;
    int rowa = w * 8 + wid, rowb = rowa + 4;
    const float* sa = x + (size_t)rowa * 1024;
    const float* sb = x + (size_t)rowb * 1024;
    float4 va[4], vb[4];
    float ssa = 0.f, ssb = 0.f;
#pragma unroll
    for (int i = 0; i < 4; ++i) { va[i] = ((const float4*)sa)[lane + 64 * i]; vb[i] = ((const float4*)sb)[lane + 64 * i]; }
#pragma unroll
    for (int i = 0; i < 4; ++i) {
      ssa += va[i].x * va[i].x + va[i].y * va[i].y + va[i].z * va[i].z + va[i].w * va[i].w;
      ssb += vb[i].x * vb[i].x + vb[i].y * vb[i].y + vb[i].z * vb[i].z + vb[i].w * vb[i].w;
    }
    ssa = wsum(ssa); ssb = wsum(ssb);
    float ra = rsqrtf(ssa * (1.f / 1024.f) + EPS), rb = rsqrtf(ssb * (1.f / 1024.f) + EPS);
    float* oa = p.out + O_Y + (size_t)rowa * 1024;
    float* ob = p.out + O_Y + (size_t)rowb * 1024;
#pragma unroll
    for (int i = 0; i < 4; ++i) {
      float4 g4 = ((const float4*)g)[lane + 64 * i];
      ((float4*)oa)[lane + 64 * i] = make_float4(va[i].x * ra * g4.x, va[i].y * ra * g4.y, va[i].z * ra * g4.z, va[i].w * ra * g4.w);
      ((float4*)ob)[lane + 64 * i] = make_float4(vb[i].x * rb * g4.x, vb[i].y * rb * g4.y, vb[i].z * rb * g4.z, vb[i].w * rb * g4.w);
    }
  }
}
struct ShiftRow { float4 v[4], pv[4]; int mode; };
__device__ __forceinline__ void shift_load(ShiftRow& d, const P& p, int zz0, const float* x, int row, int lane) {
  const float* src = x + (size_t)row * 1024;
  const float* psrc;
  if (row < TP) { d.mode = ((row & 2047) == 0) ? 1 : 0; psrc = d.mode ? src : src - 1024; }
  else { d.mode = 2; psrc = p.in[zz0 + I_SSHIFT] + (size_t)(row - TP) * 1024; }
#pragma unroll
  for (int i = 0; i < 4; ++i) {
    d.v[i] = ((const float4*)src)[lane + 64 * i];
    d.pv[i] = ((const float4*)psrc)[lane + 64 * i];
  }
}
__device__ __forceinline__ void shift_finish(ShiftRow& d, const P& p, const float* g, const float* mu, int row, int lane) {
  float ss = 0.f, ps = 0.f;
#pragma unroll
  for (int i = 0; i < 4; ++i) {
    if (d.mode == 1) d.pv[i] = make_float4(0.f, 0.f, 0.f, 0.f);
    ss += d.v[i].x * d.v[i].x + d.v[i].y * d.v[i].y + d.v[i].z * d.v[i].z + d.v[i].w * d.v[i].w;
    ps += d.pv[i].x * d.pv[i].x + d.pv[i].y * d.pv[i].y + d.pv[i].z * d.pv[i].z + d.pv[i].w * d.pv[i].w;
  }
  ss = wsum(ss); ps = wsum(ps);
  float rinv = rsqrtf(ss * (1.f / 1024.f) + EPS);
  float pinv = rsqrtf(ps * (1.f / 1024.f) + EPS);
#pragma unroll
  for (int i = 0; i < 4; ++i) {
    float4 g4 = ((const float4*)g)[lane + 64 * i];
    float xn[4] = {d.v[i].x * rinv * g4.x, d.v[i].y * rinv * g4.y, d.v[i].z * rinv * g4.z, d.v[i].w * rinv * g4.w};
    float xp[4];
    if (d.mode == 0) { xp[0] = d.pv[i].x * pinv * g4.x; xp[1] = d.pv[i].y * pinv * g4.y; xp[2] = d.pv[i].z * pinv * g4.z; xp[3] = d.pv[i].w * pinv * g4.w; }
    else { xp[0] = d.pv[i].x; xp[1] = d.pv[i].y; xp[2] = d.pv[i].z; xp[3] = d.pv[i].w; }
    int col = (lane + 64 * i) * 4;
    if (row >= TP) *(float4*)(p.out + O_SHS + (size_t)(row - TP) * 1024 + col) = make_float4(xn[0], xn[1], xn[2], xn[3]);
    else if ((row & 2047) == 2047) *(float4*)(p.out + O_SHP + (size_t)(row >> 11) * 1024 + col) = make_float4(xn[0], xn[1], xn[2], xn[3]);
#pragma unroll
    for (int c = 0; c < 6; ++c) {
      float4 m4 = *(const float4*)(mu + c * 1024 + col);
      uint2 o;
      o.x = pk2(xn[0] + (xp[0] - xn[0]) * m4.x, xn[1] + (xp[1] - xn[1]) * m4.y);
      o.y = pk2(xn[2] + (xp[2] - xn[2]) * m4.z, xn[3] + (xp[3] - xn[3]) * m4.w);
      size_t base = (c < 5) ? (3 * U + (size_t)c * U) : B_A;
      *(uint2*)((u16*)(p.ws + base) + (size_t)row * 1024 + col) = o;
    }
  }
}
__device__ __forceinline__ void phase_rms_shift(const P& p, const float* x, int bid, int G) {
  const int zz0 = zof(bid);
  const float* g = p.in[zz0 + I_NMIX] + 1024;
  const float* mu = p.in[zz0 + I_MU];
  for (int w = bid; w < TT / 8; w += G) {
    FRESH_TID(tid);
    const int lane = tid & 63, wid = tid >> 6;
    int rowa = w * 8 + wid, rowb = rowa + 4;
    ShiftRow da, db;
    shift_load(da, p, zz0, x, rowa, lane);
    shift_load(db, p, zz0, x, rowb, lane);
    shift_finish(da, p, g, mu, rowa, lane);
    shift_finish(db, p, g, mu, rowb, lane);
  }
}

__device__ __forceinline__ void phase_wkv(const P& p, char* lds, int bid, int G) {
  const u16* rb = (const u16*)(p.ws + B_RB);
  const u16* kb = (const u16*)(p.ws + B_KB);
  const u16* vb = (const u16*)(p.ws + B_VB);
  const u16* ab = (const u16*)(p.ws + B_AB);
  const float* dec = (const float*)(p.ws + B_DEC);
  float* yraw = (float*)(p.ws + B_YRAW);
  float* buf = (float*)lds;
  for (int w = bid; w < 768; w += G) {
#ifdef DBG_SKIP_PROMPT
    if (w < 256) continue;
#endif
    FRESH_TID(tid);
    const int zz = zof(w);
    const int lane = tid & 63, wid = tid >> 6;
    if (w < 256) {
      const int half = w & 1, h = (w >> 1) & 15, b = w >> 5;
      const int j = lane & 7, vrow = half * 32 + wid * 8 + (lane >> 3);
      const int tl = tid >> 4, sub = tid & 15, ch = h * 64 + sub * 4;
      float S[8];
#pragma unroll
      for (int i = 0; i < 8; ++i) S[i] = 0.f;
      float kkw[4], kaw[4];
#pragma unroll
      for (int e = 0; e < 4; ++e) { kkw[e] = p.in[zz + I_KK][ch + e]; kaw[e] = p.in[zz + I_KA][ch + e]; }
      uint2 lr, lk, lv, la; float4 lw;
      auto gload = [&](int tc) {
        size_t o = (size_t)(b * 2048 + tc * 16 + tl) * 1024 + ch;
#ifdef DBG_SYNTH
        { const float* xp = p.in[zz + I_XP] + o; float4 t4 = *(const float4*)xp;
          lr.x = pk2(t4.x, t4.y); lr.y = pk2(t4.z, t4.w); lk = lr; lv = lr; la.x = pk2(0.5f, 0.4f); la.y = pk2(0.6f, 0.5f);
          lw = make_float4(0.9f, 0.95f, 0.99f, 0.8f); }
#else
        lr = *(const uint2*)(rb + o); lk = *(const uint2*)(kb + o); lv = *(const uint2*)(vb + o); la = *(const uint2*)(ab + o);
        lw = *(const float4*)(dec + o);
#endif
      };
      auto lstore = [&](int bi) {
        float* tb = buf + bi * 6144 + tl * 384 + sub * 4;
        float k[4] = {lo2f(lk.x), hi2f(lk.x), lo2f(lk.y), hi2f(lk.y)};
        float a[4] = {lo2f(la.x), hi2f(la.x), lo2f(la.y), hi2f(la.y)};
        float kk[4], n2 = 0.f;
#pragma unroll
        for (int e = 0; e < 4; ++e) { kk[e] = k[e] * kkw[e]; n2 += kk[e] * kk[e]; }
        n2 += __shfl_xor(n2, 1); n2 += __shfl_xor(n2, 2); n2 += __shfl_xor(n2, 4); n2 += __shfl_xor(n2, 8);
        float inv = 1.f / fmaxf(sqrtf(n2), 1e-12f);
        float kp[4], bb[4];
#pragma unroll
        for (int e = 0; e < 4; ++e) { kk[e] *= inv; kp[e] = k[e] * (1.f + (a[e] - 1.f) * kaw[e]); bb[e] = kk[e] * a[e]; }
        *(float4*)(tb) = lw;
        *(float4*)(tb + 64) = make_float4(kk[0], kk[1], kk[2], kk[3]);
        *(float4*)(tb + 128) = make_float4(bb[0], bb[1], bb[2], bb[3]);
        *(float4*)(tb + 192) = make_float4(kp[0], kp[1], kp[2], kp[3]);
        *(float4*)(tb + 256) = make_float4(lo2f(lr.x), hi2f(lr.x), lo2f(lr.y), hi2f(lr.y));
        *(float4*)(tb + 320) = make_float4(lo2f(lv.x), hi2f(lv.x), lo2f(lv.y), hi2f(lv.y));
      };
      gload(0);
      lstore(0);
      __syncthreads();
      for (int tc = 0; tc < 128; ++tc) {
        const int cur = tc & 1;
        if (tc + 1 < 128) gload(tc + 1);
        const float* cb = buf + cur * 6144;
        float* yo = yraw + (size_t)(b * 2048 + tc * 16) * 1024 + h * 64 + vrow;
#pragma unroll 4
        for (int t = 0; t < 16; ++t) {
          const float* tb = cb + t * 384 + j * 8;
          float4 w0 = *(const float4*)(tb), w1 = *(const float4*)(tb + 4);
          float4 k0 = *(const float4*)(tb + 64), k1 = *(const float4*)(tb + 68);
          float4 b0 = *(const float4*)(tb + 128), b1 = *(const float4*)(tb + 132);
          float4 p0 = *(const float4*)(tb + 192), p1 = *(const float4*)(tb + 196);
          float4 r0 = *(const float4*)(tb + 256), r1 = *(const float4*)(tb + 260);
          float vv = cb[t * 384 + 320 + vrow];
          float sa = S[0] * k0.x + S[1] * k0.y + S[2] * k0.z + S[3] * k0.w + S[4] * k1.x + S[5] * k1.y + S[6] * k1.z + S[7] * k1.w;
          sa += DPPF(sa, 0xB1);
          sa += DPPF(sa, 0x4E);
          sa += DPPF(sa, 0x141);
          sa = -sa;
          S[0] = S[0] * w0.x + (sa * b0.x + vv * p0.x);
          S[1] = S[1] * w0.y + (sa * b0.y + vv * p0.y);
          S[2] = S[2] * w0.z + (sa * b0.z + vv * p0.z);
          S[3] = S[3] * w0.w + (sa * b0.w + vv * p0.w);
          S[4] = S[4] * w1.x + (sa * b1.x + vv * p1.x);
          S[5] = S[5] * w1.y + (sa * b1.y + vv * p1.y);
          S[6] = S[6] * w1.z + (sa * b1.z + vv * p1.z);
          S[7] = S[7] * w1.w + (sa * b1.w + vv * p1.w);
          float y = S[0] * r0.x + S[1] * r0.y + S[2] * r0.z + S[3] * r0.w + S[4] * r1.x + S[5] * r1.y + S[6] * r1.z + S[7] * r1.w;
          y += DPPF(y, 0xB1);
          y += DPPF(y, 0x4E);
          y += DPPF(y, 0x141);
          if (j == 0) yo[(size_t)t * 1024] = y;
        }
        if (tc + 1 < 128) lstore(cur ^ 1);
        __syncthreads();
      }
      float* so = p.out + O_WKVP + ((size_t)((b * 16 + h) * 64 + vrow)) * 64 + j * 8;
      *(float4*)so = make_float4(S[0], S[1], S[2], S[3]);
      *(float4*)(so + 4) = make_float4(S[4], S[5], S[6], S[7]);
    } else {
      const int it = (w - 256) * 4 + wid;
      const int bs = it >> 4, h = it & 15, row = TP + bs;
      float* vb_ = buf + wid * 320;
      {
        size_t o = (size_t)row * 1024 + h * 64 + lane;
        float k = bf2f(kb[o]), a = bf2f(ab[o]);
        float kk = k * p.in[zz + I_KK][h * 64 + lane];
        float n2 = wsum(kk * kk);
        kk *= 1.f / fmaxf(sqrtf(n2), 1e-12f);
        vb_[lane] = dec[o];
        vb_[64 + lane] = kk;
        vb_[128 + lane] = kk * a;
        vb_[192 + lane] = k * (1.f + (a - 1.f) * p.in[zz + I_KA][h * 64 + lane]);
        vb_[256 + lane] = bf2f(rb[o]);
      }
      float vv = bf2f(vb[(size_t)row * 1024 + h * 64 + lane]);
      const float* st = p.in[zz + I_SWKV] + ((size_t)((bs * 16 + h) * 64 + lane)) * 64;
      float* so = p.out + O_WKVS + ((size_t)((bs * 16 + h) * 64 + lane)) * 64;
      float4 S4[16];
#pragma unroll
      for (int i = 0; i < 16; ++i) S4[i] = *(const float4*)(st + i * 4);
      float sa = 0.f;
#pragma unroll
      for (int i = 0; i < 16; ++i) {
        float4 k4 = *(const float4*)(vb_ + 64 + i * 4);
        sa += S4[i].x * k4.x + S4[i].y * k4.y + S4[i].z * k4.z + S4[i].w * k4.w;
      }
      sa = -sa;
      float y = 0.f;
#pragma unroll
      for (int i = 0; i < 16; ++i) {
        float4 w4 = *(const float4*)(vb_ + i * 4), b4 = *(const float4*)(vb_ + 128 + i * 4);
        float4 p4 = *(const float4*)(vb_ + 192 + i * 4), r4 = *(const float4*)(vb_ + 256 + i * 4);
        float4 s = S4[i];
        s.x = s.x * w4.x + (sa * b4.x + vv * p4.x);
        s.y = s.y * w4.y + (sa * b4.y + vv * p4.y);
        s.z = s.z * w4.z + (sa * b4.z + vv * p4.z);
        s.w = s.w * w4.w + (sa * b4.w + vv * p4.w);
        y += s.x * r4.x + s.y * r4.y + s.z * r4.z + s.w * r4.w;
        *(float4*)(so + i * 4) = s;
      }
      yraw[(size_t)row * 1024 + h * 64 + lane] = y;
      __syncthreads();
    }
  }
}

__device__ __forceinline__ void phase_wkv_ln(const P& p, int bid, int G) {
  const u16* rb = (const u16*)(p.ws + B_RB);
  const u16* kb = (const u16*)(p.ws + B_KB);
  const u16* vb = (const u16*)(p.ws + B_VB);
  const u16* ab = (const u16*)(p.ws + B_AB);
  const u16* gb = (const u16*)(p.ws + B_GB);
  const float* yraw = (const float*)(p.ws + B_YRAW);
  u16* yb = (u16*)(p.ws + B_YB);
  for (int w = bid; w < TT / 4; w += G) {
    FRESH_TID(tid);
    const int zz = zof(w);
    const int lane = tid & 63, wid = tid >> 6;
    int row = w * 4 + wid;
    size_t o = (size_t)row * 1024 + lane * 16;
    float y[16], r[16], k[16], v[16], a[16], g[16];
#pragma unroll
    for (int i = 0; i < 4; ++i) {
      float4 t = *(const float4*)(yraw + o + i * 4);
      y[i * 4] = t.x; y[i * 4 + 1] = t.y; y[i * 4 + 2] = t.z; y[i * 4 + 3] = t.w;
    }
    unpack8(*(const uint4*)(rb + o), r); unpack8(*(const uint4*)(rb + o + 8), r + 8);
    unpack8(*(const uint4*)(kb + o), k); unpack8(*(const uint4*)(kb + o + 8), k + 8);
    unpack8(*(const uint4*)(vb + o), v); unpack8(*(const uint4*)(vb + o + 8), v + 8);
    unpack8(*(const uint4*)(ab + o), a); unpack8(*(const uint4*)(ab + o + 8), a + 8);
    unpack8(*(const uint4*)(gb + o), g); unpack8(*(const uint4*)(gb + o + 8), g + 8);
    int c0 = lane * 16;
    float sm = 0.f, bon = 0.f;
#pragma unroll
    for (int e = 0; e < 16; ++e) {
      sm += y[e];
      float kp = k[e] * (1.f + (a[e] - 1.f) * p.in[zz + I_KA][c0 + e]);
      bon += r[e] * kp * p.in[zz + I_RK][c0 + e];
    }
    sm += __shfl_xor(sm, 1); sm += __shfl_xor(sm, 2);
    bon += __shfl_xor(bon, 1); bon += __shfl_xor(bon, 2);
    float mean = sm * (1.f / 64.f), vr = 0.f;
#pragma unroll
    for (int e = 0; e < 16; ++e) { float d = y[e] - mean; vr += d * d; }
    vr += __shfl_xor(vr, 1); vr += __shfl_xor(vr, 2);
    float rinv = rsqrtf(vr * (1.f / 64.f) + 64e-5f);
    float ov[16];
#pragma unroll
    for (int e = 0; e < 16; ++e)
      ov[e] = ((y[e] - mean) * rinv * p.in[zz + I_LNW][c0 + e] + p.in[zz + I_LNB][c0 + e] + bon * v[e]) * g[e];
    *(uint4*)(yb + o) = pack8(ov);
    *(uint4*)(yb + o + 8) = pack8(ov + 8);
  }
}

__device__ __forceinline__ void run_phase(const P& p, int ph, char* lds, int bid, int G) {
  char* ws = p.ws;
  const int zz = zof(ph);
  switch (ph) {
    case 0: if (PHEN(0)) phase_prep(p, lds, bid, G); break;
    case 1: { if (!PHEN(1)) break;
      EpiProj e{(u16*)(ws + B_PROJ), (float*)(ws + B_SMALL)};
      gemm_phase((const u16*)(ws + B_A), 1024, (const u16*)(ws + W_IN0), 1024, 1024, 65, 37, lds, bid, G, e);
    } break;
    case 2: if (PHEN(2)) phase_conv(p, lds, bid, G); break;
    case 3: if (PHEN(3)) phase_chunkstate(p, lds, bid, G); break;
    case 4: if (PHEN(4)) phase_scan(p, lds, bid, G); break;
    case 5: if (PHEN(5)) phase_chunkout(p, lds, bid, G); break;
    case 6: { if (!PHEN(6)) break;
      EpiRes e{p.in[zz + I_XP], p.in[zz + I_XS], (float*)(ws + B_X1)};
      gemm_phase((const u16*)(ws + B_MIX), 2048, (const u16*)(ws + W_OUT0), 2048, 2048, 65, 8, lds, bid, G, e);
    } break;
    case 7: if (PHEN(7)) phase_rms((const float*)(ws + B_X1), p.in[zz + I_NFFN], (u16*)(ws + B_A), bid, G); break;
    case 8: { if (!PHEN(8)) break;
      EpiSwiglu e{(u16*)(ws + B_HB)};
      gemm_phase((const u16*)(ws + B_A), 1024, (const u16*)(ws + W_GU), 1024, 1024, 65, 44, lds, bid, G, e);
    } break;
    case 9: { if (!PHEN(9)) break;
      const float* x1 = (const float*)(ws + B_X1);
      EpiRes e{x1, x1 + (size_t)TP * 1024, (float*)(ws + B_X2)};
      gemm_phase((const u16*)(ws + B_HB), 2816, (const u16*)(ws + W_DN), 2816, 2816, 65, 8, lds, bid, G, e);
    } break;
    case 10: if (PHEN(10)) phase_rms_shift(p, (const float*)(ws + B_X2), bid, G); break;
    case 11: { if (!PHEN(11)) break;
      const int nbig = 3 * 65 * 8;
      for (int t = bid; t < nbig + 65 * 4; t += G) {
        if (t < nbig) {
          int which = t / (65 * 8), r = t % (65 * 8);
          int mt = r % 65, nt = r / 65;
          size_t abase = which == 0 ? 3 * U : (which == 1 ? 5 * U : 6 * U);
          size_t wbase = which == 0 ? W_R : (which == 1 ? W_K : W_V);
          size_t obase = which == 0 ? B_RB : (which == 1 ? B_KB : B_VB);
          EpiAct e{(u16*)(ws + obase), 1024, 1024, 1024, 0};
          gemm_tile((const u16*)(ws + abase), 1024, (const u16*)(ws + wbase), 1024, 1024, mt * 256, nt * 128, lds, e);
        } else {
          int r = t - nbig;
          if (r < 65) {
            EpiAct e{(u16*)(ws + B_LW), 128, 64, 128, 1};
            gemm_tile((const u16*)(ws + 4 * U), 1024, (const u16*)(ws + W_W1), 1024, 1024, r * 256, 0, lds, e);
          } else if (r < 130) {
            EpiAct e{(u16*)(ws + B_LA), 128, 64, 128, 0};
            gemm_tile((const u16*)(ws + 7 * U), 1024, (const u16*)(ws + W_A1), 1024, 1024, (r - 65) * 256, 0, lds, e);
          } else {
            int q = r - 130;
            EpiAct e{(u16*)(ws + B_LG), 256, 160, 256, 2};
            gemm_tile((const u16*)(ws + B_A), 1024, (const u16*)(ws + W_G1), 1024, 1024, (q % 65) * 256, (q / 65) * 128, lds, e);
          }
        }
      }
    } break;
    case 12: { if (!PHEN(12)) break;
      for (int t = bid; t < 3 * 65 * 8; t += G) {
        int which = t / (65 * 8), r = t % (65 * 8);
        int mt = r % 65, nt = r / 65;
        if (which == 0) {
          EpiLora2 e{0, p.in[zz + I_W0], (float*)(ws + B_DEC), nullptr};
          gemm_tile((const u16*)(ws + B_LW), 128, (const u16*)(ws + W_W2), 128, 128, mt * 256, nt * 128, lds, e);
        } else if (which == 1) {
          EpiLora2 e{1, p.in[zz + I_A0], nullptr, (u16*)(ws + B_AB)};
          gemm_tile((const u16*)(ws + B_LA), 128, (const u16*)(ws + W_A2), 128, 128, mt * 256, nt * 128, lds, e);
        } else {
          EpiLora2 e{2, nullptr, nullptr, (u16*)(ws + B_GB)};
          gemm_tile((const u16*)(ws + B_LG), 256, (const u16*)(ws + W_G2), 256, 256, mt * 256, nt * 128, lds, e);
        }
      }
    } break;
    case 13: if (PHEN(13)) phase_wkv(p, lds, bid, G); break;
    case 14: if (PHEN(14)) phase_wkv_ln(p, bid, G); break;
    case 15: { if (!PHEN(15)) break;
      const float* x2 = (const float*)(ws + B_X2);
      EpiRes e{x2, x2 + (size_t)TP * 1024, (float*)(ws + B_X3)};
      gemm_phase((const u16*)(ws + B_YB), 1024, (const u16*)(ws + W_O), 1024, 1024, 65, 8, lds, bid, G, e);
    } break;
    case 16: if (PHEN(16)) phase_rms((const float*)(ws + B_X3), p.in[zz + I_NFFN] + 1024, (u16*)(ws + B_A), bid, G); break;
    case 17: { if (!PHEN(17)) break;
      EpiSwiglu e{(u16*)(ws + B_HB)};
      gemm_phase((const u16*)(ws + B_A), 1024, (const u16*)(ws + W_GU + 5632ull * 1024 * 2), 1024, 1024, 65, 44, lds, bid, G, e);
    } break;
    case 18: { if (!PHEN(18)) break;
      const float* x3 = (const float*)(ws + B_X3);
      EpiRes e{x3, x3 + (size_t)TP * 1024, (float*)(ws + B_X4)};
      gemm_phase((const u16*)(ws + B_HB), 2816, (const u16*)(ws + W_DN + 1024ull * 2816 * 2), 2816, 2816, 65, 8, lds, bid, G, e);
    } break;
    case 19: if (PHEN(19)) phase_rms_final(p, (const float*)(ws + B_X4), bid, G); break;
#ifdef DBG_MIX_OFF
    case 100: {
      for (size_t i = (size_t)bid * 256 + threadIdx.x; i < (size_t)TT * 1024; i += (size_t)G * 256) {
        size_t row = i >> 10; int c = (int)(i & 1023);
        p.out[O_Y + i] = bf2f(((const u16*)(p.ws + B_MIX))[row * 2048 + DBG_MIX_OFF + c]);
      }
    } break;
#endif
    default: break;
  }
}

#ifndef MK_LB
#define MK_LB 1
#endif
__global__ void __launch_bounds__(256, MK_LB) mk_forward(P p, int ph_lo, int ph_hi) {
  extern __shared__ __attribute__((aligned(16))) char lds[];
  cg::grid_group grid = cg::this_grid();
  const int bid = blockIdx.x, G = gridDim.x;
#ifdef TM_A
  unsigned long long tm0 = wall_clock64(), tm1 = 0, tm2 = 0;
#endif
#if !MK_MULTI
  unsigned* bar = (unsigned*)(p.ws + M_BAR);
  const unsigned xcc = (unsigned)__builtin_amdgcn_s_getreg((3 << 11) | 20) & 0xFu;
  unsigned nloc = 0, nx = 0;
  if (threadIdx.x == 0) __hip_atomic_fetch_add(&bar[xcc * 64], 1u, __ATOMIC_RELAXED, __HIP_MEMORY_SCOPE_AGENT);
#endif
  for (int ph = ph_lo; ph < ph_hi; ++ph) {
    run_phase(p, ph, lds, bid, G);
    if (ph + 1 < ph_hi) {
#if MK_MULTI
      grid.sync();
#else
      if (ph == ph_lo) {
        grid.sync();
        if (threadIdx.x == 0) {
          for (int j = 0; j < 16; ++j) {
            unsigned c = __hip_atomic_load(&bar[j * 64], __ATOMIC_RELAXED, __HIP_MEMORY_SCOPE_AGENT);
            if (c) ++nx;
            if ((unsigned)j == xcc) nloc = c;
          }
        }
      } else {
        asm volatile("s_waitcnt vmcnt(0)" ::: "memory");
        __syncthreads();
        if (threadIdx.x == 0) {
          unsigned* sub = bar + 64 * (16 + ph * 33 + xcc);
          unsigned* gen = bar + 64 * (16 + ph * 33 + 16 + xcc);
          unsigned* top = bar + 64 * (16 + ph * 33 + 32);
          unsigned old = __hip_atomic_fetch_add(sub, 1u, __ATOMIC_RELAXED, __HIP_MEMORY_SCOPE_AGENT);
          if (old == nloc - 1) {
            __builtin_amdgcn_fence(__ATOMIC_RELEASE, "agent");
            asm volatile("s_waitcnt vmcnt(0)" ::: "memory");
            __hip_atomic_fetch_add(top, 1u, __ATOMIC_RELAXED, __HIP_MEMORY_SCOPE_AGENT);
            while (__hip_atomic_load(top, __ATOMIC_RELAXED, __HIP_MEMORY_SCOPE_AGENT) < nx) __builtin_amdgcn_s_sleep(1);
            __hip_atomic_store(gen, 1u, __ATOMIC_RELAXED, __HIP_MEMORY_SCOPE_AGENT);
          } else {
            while (__hip_atomic_load(gen, __ATOMIC_RELAXED, __HIP_MEMORY_SCOPE_AGENT) == 0u) __builtin_amdgcn_s_sleep(1);
          }
        }
        __syncthreads();
        __builtin_amdgcn_fence(__ATOMIC_ACQUIRE, "agent");
        asm volatile("s_waitcnt vmcnt(0)" ::: "memory");
      }
#endif
    }
#ifdef TM_A
    if (ph == TM_A) tm1 = wall_clock64();
    if (ph == TM_B) tm2 = wall_clock64();
#endif
  }
#ifdef TM_A
  grid.sync();
  if (bid == 0 && threadIdx.x == 0) {
    unsigned long long tm3 = wall_clock64();
    float tot = (float)(tm3 - tm0);
    float f1 = (float)(tm1 - tm0) / tot, f2 = (float)(tm2 - tm0) / tot;
    float sc = 1.f + sqrtf(0.01f + 0.5f * f1);
    for (int i = 0; i < 32; ++i) p.out[O_MMP + i] *= sc;
    p.out[O_Y + (size_t)TP * 1024] += 1.f + 10.f * f2;
  }
#endif
#if defined(DBG_MIX_OFF) && !MK_MULTI
  grid.sync();
  run_phase(p, 100, lds, bid, G);
#endif

}

extern "C" void kernel_launch(void* const* d_in, const int* in_sizes, int n_in, void* d_out, int out_size, void* d_ws,
                              size_t ws_size, hipStream_t stream) {
  static int grid_blocks = 0;
  if (!grid_blocks) {
    hipFuncSetAttribute((const void*)mk_forward, hipFuncAttributeMaxDynamicSharedMemorySize, LDS_BYTES);
    int dev = 0, cus = 0, per_cu = 0;
    hipGetDevice(&dev);
    hipDeviceGetAttribute(&cus, hipDeviceAttributeMultiprocessorCount, dev);
    hipOccupancyMaxActiveBlocksPerMultiprocessor(&per_cu, mk_forward, 256, LDS_BYTES);
    if (per_cu > 2) per_cu = 2;
    if (per_cu < 1) per_cu = 1;
    grid_blocks = cus * per_cu;
  }
  P p{};
  for (int i = 0; i < N_IN; ++i) p.in[i] = (const float*)d_in[i];
  p.out = (float*)d_out;
  p.ws = (char*)d_ws;
  if (ws_size < WS_NEED) fprintf(stderr, "workspace too small: %zu < %zu\n", ws_size, (size_t)WS_NEED);
#if MK_MULTI
#ifndef MK_HI
#define MK_HI NPH
#endif
  for (int ph = 0; ph < MK_HI; ++ph) {
    int lo = ph, hi = ph + 1;
    hipLaunchKernelGGL(mk_forward, dim3(grid_blocks), dim3(256), LDS_BYTES, stream, p, lo, hi);
  }
#ifdef DBG_MIX_OFF
  hipLaunchKernelGGL(mk_forward, dim3(grid_blocks), dim3(256), LDS_BYTES, stream, p, 100, 101);
#endif
#else
#ifndef MK_HI
#define MK_HI NPH
#endif
  int lo = 0, hi = MK_HI;
  hipMemsetAsync((char*)d_ws + M_BAR, 0, (size_t)BAR_WORDS * 4, stream);
  void* args[] = {&p, &lo, &hi};
  hipError_t e = hipLaunchCooperativeKernel((void*)mk_forward, dim3(grid_blocks), dim3(256), args, LDS_BYTES, stream);
  if (e != hipSuccess) fprintf(stderr, "cooperative launch failed: %s (grid %d)\n", hipGetErrorString(e), grid_blocks);
#endif
}
```

```cpp
#include <hip/hip_runtime.h>
#include <hip/hip_cooperative_groups.h>
#include <cstdio>
namespace cg = cooperative_groups;

#ifndef DBG_DPN
#define DBG_DPN 4
#endif
#ifndef DBG_NORM_IT
#define DBG_NORM_IT 16
#endif
#ifndef MK_MULTI
#define MK_MULTI 0
#endif
#ifdef ONLY_PH
#define PHEN(n) ((n) == ONLY_PH)
#else
#define PHEN(n) true
#endif

#define SB() __builtin_amdgcn_sched_barrier(0)
typedef unsigned short u16;
typedef __attribute__((ext_vector_type(8))) short bf16x8;
typedef __attribute__((ext_vector_type(16))) float f32x16;

constexpr int TP = 16384, TS = 128, TT = 16512, DM = 1024;
constexpr int PJ = 4608;
constexpr int NPH = 20;
constexpr float EPS = 1e-5f;

enum { I_XP = 0, I_XS, I_SCONV, I_SSSM, I_SMC, I_SMN, I_SMM, I_SSHIFT, I_SWKV, I_NMIX, I_NFFN, I_NFIN, I_WIN0,
       I_CONVW, I_CONVB, I_DTB, I_ALOG, I_SSDD, I_SSDN, I_WQ, I_WK, I_WV, I_IB, I_FB, I_MLN, I_MLS, I_WOUT0,
       I_MU, I_WR, I_WKK, I_WVV, I_WO, I_W0, I_W1, I_W2, I_A0, I_A1, I_A2, I_G1, I_G2, I_KK, I_KA, I_RK,
       I_LNW, I_LNB, I_GU, I_DN, N_IN };

constexpr size_t O_Y = 0;
constexpr size_t O_CONVP = O_Y + (size_t)TT * 1024;
constexpr size_t O_CONVS = O_CONVP + 8 * 3 * 2560;
constexpr size_t O_SSMP = O_CONVS + 128 * 3 * 2560;
constexpr size_t O_SSMS = O_SSMP + 8ull * 16 * 64 * 128;
constexpr size_t O_MCP = O_SSMS + 128ull * 16 * 64 * 128;
constexpr size_t O_MCS = O_MCP + 8ull * 4 * 256 * 256;
constexpr size_t O_MNP = O_MCS + 128ull * 4 * 256 * 256;
constexpr size_t O_MNS = O_MNP + 8 * 4 * 256;
constexpr size_t O_MMP = O_MNS + 128 * 4 * 256;
constexpr size_t O_MMS = O_MMP + 32;
constexpr size_t O_SHP = O_MMS + 512;
constexpr size_t O_SHS = O_SHP + 8 * 1024;
constexpr size_t O_WKVP = O_SHS + 128 * 1024;
constexpr size_t O_WKVS = O_WKVP + 8ull * 16 * 64 * 64;

constexpr size_t U = 33ull << 20;
constexpr size_t W_IN0 = 0;
constexpr size_t W_OUT0 = W_IN0 + 4736ull * 1024 * 2;
constexpr size_t W_GU = W_OUT0 + 1024ull * 2048 * 2;
constexpr size_t W_DN = W_GU + 2ull * 5632 * 1024 * 2;
constexpr size_t W_R = W_DN + 2ull * 1024 * 2816 * 2;
constexpr size_t W_K = W_R + 1024ull * 1024 * 2;
constexpr size_t W_V = W_K + 1024ull * 1024 * 2;
constexpr size_t W_O = W_V + 1024ull * 1024 * 2;
constexpr size_t W_W1 = W_O + 1024ull * 1024 * 2;
constexpr size_t W_A1 = W_W1 + 128ull * 1024 * 2;
constexpr size_t W_G1 = W_A1 + 128ull * 1024 * 2;
constexpr size_t W_W2 = W_G1 + 256ull * 1024 * 2;
constexpr size_t W_A2 = W_W2 + 1024ull * 128 * 2;
constexpr size_t W_G2 = W_A2 + 1024ull * 128 * 2;
constexpr size_t W_END = W_G2 + 1024ull * 256 * 2;
static_assert(W_END <= 2 * U, "weights");
constexpr size_t B_A = 2 * U;
constexpr size_t B_PROJ = 3 * U;
constexpr size_t B_SMALL = 8 * U;
constexpr size_t B_BM = B_SMALL + (size_t)TT * 32 * 4;
constexpr size_t B_CM = B_BM + (size_t)TT * 256 * 2;
constexpr size_t B_XM = 9 * U;
constexpr size_t B_SSDST = 10 * U;
constexpr size_t B_MLST = 11 * U;
constexpr size_t B_MIX = 13 * U;
constexpr size_t B_MISC = 15 * U;
constexpr size_t M_GSUM = B_MISC;
constexpr size_t M_BCUM = M_GSUM + 8 * 4 * 16 * 2 * 4;
constexpr size_t M_LI = M_BCUM + (size_t)TT * 4 * 4;
constexpr size_t M_DT = M_LI + (size_t)TT * 4 * 4;
constexpr size_t M_ACUM = M_DT + (size_t)TT * 16 * 4;
constexpr size_t M_MLN = M_ACUM + (size_t)TT * 16 * 4;
constexpr size_t M_END = M_MLN + 8ull * 4 * 16 * 256 * 4;
constexpr size_t WS_NEED = 15 * U + (8ull << 20);
constexpr size_t M_BAR = M_END;
constexpr int BAR_WORDS = 64 * (16 + 24 * 33);
static_assert(M_BAR + (size_t)BAR_WORDS * 4 <= WS_NEED, "bar");
static_assert(M_END <= WS_NEED, "misc");
static_assert(B_CM + (size_t)TT * 256 * 2 <= 9 * U, "bm/cm");
constexpr size_t B_X1 = 3 * U, B_HB = 5 * U, B_X2 = 8 * U;
constexpr size_t B_RB = 10 * U, B_KB = 11 * U, B_VB = 12 * U;
constexpr size_t B_LW = 13 * U, B_LA = B_LW + (size_t)TT * 128 * 2, B_LG = B_LA + (size_t)TT * 128 * 2;
constexpr size_t B_DEC = 3 * U, B_AB = 5 * U, B_GB = 6 * U, B_YB = 7 * U;
constexpr size_t B_YRAW = 13 * U;
constexpr size_t B_X3 = 3 * U, B_X4 = 8 * U;

constexpr int LDS_BYTES = 98304;

struct P {
  const float* in[N_IN];
  float* out;
  char* ws;
};

__device__ __forceinline__ u16 f2bf(float f) {
  unsigned u = __float_as_uint(f);
  u += 0x7fffu + ((u >> 16) & 1u);
  return (u16)(u >> 16);
}
__device__ __forceinline__ float bf2f(u16 h) { return __uint_as_float(((unsigned)h) << 16); }
__device__ __forceinline__ unsigned pk2(float a, float b) { return (unsigned)f2bf(a) | ((unsigned)f2bf(b) << 16); }
__device__ __forceinline__ float lo2f(unsigned u) { return __uint_as_float(u << 16); }
__device__ __forceinline__ float hi2f(unsigned u) { return __uint_as_float(u & 0xffff0000u); }
__device__ __forceinline__ void unpack8(const uint4& q, float* f) {
  f[0] = lo2f(q.x); f[1] = hi2f(q.x); f[2] = lo2f(q.y); f[3] = hi2f(q.y);
  f[4] = lo2f(q.z); f[5] = hi2f(q.z); f[6] = lo2f(q.w); f[7] = hi2f(q.w);
}
__device__ __forceinline__ uint4 pack8(const float* f) {
  uint4 q; q.x = pk2(f[0], f[1]); q.y = pk2(f[2], f[3]); q.z = pk2(f[4], f[5]); q.w = pk2(f[6], f[7]);
  return q;
}
__device__ __forceinline__ float softplusf(float x) { return x > 20.f ? x : log1pf(__expf(x)); }
__device__ __forceinline__ float sigmoidf(float x) { return 1.f / (1.f + __expf(-x)); }
__device__ __forceinline__ float wsum(float v) {
#pragma unroll
  for (int m = 32; m >= 1; m >>= 1) v += __shfl_xor(v, m);
  return v;
}
__device__ __forceinline__ float wmax(float v) {
#pragma unroll
  for (int m = 32; m >= 1; m >>= 1) v = fmaxf(v, __shfl_xor(v, m));
  return v;
}
__device__ __forceinline__ float wscan(float v, int lane) {
#pragma unroll
  for (int o = 1; o < 64; o <<= 1) {
    float t = __shfl_up(v, o);
    if (lane >= o) v += t;
  }
  return v;
}
__device__ __forceinline__ float bsum(float v, float* scr) {
  v = wsum(v);
  __syncthreads();
  if ((threadIdx.x & 63) == 0) scr[threadIdx.x >> 6] = v;
  __syncthreads();
  return scr[0] + scr[1] + scr[2] + scr[3];
}
__device__ __forceinline__ float dpp_f(float v, const int ctrl);
#define DPPF(v, ctrl) __int_as_float(__builtin_amdgcn_update_dpp(0, __float_as_int(v), ctrl, 0xF, 0xF, true))

__device__ __forceinline__ int img_off(int row, int kk  ) {
  return row * 128 + ((((kk >> 3) ^ ((row >> 1) & 7))) << 4) + ((kk & 7) << 1);
}

template <int MI, int NI>
__device__ __forceinline__ void mma_panel(f32x16 (&acc)[MI][NI], const char* Ap, int ar0, const char* Bp, int br0, int lane) {
  const int r = lane & 31, h = lane >> 5;
  bf16x8 a[2][MI], b[2][NI];
  const char* ap[MI];
  const char* bp[NI];
  int asw[MI], bsw[NI];
#pragma unroll
  for (int mi = 0; mi < MI; ++mi) { int row = ar0 + mi * 32 + r; ap[mi] = Ap + row * 128; asw[mi] = (row >> 1) & 7; }
#pragma unroll
  for (int ni = 0; ni < NI; ++ni) { int row = br0 + ni * 32 + r; bp[ni] = Bp + row * 128; bsw[ni] = (row >> 1) & 7; }
#pragma unroll
  for (int mi = 0; mi < MI; ++mi) a[0][mi] = *(const bf16x8*)(ap[mi] + ((h ^ asw[mi]) << 4));
#pragma unroll
  for (int ni = 0; ni < NI; ++ni) b[0][ni] = *(const bf16x8*)(bp[ni] + ((h ^ bsw[ni]) << 4));
#pragma unroll
  for (int ks = 0; ks < 4; ++ks) {
    const int cur = ks & 1, nxt = cur ^ 1;
    if (ks < 3) {
      const int ch = (ks + 1) * 2 + h;
#pragma unroll
      for (int mi = 0; mi < MI; ++mi) a[nxt][mi] = *(const bf16x8*)(ap[mi] + ((ch ^ asw[mi]) << 4));
#pragma unroll
      for (int ni = 0; ni < NI; ++ni) b[nxt][ni] = *(const bf16x8*)(bp[ni] + ((ch ^ bsw[ni]) << 4));
    }
    SB();
#pragma unroll
    for (int mi = 0; mi < MI; ++mi)
#pragma unroll
      for (int ni = 0; ni < NI; ++ni)
        acc[mi][ni] = __builtin_amdgcn_mfma_f32_32x32x16_bf16(a[cur][mi], b[cur][ni], acc[mi][ni], 0, 0, 0);
    SB();
  }
}
template <int MI, int NI>
__device__ __forceinline__ void mma_panel_s(f32x16 (&acc)[MI][NI], const char* Ap, int ar0, const char* Bp, int br0, int lane) {
  const int r = lane & 31, h = lane >> 5;
#pragma unroll
  for (int ks = 0; ks < 4; ++ks) {
    const int ch = ks * 2 + h;
    bf16x8 a[MI], b[NI];
#pragma unroll
    for (int mi = 0; mi < MI; ++mi) { int row = ar0 + mi * 32 + r; a[mi] = *(const bf16x8*)(Ap + row * 128 + ((ch ^ ((row >> 1) & 7)) << 4)); }
#pragma unroll
    for (int ni = 0; ni < NI; ++ni) { int row = br0 + ni * 32 + r; b[ni] = *(const bf16x8*)(Bp + row * 128 + ((ch ^ ((row >> 1) & 7)) << 4)); }
    SB();
#pragma unroll
    for (int mi = 0; mi < MI; ++mi)
#pragma unroll
      for (int ni = 0; ni < NI; ++ni)
        acc[mi][ni] = __builtin_amdgcn_mfma_f32_32x32x16_bf16(a[mi], b[ni], acc[mi][ni], 0, 0, 0);
    SB();
  }
}
template <int MI, int NI>
__device__ __forceinline__ void zero_acc(f32x16 (&acc)[MI][NI]) {
#pragma unroll
  for (int mi = 0; mi < MI; ++mi)
#pragma unroll
    for (int ni = 0; ni < NI; ++ni)
#pragma unroll
      for (int i = 0; i < 16; ++i) acc[mi][ni][i] = 0.f;
}
#define FRESH_TID(tid) int tid = threadIdx.x; asm volatile("" : "+v"(tid))
__device__ __forceinline__ int zof(int w) { int z; asm("s_mov_b32 %0, 0" : "=s"(z) : "s"(w)); return z; }
#define ACC_ROW(i, lane) (((i) & 3) + 8 * ((i) >> 2) + 4 * ((lane) >> 5))

template <class Epi>
__device__ __forceinline__ void gemm_tile(const u16* __restrict__ A, int lda, const u16* __restrict__ B, int ldb, int K,
                                          int m0, int n0, char* lds, const Epi& epi) {
  FRESH_TID(tid);
  const int lane = tid & 63, wid = tid >> 6, wr = wid & 1, wc = wid >> 1;
  f32x16 acc[4][2];
  epi.init(acc, m0 + wr * 128, n0 + wc * 64, lane);
  const int lrow = tid >> 3, lch = tid & 7;
  const u16* Bp = B + (size_t)(n0 + lrow) * ldb + lch * 8;
  const int soff = lrow * 128 + ((lch ^ ((lrow >> 1) & 7)) << 4);
  int aoff[8];
#pragma unroll
  for (int i = 0; i < 8; ++i) {
    int r = m0 + lrow + 32 * i;
    r = r < TT ? r : TT - 1;
    aoff[i] = (r - m0) * lda;
  }
  const u16* Ab = A + (size_t)m0 * lda + lch * 8;
  uint4 ra0, ra1, ra2, ra3, ra4, ra5, ra6, ra7, rb0, rb1, rb2, rb3, rc0, rc1, rc2, rc3, rc4, rc5, rc6, rc7, rd0, rd1, rd2, rd3;
  const int nk = K >> 6;
  {
    ra0 = *(const uint4*)(Ab + aoff[0] + 0);
    ra1 = *(const uint4*)(Ab + aoff[1] + 0);
    ra2 = *(const uint4*)(Ab + aoff[2] + 0);
    ra3 = *(const uint4*)(Ab + aoff[3] + 0);
    ra4 = *(const uint4*)(Ab + aoff[4] + 0);
    ra5 = *(const uint4*)(Ab + aoff[5] + 0);
    ra6 = *(const uint4*)(Ab + aoff[6] + 0);
    ra7 = *(const uint4*)(Ab + aoff[7] + 0);
    rb0 = *(const uint4*)(Bp + (size_t)(0) * ldb + 0);
    rb1 = *(const uint4*)(Bp + (size_t)(32) * ldb + 0);
    rb2 = *(const uint4*)(Bp + (size_t)(64) * ldb + 0);
    rb3 = *(const uint4*)(Bp + (size_t)(96) * ldb + 0);
    rc0 = *(const uint4*)(Ab + aoff[0] + 64);
    rc1 = *(const uint4*)(Ab + aoff[1] + 64);
    rc2 = *(const uint4*)(Ab + aoff[2] + 64);
    rc3 = *(const uint4*)(Ab + aoff[3] + 64);
    rc4 = *(const uint4*)(Ab + aoff[4] + 64);
    rc5 = *(const uint4*)(Ab + aoff[5] + 64);
    rc6 = *(const uint4*)(Ab + aoff[6] + 64);
    rc7 = *(const uint4*)(Ab + aoff[7] + 64);
    rd0 = *(const uint4*)(Bp + (size_t)(0) * ldb + 64);
    rd1 = *(const uint4*)(Bp + (size_t)(32) * ldb + 64);
    rd2 = *(const uint4*)(Bp + (size_t)(64) * ldb + 64);
    rd3 = *(const uint4*)(Bp + (size_t)(96) * ldb + 64);
    *(uint4*)(lds + 0 + soff + 0) = ra0;
    *(uint4*)(lds + 0 + soff + 4096) = ra1;
    *(uint4*)(lds + 0 + soff + 8192) = ra2;
    *(uint4*)(lds + 0 + soff + 12288) = ra3;
    *(uint4*)(lds + 0 + soff + 16384) = ra4;
    *(uint4*)(lds + 0 + soff + 20480) = ra5;
    *(uint4*)(lds + 0 + soff + 24576) = ra6;
    *(uint4*)(lds + 0 + soff + 28672) = ra7;
    *(uint4*)(lds + 0 + 32768 + soff + 0) = rb0;
    *(uint4*)(lds + 0 + 32768 + soff + 4096) = rb1;
    *(uint4*)(lds + 0 + 32768 + soff + 8192) = rb2;
    *(uint4*)(lds + 0 + 32768 + soff + 12288) = rb3;
  }
  __syncthreads();
  const int r_ = lane & 31, h_ = lane >> 5;
  int arow[4], asw[4], brow[2], bsw[2];
#pragma unroll
  for (int mi = 0; mi < 4; ++mi) { int row = wr * 128 + mi * 32 + r_; arow[mi] = row * 128; asw[mi] = (row >> 1) & 7; }
#pragma unroll
  for (int ni = 0; ni < 2; ++ni) { int row = wc * 64 + ni * 32 + r_; brow[ni] = row * 128; bsw[ni] = (row >> 1) & 7; }
  for (int kt = 0; kt < nk; kt += 2) {
    {
    const int kk = (kt + 2 < nk ? kt + 2 : nk - 1) * 64;
    ra0 = *(const uint4*)(Ab + aoff[0] + kk);
    ra1 = *(const uint4*)(Ab + aoff[1] + kk);
    ra2 = *(const uint4*)(Ab + aoff[2] + kk);
    ra3 = *(const uint4*)(Ab + aoff[3] + kk);
    ra4 = *(const uint4*)(Ab + aoff[4] + kk);
    ra5 = *(const uint4*)(Ab + aoff[5] + kk);
    ra6 = *(const uint4*)(Ab + aoff[6] + kk);
    ra7 = *(const uint4*)(Ab + aoff[7] + kk);
    rb0 = *(const uint4*)(Bp + (size_t)(0) * ldb + kk);
    rb1 = *(const uint4*)(Bp + (size_t)(32) * ldb + kk);
    rb2 = *(const uint4*)(Bp + (size_t)(64) * ldb + kk);
    rb3 = *(const uint4*)(Bp + (size_t)(96) * ldb + kk);
    }
    SB();
    {
      bf16x8 fa[2][4], fb[2][2];
        { const int ch = 0 + h_;
#pragma unroll
          for (int mi = 0; mi < 4; ++mi) fa[0][mi] = *(const bf16x8*)(lds + 0 + arow[mi] + ((ch ^ asw[mi]) << 4));
#pragma unroll
          for (int ni = 0; ni < 2; ++ni) fb[0][ni] = *(const bf16x8*)(lds + 0 + 32768 + brow[ni] + ((ch ^ bsw[ni]) << 4));
        }
        { const int ch = 2 + h_;
#pragma unroll
          for (int mi = 0; mi < 4; ++mi) fa[1][mi] = *(const bf16x8*)(lds + 0 + arow[mi] + ((ch ^ asw[mi]) << 4));
#pragma unroll
          for (int ni = 0; ni < 2; ++ni) fb[1][ni] = *(const bf16x8*)(lds + 0 + 32768 + brow[ni] + ((ch ^ bsw[ni]) << 4));
        }
        SB();
#pragma unroll
        for (int mi = 0; mi < 4; ++mi)
#pragma unroll
          for (int ni = 0; ni < 2; ++ni) acc[mi][ni] = __builtin_amdgcn_mfma_f32_32x32x16_bf16(fa[0][mi], fb[0][ni], acc[mi][ni], 0, 0, 0);
        *(uint4*)(lds + 49152 + soff + 0) = rc0;
        *(uint4*)(lds + 49152 + soff + 4096) = rc1;
        *(uint4*)(lds + 49152 + soff + 8192) = rc2;
        SB();
        { const int ch = 4 + h_;
#pragma unroll
          for (int mi = 0; mi < 4; ++mi) fa[0][mi] = *(const bf16x8*)(lds + 0 + arow[mi] + ((ch ^ asw[mi]) << 4));
#pragma unroll
          for (int ni = 0; ni < 2; ++ni) fb[0][ni] = *(const bf16x8*)(lds + 0 + 32768 + brow[ni] + ((ch ^ bsw[ni]) << 4));
        }
        SB();
#pragma unroll
        for (int mi = 0; mi < 4; ++mi)
#pragma unroll
          for (int ni = 0; ni < 2; ++ni) acc[mi][ni] = __builtin_amdgcn_mfma_f32_32x32x16_bf16(fa[1][mi], fb[1][ni], acc[mi][ni], 0, 0, 0);
        *(uint4*)(lds + 49152 + soff + 12288) = rc3;
        *(uint4*)(lds + 49152 + soff + 16384) = rc4;
        *(uint4*)(lds + 49152 + soff + 20480) = rc5;
        SB();
        { const int ch = 6 + h_;
#pragma unroll
          for (int mi = 0; mi < 4; ++mi) fa[1][mi] = *(const bf16x8*)(lds + 0 + arow[mi] + ((ch ^ asw[mi]) << 4));
#pragma unroll
          for (int ni = 0; ni < 2; ++ni) fb[1][ni] = *(const bf16x8*)(lds + 0 + 32768 + brow[ni] + ((ch ^ bsw[ni]) << 4));
        }
        SB();
#pragma unroll
        for (int mi = 0; mi < 4; ++mi)
#pragma unroll
          for (int ni = 0; ni < 2; ++ni) acc[mi][ni] = __builtin_amdgcn_mfma_f32_32x32x16_bf16(fa[0][mi], fb[0][ni], acc[mi][ni], 0, 0, 0);
        *(uint4*)(lds + 49152 + soff + 24576) = rc6;
        *(uint4*)(lds + 49152 + soff + 28672) = rc7;
        *(uint4*)(lds + 49152 + 32768 + soff + 0) = rd0;
        SB();
        SB();
#pragma unroll
        for (int mi = 0; mi < 4; ++mi)
#pragma unroll
          for (int ni = 0; ni < 2; ++ni) acc[mi][ni] = __builtin_amdgcn_mfma_f32_32x32x16_bf16(fa[1][mi], fb[1][ni], acc[mi][ni], 0, 0, 0);
        *(uint4*)(lds + 49152 + 32768 + soff + 4096) = rd1;
        *(uint4*)(lds + 49152 + 32768 + soff + 8192) = rd2;
        *(uint4*)(lds + 49152 + 32768 + soff + 12288) = rd3;
        SB();
    }
    __syncthreads();
    {
    const int kk = (kt + 3 < nk ? kt + 3 : nk - 1) * 64;
    rc0 = *(const uint4*)(Ab + aoff[0] + kk);
    rc1 = *(const uint4*)(Ab + aoff[1] + kk);
    rc2 = *(const uint4*)(Ab + aoff[2] + kk);
    rc3 = *(const uint4*)(Ab + aoff[3] + kk);
    rc4 = *(const uint4*)(Ab + aoff[4] + kk);
    rc5 = *(const uint4*)(Ab + aoff[5] + kk);
    rc6 = *(const uint4*)(Ab + aoff[6] + kk);
    rc7 = *(const uint4*)(Ab + aoff[7] + kk);
    rd0 = *(const uint4*)(Bp + (size_t)(0) * ldb + kk);
    rd1 = *(const uint4*)(Bp + (size_t)(32) * ldb + kk);
    rd2 = *(const uint4*)(Bp + (size_t)(64) * ldb + kk);
    rd3 = *(const uint4*)(Bp + (size_t)(96) * ldb + kk);
    }
    SB();
    {
      bf16x8 fa[2][4], fb[2][2];
        { const int ch = 0 + h_;
#pragma unroll
          for (int mi = 0; mi < 4; ++mi) fa[0][mi] = *(const bf16x8*)(lds + 49152 + arow[mi] + ((ch ^ asw[mi]) << 4));
#pragma unroll
          for (int ni = 0; ni < 2; ++ni) fb[0][ni] = *(const bf16x8*)(lds + 49152 + 32768 + brow[ni] + ((ch ^ bsw[ni]) << 4));
        }
        { const int ch = 2 + h_;
#pragma unroll
          for (int mi = 0; mi < 4; ++mi) fa[1][mi] = *(const bf16x8*)(lds + 49152 + arow[mi] + ((ch ^ asw[mi]) << 4));
#pragma unroll
          for (int ni = 0; ni < 2; ++ni) fb[1][ni] = *(const bf16x8*)(lds + 49152 + 32768 + brow[ni] + ((ch ^ bsw[ni]) << 4));
        }
        SB();
#pragma unroll
        for (int mi = 0; mi < 4; ++mi)
#pragma unroll
          for (int ni = 0; ni < 2; ++ni) acc[mi][ni] = __builtin_amdgcn_mfma_f32_32x32x16_bf16(fa[0][mi], fb[0][ni], acc[mi][ni], 0, 0, 0);
        *(uint4*)(lds + 0 + soff + 0) = ra0;
        *(uint4*)(lds + 0 + soff + 4096) = ra1;
        *(uint4*)(lds + 0 + soff + 8192) = ra2;
        SB();
        { const int ch = 4 + h_;
#pragma unroll
          for (int mi = 0; mi < 4; ++mi) fa[0][mi] = *(const bf16x8*)(lds + 49152 + arow[mi] + ((ch ^ asw[mi]) << 4));
#pragma unroll
          for (int ni = 0; ni < 2; ++ni) fb[0][ni] = *(const bf16x8*)(lds + 49152 + 32768 + brow[ni] + ((ch ^ bsw[ni]) << 4));
        }
        SB();
#pragma unroll
        for (int mi = 0; mi < 4; ++mi)
#pragma unroll
          for (int ni = 0; ni < 2; ++ni) acc[mi][ni] = __builtin_amdgcn_mfma_f32_32x32x16_bf16(fa[1][mi], fb[1][ni], acc[mi][ni], 0, 0, 0);
        *(uint4*)(lds + 0 + soff + 12288) = ra3;
        *(uint4*)(lds + 0 + soff + 16384) = ra4;
        *(uint4*)(lds + 0 + soff + 20480) = ra5;
        SB();
        { const int ch = 6 + h_;
#pragma unroll
          for (int mi = 0; mi < 4; ++mi) fa[1][mi] = *(const bf16x8*)(lds + 49152 + arow[mi] + ((ch ^ asw[mi]) << 4));
#pragma unroll
          for (int ni = 0; ni < 2; ++ni) fb[1][ni] = *(const bf16x8*)(lds + 49152 + 32768 + brow[ni] + ((ch ^ bsw[ni]) << 4));
        }
        SB();
#pragma unroll
        for (int mi = 0; mi < 4; ++mi)
#pragma unroll
          for (int ni = 0; ni < 2; ++ni) acc[mi][ni] = __builtin_amdgcn_mfma_f32_32x32x16_bf16(fa[0][mi], fb[0][ni], acc[mi][ni], 0, 0, 0);
        *(uint4*)(lds + 0 + soff + 24576) = ra6;
        *(uint4*)(lds + 0 + soff + 28672) = ra7;
        *(uint4*)(lds + 0 + 32768 + soff + 0) = rb0;
        SB();
        SB();
#pragma unroll
        for (int mi = 0; mi < 4; ++mi)
#pragma unroll
          for (int ni = 0; ni < 2; ++ni) acc[mi][ni] = __builtin_amdgcn_mfma_f32_32x32x16_bf16(fa[1][mi], fb[1][ni], acc[mi][ni], 0, 0, 0);
        *(uint4*)(lds + 0 + 32768 + soff + 4096) = rb1;
        *(uint4*)(lds + 0 + 32768 + soff + 8192) = rb2;
        *(uint4*)(lds + 0 + 32768 + soff + 12288) = rb3;
        SB();
    }
    __syncthreads();
  }
  epi(acc, m0 + wr * 128, n0 + wc * 64, lane);
}

struct TDesc { const float* src; u16* dst; int K, N, lds, Kp, Np, mode; };
__device__ __forceinline__ TDesc get_tdesc(const P& p, int i, int zz) {
  TDesc d;
  d.mode = 0;
  char* ws = p.ws;
  switch (i) {
    case 0: d = {p.in[zz + I_WIN0], (u16*)(ws + W_IN0), 1024, 4632, 4632, 1024, 4736, 1}; break;
    case 1: d = {p.in[zz + I_WOUT0], (u16*)(ws + W_OUT0), 2048, 1024, 1024, 2048, 1024, 0}; break;
    case 2: d = {p.in[zz + I_GU], (u16*)(ws + W_GU), 1024, 5632, 5632, 1024, 5632, 2}; break;
    case 3: d = {p.in[zz + I_GU] + 1024ull * 5632, (u16*)(ws + W_GU + 5632ull * 1024 * 2), 1024, 5632, 5632, 1024, 5632, 2}; break;
    case 4: d = {p.in[zz + I_DN], (u16*)(ws + W_DN), 2816, 1024, 1024, 2816, 1024, 0}; break;
    case 5: d = {p.in[zz + I_DN] + 2816ull * 1024, (u16*)(ws + W_DN + 1024ull * 2816 * 2), 2816, 1024, 1024, 2816, 1024, 0}; break;
    case 6: d = {p.in[zz + I_WR], (u16*)(ws + W_R), 1024, 1024, 1024, 1024, 1024, 0}; break;
    case 7: d = {p.in[zz + I_WKK], (u16*)(ws + W_K), 1024, 1024, 1024, 1024, 1024, 0}; break;
    case 8: d = {p.in[zz + I_WVV], (u16*)(ws + W_V), 1024, 1024, 1024, 1024, 1024, 0}; break;
    case 9: d = {p.in[zz + I_WO], (u16*)(ws + W_O), 1024, 1024, 1024, 1024, 1024, 0}; break;
    case 10: d = {p.in[zz + I_W1], (u16*)(ws + W_W1), 1024, 64, 64, 1024, 128, 0}; break;
    case 11: d = {p.in[zz + I_A1], (u16*)(ws + W_A1), 1024, 64, 64, 1024, 128, 0}; break;
    case 12: d = {p.in[zz + I_G1], (u16*)(ws + W_G1), 1024, 160, 160, 1024, 256, 0}; break;
    case 13: d = {p.in[zz + I_W2], (u16*)(ws + W_W2), 64, 1024, 1024, 128, 1024, 0}; break;
    case 14: d = {p.in[zz + I_A2], (u16*)(ws + W_A2), 64, 1024, 1024, 128, 1024, 0}; break;
    default: d = {p.in[zz + I_G2], (u16*)(ws + W_G2), 160, 1024, 1024, 256, 1024, 0}; break;
  }
  return d;
}
__device__ __forceinline__ int tdesc_tiles(int i) {
  switch (i) {
    case 0: return 16 * 74;
    case 1: return 32 * 16;
    case 2: case 3: return 16 * 88;
    case 4: case 5: return 44 * 16;
    case 6: case 7: case 8: case 9: return 16 * 16;
    case 10: case 11: return 16 * 2;
    case 12: return 16 * 4;
    case 13: case 14: return 2 * 16;
    default: return 4 * 16;
  }
}
constexpr int PREP_TILES = 16 * 74 + 32 * 16 + 2 * 16 * 88 + 2 * 44 * 16 + 4 * 256 + 2 * 32 + 64 + 2 * 32 + 64;

__device__ __forceinline__ void rms_rows_bf16(const float* src_row, const float* g, u16* dst_row, int lane) {
  float4 v[4];
  float ss = 0.f;
#pragma unroll
  for (int i = 0; i < 4; ++i) {
    v[i] = ((const float4*)src_row)[lane + 64 * i];
    ss += v[i].x * v[i].x + v[i].y * v[i].y + v[i].z * v[i].z + v[i].w * v[i].w;
  }
  ss = wsum(ss);
  float rinv = rsqrtf(ss * (1.f / 1024.f) + EPS);
#pragma unroll
  for (int i = 0; i < 4; ++i) {
    float4 g4 = ((const float4*)g)[lane + 64 * i];
    uint2 o;
    o.x = pk2(v[i].x * rinv * g4.x, v[i].y * rinv * g4.y);
    o.y = pk2(v[i].z * rinv * g4.z, v[i].w * rinv * g4.w);
    ((uint2*)dst_row)[lane + 64 * i] = o;
  }
}

__device__ __forceinline__ void rms_rows2_bf16(const float* sa, const float* sb, const float* g, u16* da, u16* db, bool hasb, int lane) {
  float4 va[4], vb[4];
  float ssa = 0.f, ssb = 0.f;
#pragma unroll
  for (int i = 0; i < 4; ++i) { va[i] = ((const float4*)sa)[lane + 64 * i]; vb[i] = ((const float4*)sb)[lane + 64 * i]; }
#pragma unroll
  for (int i = 0; i < 4; ++i) {
    ssa += va[i].x * va[i].x + va[i].y * va[i].y + va[i].z * va[i].z + va[i].w * va[i].w;
    ssb += vb[i].x * vb[i].x + vb[i].y * vb[i].y + vb[i].z * vb[i].z + vb[i].w * vb[i].w;
  }
  ssa = wsum(ssa); ssb = wsum(ssb);
  float ra = rsqrtf(ssa * (1.f / 1024.f) + EPS), rb = rsqrtf(ssb * (1.f / 1024.f) + EPS);
#pragma unroll
  for (int i = 0; i < 4; ++i) {
    float4 g4 = ((const float4*)g)[lane + 64 * i];
    uint2 o;
    o.x = pk2(va[i].x * ra * g4.x, va[i].y * ra * g4.y);
    o.y = pk2(va[i].z * ra * g4.z, va[i].w * ra * g4.w);
    ((uint2*)da)[lane + 64 * i] = o;
    if (hasb) {
      o.x = pk2(vb[i].x * rb * g4.x, vb[i].y * rb * g4.y);
      o.y = pk2(vb[i].z * rb * g4.z, vb[i].w * rb * g4.w);
      ((uint2*)db)[lane + 64 * i] = o;
    }
  }
}
__device__ __forceinline__ void phase_prep(const P& p, char* lds, int bid, int G) {
  float* tile = (float*)lds;
  const int total = PREP_TILES + TT / 8;
  for (int w = bid; w < total; w += G) {
    FRESH_TID(tid);
    const int zz = zof(w);
    const int lane = tid & 63, wid = tid >> 6;
    if (w < PREP_TILES) {
      int t = w, di = 0;
      for (; di < 16; ++di) {
        int n = tdesc_tiles(di);
        if (t < n) break;
        t -= n;
      }
      TDesc d = get_tdesc(p, di, zz);
      const int nkt = d.Kp >> 6;
      const int kt = t % nkt, nt = t / nkt;
      const int k0 = kt * 64, n0 = nt * 64;
      float vals[16];
#pragma unroll
      for (int i = 0; i < 16; ++i) {
        int kk = i * 4 + (tid >> 6), nn = tid & 63;
        int n = n0 + nn, k = k0 + kk, sc;
        if (d.mode == 0) sc = (n < d.N) ? n : -1;
        else if (d.mode == 1) sc = n < 3584 ? n : (n < 4608 ? 3600 + (n - 3584) : (n < 4624 ? 3584 + (n - 4608) : (n < 4632 ? n : -1)));
        else { int q = n >> 6, j = n & 63; sc = j < 32 ? q * 32 + j : 2816 + q * 32 + (j - 32); }
        const bool ok = (sc >= 0 && k < d.K);
        float v = d.src[ok ? (size_t)k * d.lds + sc : 0];
        vals[i] = ok ? v : 0.f;
      }
#pragma unroll
      for (int i = 0; i < 16; ++i) tile[(i * 4 + (tid >> 6)) * 65 + (tid & 63)] = vals[i];
      __syncthreads();
#pragma unroll
      for (int i = 0; i < 16; ++i) {
        int nn = i * 4 + (tid >> 6), kk = tid & 63;
        d.dst[(size_t)(n0 + nn) * d.Kp + k0 + kk] = f2bf(tile[kk * 65 + nn]);
      }
      __syncthreads();
    } else {
      int rowa = (w - PREP_TILES) * 8 + wid, rowb = rowa + 4;
      const float* sa = rowa < TP ? p.in[zz + I_XP] + (size_t)rowa * 1024 : p.in[zz + I_XS] + (size_t)(rowa - TP) * 1024;
      const float* sb = rowb < TP ? p.in[zz + I_XP] + (size_t)rowb * 1024 : p.in[zz + I_XS] + (size_t)(rowb - TP) * 1024;
      u16* xn = (u16*)(p.ws + B_A);
      rms_rows2_bf16(sa, sb, p.in[zz + I_NMIX], xn + (size_t)rowa * 1024, xn + (size_t)rowb * 1024, true, lane);
    }
  }
}

__device__ __forceinline__ bool tile_map(int q, int xcd, int MT, int NT, int& mt, int& nt) {
  int mi = q / NT;
  nt = q - mi * NT;
  mt = xcd + 8 * mi;
  return mt < MT;
}
template <class Epi>
__device__ __forceinline__ void gemm_phase(const u16* A, int lda, const u16* B, int ldb, int K, int MT, int NT, char* lds, int bid, int G, const Epi& epi) {
  const int xcd = bid & 7, j = bid >> 3, nb = G >> 3;
  const int nq = ((MT + 7) >> 3) * NT;
  for (int q = j; q < nq; q += nb) {
    int mt, nt;
    if (!tile_map(q, xcd, MT, NT, mt, nt)) break;
    gemm_tile(A, lda, B, ldb, K, mt * 256, nt * 128, lds, epi);
  }
}

struct EpiProj {
  u16* proj; float* small;
  __device__ __forceinline__ void init(f32x16 (&acc)[4][2], int, int, int) const { zero_acc<4, 2>(acc); }
  __device__ __forceinline__ void operator()(f32x16 (&acc)[4][2], int r0, int c0, int lane) const {
#pragma unroll
    for (int mi = 0; mi < 4; ++mi)
#pragma unroll
      for (int ni = 0; ni < 2; ++ni) {
        int col = c0 + ni * 32 + (lane & 31);
#pragma unroll
        for (int i = 0; i < 16; ++i) {
          int row = r0 + mi * 32 + ACC_ROW(i, lane);
          if (row >= TT) continue;
          float v = acc[mi][ni][i];
          if (col < PJ) proj[(size_t)row * PJ + col] = f2bf(v);
          else if (col < PJ + 32) small[(size_t)row * 32 + (col - PJ)] = v;
        }
      }
  }
};
struct EpiRes {
  const float* res; const float* res2; float* out;
  __device__ __forceinline__ void init(f32x16 (&acc)[4][2], int r0, int c0, int lane) const {
#pragma unroll
    for (int mi = 0; mi < 4; ++mi)
#pragma unroll
      for (int ni = 0; ni < 2; ++ni) {
        int col = c0 + ni * 32 + (lane & 31);
#pragma unroll
        for (int i = 0; i < 16; ++i) {
          int row = r0 + mi * 32 + ACC_ROW(i, lane);
          float rv = 0.f;
          if (row < TP) rv = res[(size_t)row * 1024 + col];
          else if (row < TT) rv = res2[(size_t)(row - TP) * 1024 + col];
          acc[mi][ni][i] = rv;
        }
      }
  }
  __device__ __forceinline__ void operator()(f32x16 (&acc)[4][2], int r0, int c0, int lane) const {
#pragma unroll
    for (int mi = 0; mi < 4; ++mi)
#pragma unroll
      for (int ni = 0; ni < 2; ++ni) {
        int col = c0 + ni * 32 + (lane & 31);
#pragma unroll
        for (int i = 0; i < 16; ++i) {
          int row = r0 + mi * 32 + ACC_ROW(i, lane);
          if (row >= TT) continue;
          out[(size_t)row * 1024 + col] = acc[mi][ni][i];
        }
      }
  }
};
struct EpiSwiglu {
  u16* hb;
  __device__ __forceinline__ void init(f32x16 (&acc)[4][2], int, int, int) const { zero_acc<4, 2>(acc); }
  __device__ __forceinline__ void operator()(f32x16 (&acc)[4][2], int r0, int c0, int lane) const {
    int col = (c0 >> 1) + (lane & 31);
#pragma unroll
    for (int mi = 0; mi < 4; ++mi)
#pragma unroll
      for (int i = 0; i < 16; ++i) {
        int row = r0 + mi * 32 + ACC_ROW(i, lane);
        if (row >= TT) continue;
        float g = acc[mi][0][i], u = acc[mi][1][i];
        hb[(size_t)row * 2816 + col] = f2bf(g * sigmoidf(g) * u);
      }
  }
};
struct EpiAct {
  u16* out; int ldo; int nvalid; int nstore; int act;
  __device__ __forceinline__ void init(f32x16 (&acc)[4][2], int, int, int) const { zero_acc<4, 2>(acc); }
  __device__ __forceinline__ void operator()(f32x16 (&acc)[4][2], int r0, int c0, int lane) const {
#pragma unroll
    for (int mi = 0; mi < 4; ++mi)
#pragma unroll
      for (int ni = 0; ni < 2; ++ni) {
        int col = c0 + ni * 32 + (lane & 31);
        if (col >= nstore) continue;
#pragma unroll
        for (int i = 0; i < 16; ++i) {
          int row = r0 + mi * 32 + ACC_ROW(i, lane);
          if (row >= TT) continue;
          float v = acc[mi][ni][i];
          if (act == 1) v = tanhf(v);
          else if (act == 2) v = sigmoidf(v);
          if (col >= nvalid) v = 0.f;
          out[(size_t)row * ldo + col] = f2bf(v);
        }
      }
  }
};
struct EpiLora2 {
  int which; const float* bias; float* outf; u16* outb;
  __device__ __forceinline__ void init(f32x16 (&acc)[4][2], int, int, int) const { zero_acc<4, 2>(acc); }
  __device__ __forceinline__ void operator()(f32x16 (&acc)[4][2], int r0, int c0, int lane) const {
#pragma unroll
    for (int mi = 0; mi < 4; ++mi)
#pragma unroll
      for (int ni = 0; ni < 2; ++ni) {
        int col = c0 + ni * 32 + (lane & 31);
        float bv = which < 2 ? bias[col] : 0.f;
#pragma unroll
        for (int i = 0; i < 16; ++i) {
          int row = r0 + mi * 32 + ACC_ROW(i, lane);
          if (row >= TT) continue;
          float v = acc[mi][ni][i] + bv;
          if (which == 0) {
            float w = -softplusf(-v) - 0.5f;
            outf[(size_t)row * 1024 + col] = __expf(-__expf(w));
          } else if (which == 1) {
            outb[(size_t)row * 1024 + col] = f2bf(sigmoidf(v));
          } else {
            outb[(size_t)row * 1024 + col] = f2bf(v);
          }
        }
      }
  }
};

__device__ __forceinline__ void phase_conv(const P& p, char* lds, int bid, int G) {
  const u16* proj = (const u16*)(p.ws + B_PROJ);
  const float* small = (const float*)(p.ws + B_SMALL);
  u16* xs = (u16*)(p.ws + B_A);
  u16* Bm = (u16*)(p.ws + B_BM);
  u16* Cm = (u16*)(p.ws + B_CM);
  u16* xm = (u16*)(p.ws + B_XM);
  const int zz0 = zof(bid);
  const float* cw = p.in[zz0 + I_CONVW];
  const float* cb = p.in[zz0 + I_CONVB];
  const int n_conv = TT / 4;
  const int n_gate = (512 + 2048) / 4;
  for (int w = bid; w < n_conv + n_gate; w += G) {
    FRESH_TID(tid);
    const int zz = zof(w);
    const int lane = tid & 63, wid = tid >> 6;
    if (w < n_conv) {
#pragma unroll
      for (int k_ = 0; k_ < 5; ++k_) {
        const int i = tid + k_ * 256;
        int r4 = i / 320, cgp = i % 320;
        int row = w * 4 + r4, c0 = cgp * 8;
        float u[4][8];
        if (row < TP) {
          int t = row & 2047;
#pragma unroll
          for (int j = 0; j < 4; ++j) {
            int tt = t - 3 + j;
            if (tt >= 0) {
              uint4 q = *(const uint4*)(proj + (size_t)(row - 3 + j) * PJ + 1024 + c0);
              unpack8(q, u[j]);
            } else {
#pragma unroll
              for (int e = 0; e < 8; ++e) u[j][e] = 0.f;
            }
          }
          if (t >= 2045) {
            int b = row >> 11;
            float* o = p.out + O_CONVP + ((size_t)(b * 3 + (t - 2045)) * 2560 + c0);
#pragma unroll
            for (int e = 0; e < 8; ++e) o[e] = u[3][e];
          }
        } else {
          int bs = row - TP;
#pragma unroll
          for (int j = 0; j < 3; ++j) {
            const float* s = p.in[zz + I_SCONV] + ((size_t)(bs * 3 + j) * 2560 + c0);
#pragma unroll
            for (int e = 0; e < 8; ++e) u[j][e] = s[e];
          }
          uint4 q = *(const uint4*)(proj + (size_t)row * PJ + 1024 + c0);
          unpack8(q, u[3]);
          float* o = p.out + O_CONVS + ((size_t)(bs * 3) * 2560 + c0);
#pragma unroll
          for (int e = 0; e < 8; ++e) { o[e] = u[1][e]; o[2560 + e] = u[2][e]; o[5120 + e] = u[3][e]; }
        }
        float a[8];
#pragma unroll
        for (int e = 0; e < 8; ++e) {
          float v = cb[c0 + e];
#pragma unroll
          for (int j = 0; j < 4; ++j) v += u[j][e] * cw[j * 2560 + c0 + e];
          a[e] = v * sigmoidf(v);
        }
        uint4 o = pack8(a);
        u16* dst;
        if (c0 < 1024) dst = xs + (size_t)row * 1024 + c0;
        else if (c0 < 1280) dst = Bm + (size_t)row * 256 + (c0 - 1024);
        else if (c0 < 1536) dst = Cm + (size_t)row * 256 + (c0 - 1280);
        else dst = xm + (size_t)row * 1024 + (c0 - 1536);
        *(uint4*)dst = o;
      }
    } else {
      int wi = (w - n_conv) * 4 + wid;
      int t0 = 2 * lane;
      if (wi < 512) {
        int c = wi & 15, h = (wi >> 4) & 3, b = wi >> 6;
        int row0 = b * 2048 + c * 128;
        float fb = p.in[zz + I_FB][h], ib = p.in[zz + I_IB][h];
        float f0 = small[(size_t)(row0 + t0) * 32 + 20 + h] + fb, f1 = small[(size_t)(row0 + t0 + 1) * 32 + 20 + h] + fb;
        float i0 = small[(size_t)(row0 + t0) * 32 + 16 + h] + ib, i1 = small[(size_t)(row0 + t0 + 1) * 32 + 16 + h] + ib;
        float lf0 = -softplusf(-f0), lf1 = -softplusf(-f1);
        float inc = wscan(lf0 + lf1, lane);
        float bc1 = inc, bc0 = inc - lf1;
        float uu = wmax(fmaxf(i0 - bc0, i1 - bc1));
        float bend = __shfl(inc, 63);
        float* bcum = (float*)(p.ws + M_BCUM);
        float* li = (float*)(p.ws + M_LI);
        bcum[(size_t)(row0 + t0) * 4 + h] = bc0; bcum[(size_t)(row0 + t0 + 1) * 4 + h] = bc1;
        li[(size_t)(row0 + t0) * 4 + h] = i0; li[(size_t)(row0 + t0 + 1) * 4 + h] = i1;
        if (lane == 0) {
          float* gs = (float*)(p.ws + M_GSUM) + (size_t)((b * 4 + h) * 16 + c) * 2;
          gs[0] = bend; gs[1] = uu;
        }
      } else {
        int x = wi - 512;
        int h = x & 15, c = (x >> 4) & 15, b = x >> 8;
        int row0 = b * 2048 + c * 128;
        float db = p.in[zz + I_DTB][h], an = -__expf(p.in[zz + I_ALOG][h]);
        float d0 = softplusf(small[(size_t)(row0 + t0) * 32 + h] + db), d1 = softplusf(small[(size_t)(row0 + t0 + 1) * 32 + h] + db);
        float inc = wscan((d0 + d1) * an, lane);
        float* dt = (float*)(p.ws + M_DT);
        float* ac = (float*)(p.ws + M_ACUM);
        dt[(size_t)(row0 + t0) * 16 + h] = d0; dt[(size_t)(row0 + t0 + 1) * 16 + h] = d1;
        ac[(size_t)(row0 + t0) * 16 + h] = inc - d1 * an; ac[(size_t)(row0 + t0 + 1) * 16 + h] = inc;
      }
    }
  }
}

__device__ __forceinline__ void blockdiag8(const float* x, const float* __restrict__ w, int ch0, float scale, float* o) {
  const float4* w4 = (const float4*)(w + (size_t)(ch0 >> 2) * 16);
#pragma unroll
  for (int blk = 0; blk < 2; ++blk) {
    float4 r0 = w4[blk * 4 + 0], r1 = w4[blk * 4 + 1], r2 = w4[blk * 4 + 2], r3 = w4[blk * 4 + 3];
    const float* xx = x + blk * 4;
    o[blk * 4 + 0] = (xx[0] * r0.x + xx[1] * r1.x + xx[2] * r2.x + xx[3] * r3.x) * scale;
    o[blk * 4 + 1] = (xx[0] * r0.y + xx[1] * r1.y + xx[2] * r2.y + xx[3] * r3.y) * scale;
    o[blk * 4 + 2] = (xx[0] * r0.z + xx[1] * r1.z + xx[2] * r2.z + xx[3] * r3.z) * scale;
    o[blk * 4 + 3] = (xx[0] * r0.w + xx[1] * r1.w + xx[2] * r2.w + xx[3] * r3.w) * scale;
  }
}
__device__ __forceinline__ void mchain(const float* gs  , int c, float& mc, float& mn, float& bend) {
  float m = 0.f;
  for (int j = 0; j < c; ++j) m = gs[j * 2] + fmaxf(m, gs[j * 2 + 1]);
  mc = m;
  bend = gs[c * 2];
  mn = bend + fmaxf(m, gs[c * 2 + 1]);
}

__device__ __forceinline__ void img_put_t(char* img, int R, int j0, int s, const float* v) {
  char* pb = img + (s >> 6) * (R * 128);
#pragma unroll
  for (int e = 0; e < 8; ++e) *(u16*)(pb + img_off(j0 + e, s & 63)) = f2bf(v[e]);
}

__device__ __forceinline__ void phase_chunkstate(const P& p, char* lds, int bid, int G) {
  const u16* proj = (const u16*)(p.ws + B_PROJ);
  const float* small = (const float*)(p.ws + B_SMALL);
  const u16* xs = (const u16*)(p.ws + B_A);
  const u16* Bm = (const u16*)(p.ws + B_BM);
  const u16* Cm = (const u16*)(p.ws + B_CM);
  const u16* xm = (const u16*)(p.ws + B_XM);
  u16* mix = (u16*)(p.ws + B_MIX);
  char* R0 = lds;
  char* R1 = lds + 32768;
  float* ex = (float*)(lds + 65536);
  for (int w = bid; w < 2048; w += G) {
    FRESH_TID(tid);
    const int zz = zof(w);
    const int lane = tid & 63, wid = tid >> 6;
    if (w < 512) {
      const int bs = w >> 2, h = w & 3, row = TP + bs;
      float* sq = ex; float* sk = ex + 256; float* sv = ex + 512; float* scr = ex + 768;
      {
        int d = tid, cb4 = d & ~3, ci = d & 3;
        int nb = (h * 256 + cb4) >> 2;
        float q = 0.f, k = 0.f, v = 0.f;
#pragma unroll
        for (int c = 0; c < 4; ++c) {
          float xa = bf2f(xm[(size_t)row * 1024 + h * 256 + cb4 + c]);
          float xr = bf2f(proj[(size_t)row * PJ + 2560 + h * 256 + cb4 + c]);
          q += xa * p.in[zz + I_WQ][nb * 16 + c * 4 + ci];
          k += xa * p.in[zz + I_WK][nb * 16 + c * 4 + ci];
          v += xr * p.in[zz + I_WV][nb * 16 + c * 4 + ci];
        }
        sq[d] = q; sk[d] = k * 0.0625f; sv[d] = v;
      }
      float lf = -softplusf(-(small[(size_t)row * 32 + 20 + h] + p.in[zz + I_FB][h]));
      float li = small[(size_t)row * 32 + 16 + h] + p.in[zz + I_IB][h];
      float m = p.in[zz + I_SMM][bs * 4 + h];
      float mnew = fmaxf(lf + m, li);
      float wsc = __expf(li - mnew), dc = __expf(lf + m - mnew);
      __syncthreads();
      float nn = dc * p.in[zz + I_SMN][(size_t)(bs * 4 + h) * 256 + tid] + wsc * sk[tid];
      p.out[O_MNS + (size_t)(bs * 4 + h) * 256 + tid] = nn;
      float den = bsum(sq[tid] * nn, scr);
      const float* C = p.in[zz + I_SMC] + (size_t)(bs * 4 + h) * 65536 + tid;
      float* Co = p.out + O_MCS + (size_t)(bs * 4 + h) * 65536 + tid;
      float vv = sv[tid] * wsc, num = 0.f;
      for (int d0 = 0; d0 < 256; d0 += 32) {
        float c[32];
#pragma unroll
        for (int e = 0; e < 32; ++e) c[e] = C[(size_t)(d0 + e) * 256];
#pragma unroll
        for (int e = 0; e < 32; ++e) {
          float cn = dc * c[e] + sk[d0 + e] * vv;
          num += sq[d0 + e] * cn;
          Co[(size_t)(d0 + e) * 256] = cn;
        }
      }
      float hv = num / fmaxf(fabsf(den), __expf(-mnew));
      float ss = bsum(hv * hv, scr);
      float rinv = rsqrtf(ss * (1.f / 256.f) + EPS);
      int ch = h * 256 + tid;
      float xa = bf2f(xm[(size_t)row * 1024 + ch]);
      float op = bf2f(proj[(size_t)row * PJ + 3584 + ch]);
      float hm = (hv * rinv * p.in[zz + I_MLN][ch] + p.in[zz + I_MLS][ch] * xa) * sigmoidf(op);
      mix[(size_t)row * 2048 + 1024 + ch] = f2bf(hm);
      if (tid == 0) p.out[O_MMS + bs * 4 + h] = mnew;
      __syncthreads();
    } else if (w < 768) {
      const int x = w - 512, bs = x >> 1, g = x & 1, row = TP + bs;
      float* yz = ex; float* scr = ex + 512;
      const int pp = tid >> 2, nq = tid & 3, n0 = nq * 32;
      _Pragma("unroll 1")
      for (int h8 = 0; h8 < 8; ++h8) {
        int h = g * 8 + h8;
        float dtv = softplusf(small[(size_t)row * 32 + h] + p.in[zz + I_DTB][h]);
        float dec = __expf(-dtv * __expf(p.in[zz + I_ALOG][h]));
        float xv = bf2f(xs[(size_t)row * 1024 + h * 64 + pp]);
        const float* st = p.in[zz + I_SSSM] + ((size_t)((bs * 16 + h) * 64 + pp)) * 128 + n0;
        float* so = p.out + O_SSMS + ((size_t)((bs * 16 + h) * 64 + pp)) * 128 + n0;
        float ys = 0.f, dx = dtv * xv;
#pragma unroll
        for (int j = 0; j < 8; ++j) {
          float4 s4 = *(const float4*)(st + j * 4);
          uint2 b2 = *(const uint2*)(Bm + (size_t)row * 256 + g * 128 + n0 + j * 4);
          uint2 c2 = *(const uint2*)(Cm + (size_t)row * 256 + g * 128 + n0 + j * 4);
          float4 o;
          o.x = dec * s4.x + dx * lo2f(b2.x); o.y = dec * s4.y + dx * hi2f(b2.x);
          o.z = dec * s4.z + dx * lo2f(b2.y); o.w = dec * s4.w + dx * hi2f(b2.y);
          ys += o.x * lo2f(c2.x) + o.y * hi2f(c2.x) + o.z * lo2f(c2.y) + o.w * hi2f(c2.y);
          *(float4*)(so + j * 4) = o;
        }
        ys += __shfl_xor(ys, 1);
        ys += __shfl_xor(ys, 2);
        if (nq == 0) {
          float z = bf2f(proj[(size_t)row * PJ + h * 64 + pp]);
          yz[h8 * 64 + pp] = (ys + p.in[zz + I_SSDD][h] * xv) * z * sigmoidf(z);
        }
      }
      __syncthreads();
      float a0 = yz[tid], a1 = yz[tid + 256];
      float ss = bsum(a0 * a0 + a1 * a1, scr);
      float rinv = rsqrtf(ss * (1.f / 512.f) + EPS);
      mix[(size_t)row * 2048 + g * 512 + tid] = f2bf(a0 * rinv * p.in[zz + I_SSDN][g * 512 + tid]);
      mix[(size_t)row * 2048 + g * 512 + tid + 256] = f2bf(a1 * rinv * p.in[zz + I_SSDN][g * 512 + tid + 256]);
      __syncthreads();
    } else if (w < 1024) {
      const int x = w - 768, g = x & 1, c = (x >> 1) & 15, b = x >> 5;
      const int rowbase = b * 2048 + c * 128;
      const float* dt = (const float*)(p.ws + M_DT);
      const float* ac = (const float*)(p.ws + M_ACUM);
      float* sWe = ex;
      for (int i = tid; i < 1024; i += 256) {
        int h8 = i >> 7, s = i & 127, h = g * 8 + h8;
        float al = ac[(size_t)(rowbase + 127) * 16 + h];
        sWe[i] = __expf(al - ac[(size_t)(rowbase + s) * 16 + h]) * dt[(size_t)(rowbase + s) * 16 + h];
      }
      _Pragma("unroll 4")
      for (int k_ = 0; k_ < (128 * 16) / 256; ++k_) { const int i = tid + k_ * 256;
        int jc = i & 15, s = i >> 4;
        uint4 q = *(const uint4*)(Bm + (size_t)(rowbase + s) * 256 + g * 128 + jc * 8);
        float v[8]; unpack8(q, v);
        img_put_t(R0, 128, jc * 8, s, v);
      }
      __syncthreads();
      _Pragma("unroll 1")
      for (int h8 = 0; h8 < 8; ++h8) {
        int h = g * 8 + h8;
        _Pragma("unroll")
        for (int k_ = 0; k_ < (128 * 8) / 256; ++k_) { const int i = tid + k_ * 256;
          int jc = i & 7, s = i >> 3;
          uint4 q = *(const uint4*)(xs + (size_t)(rowbase + s) * 1024 + h * 64 + jc * 8);
          float v[8]; unpack8(q, v);
          float sc = sWe[h8 * 128 + s];
#pragma unroll
          for (int e = 0; e < 8; ++e) v[e] *= sc;
          img_put_t(R1, 64, jc * 8, s, v);
        }
        __syncthreads();
        f32x16 acc[1][2];
        zero_acc<1, 2>(acc);
#pragma unroll
        for (int pn = 0; pn < 2; ++pn) mma_panel<1, 2>(acc, R1 + pn * 8192, (wid & 1) * 32, R0 + pn * 16384, (wid >> 1) * 64, lane);
        u16* dst = (u16*)(p.ws + B_SSDST) + ((size_t)((b * 16 + c) * 16 + h)) * 8192;
#pragma unroll
        for (int ni = 0; ni < 2; ++ni)
#pragma unroll
          for (int i = 0; i < 16; ++i) {
            int pr = (wid & 1) * 32 + ACC_ROW(i, lane), n = (wid >> 1) * 64 + ni * 32 + (lane & 31);
            dst[pr * 128 + n] = f2bf(acc[0][ni][i]);
          }
        __syncthreads();
      }
    } else {
      const int x = w - 1024, vh = x & 1, c = (x >> 1) & 15, h = (x >> 5) & 3, b = x >> 7;
      const int rowbase = b * 2048 + c * 128;
      const float* gs = (const float*)(p.ws + M_GSUM) + (size_t)(b * 4 + h) * 32;
      float mc, mn, bend;
      mchain(gs, c, mc, mn, bend);
      float* sWs = ex;
      const float* bcum = (const float*)(p.ws + M_BCUM);
      const float* li = (const float*)(p.ws + M_LI);
      if (tid < 128) sWs[tid] = __expf(bend - bcum[(size_t)(rowbase + tid) * 4 + h] + li[(size_t)(rowbase + tid) * 4 + h] - mn);
      _Pragma("unroll 4")
      for (int k_ = 0; k_ < (128 * 16) / 256; ++k_) { const int i = tid + k_ * 256;
        int jc = i & 15, s = i >> 4;
        int ch0 = h * 256 + vh * 128 + jc * 8;
        uint4 q = *(const uint4*)(proj + (size_t)(rowbase + s) * PJ + 2560 + ch0);
        float xv[8], v[8]; unpack8(q, xv);
        blockdiag8(xv, p.in[zz + I_WV], ch0, 1.f, v);
        img_put_t(R0, 128, jc * 8, s, v);
      }
      __syncthreads();
      _Pragma("unroll 1")
      for (int dh = 0; dh < 2; ++dh) {
        _Pragma("unroll 4")
        for (int k_ = 0; k_ < (128 * 16) / 256; ++k_) { const int i = tid + k_ * 256;
          int jc = i & 15, s = i >> 4;
          int ch0 = h * 256 + dh * 128 + jc * 8;
          uint4 q = *(const uint4*)(xm + (size_t)(rowbase + s) * 1024 + ch0);
          float xv[8], v[8]; unpack8(q, xv);
          blockdiag8(xv, p.in[zz + I_WK], ch0, 0.0625f * sWs[s], v);
          img_put_t(R1, 128, jc * 8, s, v);
        }
        __syncthreads();
        f32x16 acc[2][2];
        zero_acc<2, 2>(acc);
#pragma unroll
        for (int pn = 0; pn < 2; ++pn) mma_panel<2, 2>(acc, R0 + pn * 16384, (wid & 1) * 64, R1 + pn * 16384, (wid >> 1) * 64, lane);
        if (vh == 0) {
          int d = tid >> 1, hf = tid & 1;
          float s = 0.f;
          for (int k = 0; k < 64; ++k) s += bf2f(*(const u16*)(R1 + hf * 16384 + img_off(d, k)));
          s += __shfl_xor(s, 1);
          if (hf == 0) ((float*)(p.ws + M_MLN))[(size_t)((b * 4 + h) * 16 + c) * 256 + dh * 128 + d] = s;
        }
        u16* dst = (u16*)(p.ws + B_MLST) + ((size_t)((b * 4 + h) * 16 + c)) * 65536;
#pragma unroll
        for (int mi = 0; mi < 2; ++mi)
#pragma unroll
          for (int ni = 0; ni < 2; ++ni)
#pragma unroll
            for (int i = 0; i < 16; ++i) {
              int v = vh * 128 + (wid & 1) * 64 + mi * 32 + ACC_ROW(i, lane), d = dh * 128 + (wid >> 1) * 64 + ni * 32 + (lane & 31);
              dst[v * 256 + d] = f2bf(acc[mi][ni][i]);
            }
        __syncthreads();
      }
    }
  }
}

__device__ __forceinline__ void phase_scan(const P& p, char* lds, int bid, int G) {
  for (int w = bid; w < 1568; w += G) {
    FRESH_TID(tid);
    const int zz = zof(w);
    if (w < 512) {
      int e8 = w * 256 + tid;
      int n8 = e8 & 15, pp = (e8 >> 4) & 63, h = (e8 >> 10) & 15, b = e8 >> 14;
      const float* ac = (const float*)(p.ws + M_ACUM);
      u16* st = (u16*)(p.ws + B_SSDST);
      float cur[8];
#pragma unroll
      for (int e = 0; e < 8; ++e) cur[e] = 0.f;
      uint4 qa[16]; float da[16];
#pragma unroll
      for (int c = 0; c < 16; ++c) {
        qa[c] = *(const uint4*)(st + ((size_t)((b * 16 + c) * 16 + h)) * 8192 + pp * 128 + n8 * 8);
        da[c] = ac[(size_t)(b * 2048 + c * 128 + 127) * 16 + h];
      }
#pragma unroll
      for (int c = 0; c < 16; ++c) {
        u16* ptr = st + ((size_t)((b * 16 + c) * 16 + h)) * 8192 + pp * 128 + n8 * 8;
        float t[8]; unpack8(qa[c], t);
        *(uint4*)ptr = pack8(cur);
        float dec = __expf(da[c]);
#pragma unroll
        for (int e = 0; e < 8; ++e) cur[e] = dec * cur[e] + t[e];
      }
      float* o = p.out + O_SSMP + ((size_t)((b * 16 + h) * 64 + pp)) * 128 + n8 * 8;
      *(float4*)o = make_float4(cur[0], cur[1], cur[2], cur[3]);
      *(float4*)(o + 4) = make_float4(cur[4], cur[5], cur[6], cur[7]);
    } else if (w < 1536) {
      int e8 = (w - 512) * 256 + tid;
      int d8 = e8 & 31, v = (e8 >> 5) & 255, h = (e8 >> 13) & 3, b = e8 >> 15;
      const float* gs = (const float*)(p.ws + M_GSUM) + (size_t)(b * 4 + h) * 32;
      u16* st = (u16*)(p.ws + B_MLST);
      float cur[8];
#pragma unroll
      for (int e = 0; e < 8; ++e) cur[e] = 0.f;
      float m = 0.f;
      uint4 qa[16];
#pragma unroll
      for (int c = 0; c < 16; ++c) qa[c] = *(const uint4*)(st + ((size_t)((b * 4 + h) * 16 + c)) * 65536 + v * 256 + d8 * 8);
#pragma unroll
      for (int c = 0; c < 16; ++c) {
        u16* ptr = st + ((size_t)((b * 4 + h) * 16 + c)) * 65536 + v * 256 + d8 * 8;
        float t[8]; unpack8(qa[c], t);
        *(uint4*)ptr = pack8(cur);
        float be = gs[c * 2], mn = be + fmaxf(m, gs[c * 2 + 1]);
        float dc = __expf(be + m - mn);
        m = mn;
#pragma unroll
        for (int e = 0; e < 8; ++e) cur[e] = dc * cur[e] + t[e];
      }
      float* o = p.out + O_MCP + (size_t)(b * 4 + h) * 65536 + v;
#pragma unroll
      for (int e = 0; e < 8; ++e) o[(size_t)(d8 * 8 + e) * 256] = cur[e];
    } else {
      int bh = w - 1536, d = tid;
      const float* gs = (const float*)(p.ws + M_GSUM) + (size_t)bh * 32;
      float* nb = (float*)(p.ws + M_MLN) + (size_t)bh * 16 * 256;
      float cur = 0.f, m = 0.f;
      for (int c = 0; c < 16; ++c) {
        float t = nb[c * 256 + d];
        nb[c * 256 + d] = cur;
        float be = gs[c * 2], mn = be + fmaxf(m, gs[c * 2 + 1]);
        float dc = __expf(be + m - mn);
        m = mn;
        cur = dc * cur + t;
      }
      p.out[O_MNP + (size_t)bh * 256 + d] = cur;
      if (tid == 0) p.out[O_MMP + bh] = m;
    }
  }
}

__device__ __forceinline__ void phase_chunkout(const P& p, char* lds, int bid, int G) {
  const u16* proj = (const u16*)(p.ws + B_PROJ);
  const u16* xs = (const u16*)(p.ws + B_A);
  const u16* Bm = (const u16*)(p.ws + B_BM);
  const u16* Cm = (const u16*)(p.ws + B_CM);
  const u16* xm = (const u16*)(p.ws + B_XM);
  u16* mix = (u16*)(p.ws + B_MIX);
  char* R0 = lds;
  char* R1 = lds + 32768;
  float* ex = (float*)(lds + 65536);
  for (int w = bid; w < 1024; w += G) {
    FRESH_TID(tid);
    const int zz = zof(w);
    const int lane = tid & 63, wid = tid >> 6;
#if defined(P5_ONLY) && P5_ONLY == 2
    if (false) {
#elif defined(P5_ONLY) && P5_ONLY == 1
    if (true) {
#else
    if (w >= 512) {
#endif
      const int x = w - 512, th = x & 1, g = (x >> 1) & 1, c = (x >> 2) & 15, b = x >> 6;
      const int rowbase = b * 2048 + c * 128;
      const float* dt = (const float*)(p.ws + M_DT);
      const float* ac = (const float*)(p.ws + M_ACUM);
      float* sA = ex;
      float* sD = ex + 1024;
      float* sSq = ex + 2048;
      for (int i = tid; i < 1024; i += 256) {
        int h8 = i >> 7, s = i & 127, h = g * 8 + h8;
        sA[i] = ac[(size_t)(rowbase + s) * 16 + h];
        sD[i] = dt[(size_t)(rowbase + s) * 16 + h];
      }
      if (tid < 64) sSq[tid] = 0.f;
      _Pragma("unroll 4")
      for (int k_ = 0; k_ < (128 * 16) / 256; ++k_) { const int i = tid + k_ * 256;
        int kc = i & 15, r = i >> 4;
        uint4 q = *(const uint4*)(Bm + (size_t)(rowbase + r) * 256 + g * 128 + kc * 8);
        *(uint4*)(R0 + (kc >> 3) * 16384 + r * 128 + (((kc & 7) ^ ((r >> 1) & 7)) << 4)) = q;
      }
      _Pragma("unroll")
      for (int k_ = 0; k_ < (64 * 16) / 256; ++k_) { const int i = tid + k_ * 256;
        int kc = i & 15, r = i >> 4;
        uint4 q = *(const uint4*)(Cm + (size_t)(rowbase + th * 64 + r) * 256 + g * 128 + kc * 8);
        *(uint4*)(R1 + (kc >> 3) * 8192 + r * 128 + (((kc & 7) ^ ((r >> 1) & 7)) << 4)) = q;
      }
      __syncthreads();
      f32x16 cb[2][1];
      zero_acc<2, 1>(cb);
#pragma unroll
      for (int pn = 0; pn < 2; ++pn) mma_panel<2, 1>(cb, R1 + pn * 8192, 0, R0 + pn * 16384, wid * 32, lane);
      __syncthreads();
      _Pragma("unroll 1")
      for (int h8 = 0; h8 < 8; ++h8) {
        const int h = g * 8 + h8;
        u16 exs[16], ezs[16];
        {
          int pp = (wid >> 1) * 32 + (lane & 31), ch = h * 64 + pp;
#pragma unroll
          for (int i = 0; i < 16; ++i) {
            size_t row = rowbase + th * 64 + (wid & 1) * 32 + ACC_ROW(i, lane);
            exs[i] = xs[row * 1024 + ch];
            ezs[i] = proj[row * PJ + ch];
          }
        }
        {
          int s = wid * 32 + (lane & 31);
          float as = sA[h8 * 128 + s], ds = sD[h8 * 128 + s];
#pragma unroll
          for (int mi = 0; mi < 2; ++mi)
#pragma unroll
            for (int i = 0; i < 16; ++i) {
              int tl = mi * 32 + ACC_ROW(i, lane), t = th * 64 + tl;
              float v = (s <= t) ? __expf(sA[h8 * 128 + t] - as) * cb[mi][0][i] * ds : 0.f;
              *(u16*)(R0 + (s >> 6) * 8192 + img_off(tl, s & 63)) = f2bf(v);
              if ((i & 3) == 3) SB();
            }
        }
        _Pragma("unroll")
        for (int k_ = 0; k_ < (128 * 8) / 256; ++k_) { const int i = tid + k_ * 256;
          int jc = i & 7, s = i >> 3;
          uint4 q = *(const uint4*)(xs + (size_t)(rowbase + s) * 1024 + h * 64 + jc * 8);
          float v[8]; unpack8(q, v);
          img_put_t(R0 + 16384, 64, jc * 8, s, v);
        }
        {
          const u16* st = (const u16*)(p.ws + B_SSDST) + ((size_t)((b * 16 + c) * 16 + h)) * 8192;
          _Pragma("unroll")
          for (int k_ = 0; k_ < (64 * 16) / 256; ++k_) { const int i = tid + k_ * 256;
            int kc = i & 15, r = i >> 4;
            uint4 q = *(const uint4*)(st + r * 128 + kc * 8);
            *(uint4*)(R1 + 16384 + (kc >> 3) * 8192 + r * 128 + (((kc & 7) ^ ((r >> 1) & 7)) << 4)) = q;
          }
        }
        __syncthreads();
        f32x16 a1[1][1], a2[1][1];
        zero_acc<1, 1>(a1);
        zero_acc<1, 1>(a2);
#pragma unroll
        for (int pn = 0; pn < 2; ++pn) {
          mma_panel<1, 1>(a1, R0 + pn * 8192, (wid & 1) * 32, R0 + 16384 + pn * 8192, (wid >> 1) * 32, lane);
          mma_panel<1, 1>(a2, R1 + pn * 8192, (wid & 1) * 32, R1 + 16384 + pn * 8192, (wid >> 1) * 32, lane);
        }
        {
          int pp = (wid >> 1) * 32 + (lane & 31), ch = h * 64 + pp;
          float Dh = p.in[zz + I_SSDD][h];
#pragma unroll
          for (int i = 0; i < 16; ++i) {
            int tl = (wid & 1) * 32 + ACC_ROW(i, lane), t = th * 64 + tl;
            size_t row = rowbase + t;
            float y = a1[0][0][i] + __expf(sA[h8 * 128 + t]) * a2[0][0][i];
            float xv = bf2f(exs[i]);
            float z = bf2f(ezs[i]);
            float v = (y + Dh * xv) * z * sigmoidf(z);
            mix[row * 2048 + ch] = f2bf(v);
            if ((i & 3) == 3) SB();
          }
        }
        __syncthreads();
      }
      asm volatile("s_waitcnt vmcnt(0)" ::: "memory");
      __threadfence_block();
      __syncthreads();
      _Pragma("unroll 4")
      for (int tl = wid * 16; tl < wid * 16 + 16; ++tl) {
        size_t row = rowbase + th * 64 + tl;
        u16* ptr = mix + row * 2048 + g * 512 + lane * 8;
        float v[8]; unpack8(*(const uint4*)ptr, v);
        float sq = 0.f;
#pragma unroll
        for (int e = 0; e < 8; ++e) sq += v[e] * v[e];
        sq = wsum(sq);
        float rinv = rsqrtf(sq * (1.f / 512.f) + EPS);
        const float* gn = p.in[zz + I_SSDN] + g * 512 + lane * 8;
#pragma unroll
        for (int e = 0; e < 8; ++e) v[e] *= rinv * gn[e];
        *(uint4*)ptr = pack8(v);
      }
      __syncthreads();
    } else {
      const int c = w & 15, h = (w >> 4) & 3, b = w >> 6;
      const int rowbase = b * 2048 + c * 128;
      const float* gs = (const float*)(p.ws + M_GSUM) + (size_t)(b * 4 + h) * 32;
      float mc, mn, bend;
      mchain(gs, c, mc, mn, bend);
      float* sBc = ex;
      float* sLb = ex + 128;
      float* sMt = ex + 256;
      float* sWi = ex + 384;
      float* sDen = ex + 512;
      float* sQn = ex + 640;
      float* sSq = ex + 768;
      float* sN = ex + 896;
      const float* bcum = (const float*)(p.ws + M_BCUM);
      const float* li = (const float*)(p.ws + M_LI);
      if (tid < 128) {
        float bc = bcum[(size_t)(rowbase + tid) * 4 + h];
        sBc[tid] = bc;
        sLb[tid] = li[(size_t)(rowbase + tid) * 4 + h] - bc;
        sDen[tid] = 0.f; sQn[tid] = 0.f; sSq[tid] = 0.f;
      }
      sN[tid] = ((const float*)(p.ws + M_MLN))[(size_t)((b * 4 + h) * 16 + c) * 256 + tid];
      __syncthreads();
      if (tid < 128) {
        float pm = -INFINITY;
        for (int s = 0; s <= tid; ++s) pm = fmaxf(pm, sLb[s]);
        float inter = sBc[tid] + mc;
        float mt = fmaxf(inter, sBc[tid] + pm);
        sMt[tid] = mt;
        sWi[tid] = __expf(inter - mt);
      }
      __syncthreads();
      if (tid < 128) sBc[tid] -= sMt[tid];
      __syncthreads();
      f32x16 sa[2][2];
      zero_acc<2, 2>(sa);
      _Pragma("unroll 1")
      for (int dp = 0; dp < 4; ++dp) {
        _Pragma("unroll")
        for (int k_ = 0; k_ < (128 * 8) / 256; ++k_) { const int i = tid + k_ * 256;
          int kc = i & 7, r = i >> 3;
          int ch0 = h * 256 + dp * 64 + kc * 8;
          uint4 q = *(const uint4*)(xm + (size_t)(rowbase + r) * 1024 + ch0);
          float xv[8], qv[8], kv[8]; unpack8(q, xv);
          int so = r * 128 + ((kc ^ ((r >> 1) & 7)) << 4);
          blockdiag8(xv, p.in[zz + I_WK], ch0, 0.0625f, kv);
          *(uint4*)(R1 + 16384 + so) = pack8(kv);
          SB();
          blockdiag8(xv, p.in[zz + I_WQ], ch0, 1.f, qv);
          *(uint4*)(R1 + so) = pack8(qv);
          float qn = 0.f;
#pragma unroll
          for (int e = 0; e < 8; ++e) qn += qv[e] * sN[dp * 64 + kc * 8 + e];
          qn += __shfl_xor(qn, 1); qn += __shfl_xor(qn, 2); qn += __shfl_xor(qn, 4);
          if (kc == 0) sQn[r] += qn;
          SB();
        }
        __syncthreads();
        mma_panel<2, 2>(sa, R1, (wid & 1) * 64, R1 + 16384, (wid >> 1) * 64, lane);
        __syncthreads();
      }
#pragma unroll
      for (int mi = 0; mi < 2; ++mi)
#pragma unroll
        for (int ni = 0; ni < 2; ++ni) {
          int s = (wid >> 1) * 64 + ni * 32 + (lane & 31);
          float lb = sLb[s];
#pragma unroll
          for (int i = 0; i < 16; ++i) {
            int t = (wid & 1) * 64 + mi * 32 + ACC_ROW(i, lane);
            float v = (s <= t) ? sa[mi][ni][i] * __expf(sBc[t] + lb) : 0.f;
            *(u16*)(R0 + (s >> 6) * 16384 + img_off(t, s & 63)) = f2bf(v);
            if ((i & 3) == 3) SB();
          }
        }
      __syncthreads();
      if (tid < 128) {
        float sm = 0.f;
        _Pragma("unroll 4")
        for (int kc = 0; kc < 16; ++kc) {
          float v[8];
          unpack8(*(const uint4*)(R0 + (kc >> 3) * 16384 + tid * 128 + (((kc & 7) ^ ((tid >> 1) & 7)) << 4)), v);
#pragma unroll
          for (int e = 0; e < 8; ++e) sm += v[e];
        }
        float den = sm + sWi[tid] * sQn[tid];
#ifdef DBG_DEN1
        sDen[tid] = 1.f + 0.f * den;
#else
        sDen[tid] = 1.f / fmaxf(fabsf(den), __expf(-sMt[tid]));
#endif
      }
      __syncthreads();
      _Pragma("unroll 1")
      for (int vh = 0; vh < 2; ++vh) {
        f32x16 oa[2][2];
        zero_acc<2, 2>(oa);
        _Pragma("unroll 4")
        for (int k_ = 0; k_ < (128 * 16) / 256; ++k_) { const int i = tid + k_ * 256;
          int jc = i & 15, s = i >> 4;
          int ch0 = h * 256 + vh * 128 + jc * 8;
          uint4 q = *(const uint4*)(proj + (size_t)(rowbase + s) * PJ + 2560 + ch0);
          float xv[8], v[8]; unpack8(q, xv);
          blockdiag8(xv, p.in[zz + I_WV], ch0, 1.f, v);
          img_put_t(R1, 128, jc * 8, s, v);
        }
        __syncthreads();
#pragma unroll
        for (int pn = 0; pn < 2; ++pn) mma_panel<2, 2>(oa, R0 + pn * 16384, (wid & 1) * 64, R1 + pn * 16384, (wid >> 1) * 64, lane);
        __syncthreads();
        const u16* st = (const u16*)(p.ws + B_MLST) + ((size_t)((b * 4 + h) * 16 + c)) * 65536;
        _Pragma("unroll 1")
        for (int dp = 0; dp < DBG_DPN; ++dp) {
          _Pragma("unroll")
          for (int k_ = 0; k_ < (128 * 8) / 256; ++k_) { const int i = tid + k_ * 256;
            int kc = i & 7, r = i >> 3;
            int ch0 = h * 256 + dp * 64 + kc * 8;
            uint4 q = *(const uint4*)(xm + (size_t)(rowbase + r) * 1024 + ch0);
            float xv[8], qv[8]; unpack8(q, xv);
            blockdiag8(xv, p.in[zz + I_WQ], ch0, sWi[r], qv);
            int so = r * 128 + ((kc ^ ((r >> 1) & 7)) << 4);
            *(uint4*)(R1 + so) = pack8(qv);
            uint4 cq = *(const uint4*)(st + (size_t)(vh * 128 + r) * 256 + dp * 64 + kc * 8);
            *(uint4*)(R1 + 16384 + so) = cq;
          }
          __syncthreads();
          mma_panel<2, 2>(oa, R1, (wid & 1) * 64, R1 + 16384, (wid >> 1) * 64, lane);
          __syncthreads();
        }
#pragma unroll
        for (int mi = 0; mi < 2; ++mi)
#pragma unroll
          for (int ni = 0; ni < 2; ++ni) {
            int v = vh * 128 + (wid >> 1) * 64 + ni * 32 + (lane & 31);
#pragma unroll
            for (int i = 0; i < 16; ++i) {
              int t = (wid & 1) * 64 + mi * 32 + ACC_ROW(i, lane);
              float hv = oa[mi][ni][i] * sDen[t];
              mix[(size_t)(rowbase + t) * 2048 + 1024 + h * 256 + v] = f2bf(hv);
              if ((i & 3) == 3) SB();
            }
          }
      }
      asm volatile("s_waitcnt vmcnt(0)" ::: "memory");
      __threadfence_block();
      __syncthreads();
      _Pragma("unroll 4")
      for (int it = 0; it < DBG_NORM_IT; ++it) {
        int t = wid * 32 + it * 2 + (lane >> 5), cc = lane & 31;
        size_t row = rowbase + t;
        int ch = h * 256 + cc * 8;
        u16* ptr = mix + row * 2048 + 1024 + ch;
        float v[8], xa[8], op[8];
        unpack8(*(const uint4*)ptr, v);
        float sq = 0.f;
#pragma unroll
        for (int e = 0; e < 8; ++e) sq += v[e] * v[e];
#pragma unroll
        for (int m = 16; m >= 1; m >>= 1) sq += __shfl_xor(sq, m);
        float rinv = rsqrtf(sq * (1.f / 256.f) + EPS);
        unpack8(*(const uint4*)(xm + row * 1024 + ch), xa);
        unpack8(*(const uint4*)(proj + row * PJ + 3584 + ch), op);
#pragma unroll
        for (int e = 0; e < 8; ++e) v[e] = (v[e] * rinv * p.in[zz + I_MLN][ch + e] + p.in[zz + I_MLS][ch + e] * xa[e]) * sigmoidf(op[e]);
        *(uint4*)ptr = pack8(v);
      }
      __syncthreads();
    }
  }
}

__device__ __forceinline__ void phase_rms(const float* x, const float* g, u16* dst, int bid, int G) {
  for (int w = bid; w < TT / 4; w += 2 * G) {
    FRESH_TID(tid);
    const int lane = tid & 63, wid = tid >> 6;
    int rowa = w * 4 + wid;
    bool hasb = (w + G) < TT / 4;
    int rowb = hasb ? (w + G) * 4 + wid : rowa;
    rms_rows2_bf16(x + (size_t)rowa * 1024, x + (size_t)rowb * 1024, g, dst + (size_t)rowa * 1024, dst + (size_t)rowb * 1024, hasb, lane);
  }
}
__device__ __forceinline__ void phase_rms_final(const P& p, const float* x, int bid, int G) {
  const float* g = p.in[zof(bid) + I_NFIN];
  for (int w = bid; w < TT / 8; w += G) {
    FRESH_TID(tid);
    const int lane = tid & 63, wid = tid >> 6;
    int rowa = w * 8 + wid, rowb = rowa + 4;
    const float* sa = x + (size_t)rowa * 1024;
    const float* sb = x + (size_t)rowb * 1024;
    float4 va[4], vb[4];
    float ssa = 0.f, ssb = 0.f;
#pragma unroll
    for (int i = 0; i < 4; ++i) { va[i] = ((const float4*)sa)[lane + 64 * i]; vb[i] = ((const float4*)sb)[lane + 64 * i]; }
#pragma unroll
    for (int i = 0; i < 4; ++i) {
      ssa += va[i].x * va[i].x + va[i].y * va[i].y + va[i].z * va[i].z + va[i].w * va[i].w;
      ssb += vb[i].x * vb[i].x + vb[i].y * vb[i].y + vb[i].z * vb[i].z + vb[i].w * vb[i].w;
    }
    ssa = wsum(ssa); ssb = wsum(ssb);
    float ra = rsqrtf(ssa * (1.f / 1024.f) + EPS), rb = rsqrtf(ssb * (1.f / 1024.f) + EPS);
    float* oa = p.out + O_Y + (size_t)rowa * 1024;
    float* ob = p.out + O_Y + (size_t)rowb * 1024;
#pragma unroll
    for (int i = 0; i < 4; ++i) {
      float4 g4 = ((const float4*)g)[lane + 64 * i];
      ((float4*)oa)[lane + 64 * i] = make_float4(va[i].x * ra * g4.x, va[i].y * ra * g4.y, va[i].z * ra * g4.z, va[i].w * ra * g4.w);
      ((float4*)ob)[lane + 64 * i] = make_float4(vb[i].x * rb * g4.x, vb[i].y * rb * g4.y, vb[i].z * rb * g4.z, vb[i].w * rb * g4.w);
    }
  }
}
struct ShiftRow { float4 v[4], pv[4]; int mode; };
__device__ __forceinline__ void shift_load(ShiftRow& d, const P& p, int zz0, const float* x, int row, int lane) {
  const float* src = x + (size_t)row * 1024;
  const float* psrc;
  if (row < TP) { d.mode = ((row & 2047) == 0) ? 1 : 0; psrc = d.mode ? src : src - 1024; }
  else { d.mode = 2; psrc = p.in[zz0 + I_SSHIFT] + (size_t)(row - TP) * 1024; }
#pragma unroll
  for (int i = 0; i < 4; ++i) {
    d.v[i] = ((const float4*)src)[lane + 64 * i];
    d.pv[i] = ((const float4*)psrc)[lane + 64 * i];
  }
}
__device__ __forceinline__ void shift_finish(ShiftRow& d, const P& p, const float* g, const float* mu, int row, int lane) {
  float ss = 0.f, ps = 0.f;
#pragma unroll
  for (int i = 0; i < 4; ++i) {
    if (d.mode == 1) d.pv[i] = make_float4(0.f, 0.f, 0.f, 0.f);
    ss += d.v[i].x * d.v[i].x + d.v[i].y * d.v[i].y + d.v[i].z * d.v[i].z + d.v[i].w * d.v[i].w;
    ps += d.pv[i].x * d.pv[i].x + d.pv[i].y * d.pv[i].y + d.pv[i].z * d.pv[i].z + d.pv[i].w * d.pv[i].w;
  }
  ss = wsum(ss); ps = wsum(ps);
  float rinv = rsqrtf(ss * (1.f / 1024.f) + EPS);
  float pinv = rsqrtf(ps * (1.f / 1024.f) + EPS);
#pragma unroll
  for (int i = 0; i < 4; ++i) {
    float4 g4 = ((const float4*)g)[lane + 64 * i];
    float xn[4] = {d.v[i].x * rinv * g4.x, d.v[i].y * rinv * g4.y, d.v[i].z * rinv * g4.z, d.v[i].w * rinv * g4.w};
    float xp[4];
    if (d.mode == 0) { xp[0] = d.pv[i].x * pinv * g4.x; xp[1] = d.pv[i].y * pinv * g4.y; xp[2] = d.pv[i].z * pinv * g4.z; xp[3] = d.pv[i].w * pinv * g4.w; }
    else { xp[0] = d.pv[i].x; xp[1] = d.pv[i].y; xp[2] = d.pv[i].z; xp[3] = d.pv[i].w; }
    int col = (lane + 64 * i) * 4;
    if (row >= TP) *(float4*)(p.out + O_SHS + (size_t)(row - TP) * 1024 + col) = make_float4(xn[0], xn[1], xn[2], xn[3]);
    else if ((row & 2047) == 2047) *(float4*)(p.out + O_SHP + (size_t)(row >> 11) * 1024 + col) = make_float4(xn[0], xn[1], xn[2], xn[3]);
#pragma unroll
    for (int c = 0; c < 6; ++c) {
      float4 m4 = *(const float4*)(mu + c * 1024 + col);
      uint2 o;
      o.x = pk2(xn[0] + (xp[0] - xn[0]) * m4.x, xn[1] + (xp[1] - xn[1]) * m4.y);
      o.y = pk2(xn[2] + (xp[2] - xn[2]) * m4.z, xn[3] + (xp[3] - xn[3]) * m4.w);
      size_t base = (c < 5) ? (3 * U + (size_t)c * U) : B_A;
      *(uint2*)((u16*)(p.ws + base) + (size_t)row * 1024 + col) = o;
    }
  }
}
__device__ __forceinline__ void phase_rms_shift(const P& p, const float* x, int bid, int G) {
  const int zz0 = zof(bid);
  const float* g = p.in[zz0 + I_NMIX] + 1024;
  const float* mu = p.in[zz0 + I_MU];
  for (int w = bid; w < TT / 8; w += G) {
    FRESH_TID(tid);
    const int lane = tid & 63, wid = tid >> 6;
    int rowa = w * 8 + wid, rowb = rowa + 4;
    ShiftRow da, db;
    shift_load(da, p, zz0, x, rowa, lane);
    shift_load(db, p, zz0, x, rowb, lane);
    shift_finish(da, p, g, mu, rowa, lane);
    shift_finish(db, p, g, mu, rowb, lane);
  }
}

__device__ __forceinline__ void phase_wkv(const P& p, char* lds, int bid, int G) {
  const u16* rb = (const u16*)(p.ws + B_RB);
  const u16* kb = (const u16*)(p.ws + B_KB);
  const u16* vb = (const u16*)(p.ws + B_VB);
  const u16* ab = (const u16*)(p.ws + B_AB);
  const float* dec = (const float*)(p.ws + B_DEC);
  float* yraw = (float*)(p.ws + B_YRAW);
  float* buf = (float*)lds;
  for (int w = bid; w < 768; w += G) {
#ifdef DBG_SKIP_PROMPT
    if (w < 256) continue;
#endif
    FRESH_TID(tid);
    const int zz = zof(w);
    const int lane = tid & 63, wid = tid >> 6;
    if (w < 256) {
      const int half = w & 1, h = (w >> 1) & 15, b = w >> 5;
      const int j = lane & 7, vrow = half * 32 + wid * 8 + (lane >> 3);
      const int tl = tid >> 4, sub = tid & 15, ch = h * 64 + sub * 4;
      float S[8];
#pragma unroll
      for (int i = 0; i < 8; ++i) S[i] = 0.f;
      float kkw[4], kaw[4];
#pragma unroll
      for (int e = 0; e < 4; ++e) { kkw[e] = p.in[zz + I_KK][ch + e]; kaw[e] = p.in[zz + I_KA][ch + e]; }
      uint2 lr, lk, lv, la; float4 lw;
      auto gload = [&](int tc) {
        size_t o = (size_t)(b * 2048 + tc * 16 + tl) * 1024 + ch;
#ifdef DBG_SYNTH
        { const float* xp = p.in[zz + I_XP] + o; float4 t4 = *(const float4*)xp;
          lr.x = pk2(t4.x, t4.y); lr.y = pk2(t4.z, t4.w); lk = lr; lv = lr; la.x = pk2(0.5f, 0.4f); la.y = pk2(0.6f, 0.5f);
          lw = make_float4(0.9f, 0.95f, 0.99f, 0.8f); }
#else
        lr = *(const uint2*)(rb + o); lk = *(const uint2*)(kb + o); lv = *(const uint2*)(vb + o); la = *(const uint2*)(ab + o);
        lw = *(const float4*)(dec + o);
#endif
      };
      auto lstore = [&](int bi) {
        float* tb = buf + bi * 6144 + tl * 384 + sub * 4;
        float k[4] = {lo2f(lk.x), hi2f(lk.x), lo2f(lk.y), hi2f(lk.y)};
        float a[4] = {lo2f(la.x), hi2f(la.x), lo2f(la.y), hi2f(la.y)};
        float kk[4], n2 = 0.f;
#pragma unroll
        for (int e = 0; e < 4; ++e) { kk[e] = k[e] * kkw[e]; n2 += kk[e] * kk[e]; }
        n2 += __shfl_xor(n2, 1); n2 += __shfl_xor(n2, 2); n2 += __shfl_xor(n2, 4); n2 += __shfl_xor(n2, 8);
        float inv = 1.f / fmaxf(sqrtf(n2), 1e-12f);
        float kp[4], bb[4];
#pragma unroll
        for (int e = 0; e < 4; ++e) { kk[e] *= inv; kp[e] = k[e] * (1.f + (a[e] - 1.f) * kaw[e]); bb[e] = kk[e] * a[e]; }
        *(float4*)(tb) = lw;
        *(float4*)(tb + 64) = make_float4(kk[0], kk[1], kk[2], kk[3]);
        *(float4*)(tb + 128) = make_float4(bb[0], bb[1], bb[2], bb[3]);
        *(float4*)(tb + 192) = make_float4(kp[0], kp[1], kp[2], kp[3]);
        *(float4*)(tb + 256) = make_float4(lo2f(lr.x), hi2f(lr.x), lo2f(lr.y), hi2f(lr.y));
        *(float4*)(tb + 320) = make_float4(lo2f(lv.x), hi2f(lv.x), lo2f(lv.y), hi2f(lv.y));
      };
      gload(0);
      lstore(0);
      __syncthreads();
      for (int tc = 0; tc < 128; ++tc) {
        const int cur = tc & 1;
        if (tc + 1 < 128) gload(tc + 1);
        const float* cb = buf + cur * 6144;
        float* yo = yraw + (size_t)(b * 2048 + tc * 16) * 1024 + h * 64 + vrow;
#pragma unroll 4
        for (int t = 0; t < 16; ++t) {
          const float* tb = cb + t * 384 + j * 8;
          float4 w0 = *(const float4*)(tb), w1 = *(const float4*)(tb + 4);
          float4 k0 = *(const float4*)(tb + 64), k1 = *(const float4*)(tb + 68);
          float4 b0 = *(const float4*)(tb + 128), b1 = *(const float4*)(tb + 132);
          float4 p0 = *(const float4*)(tb + 192), p1 = *(const float4*)(tb + 196);
          float4 r0 = *(const float4*)(tb + 256), r1 = *(const float4*)(tb + 260);
          float vv = cb[t * 384 + 320 + vrow];
          float sa = S[0] * k0.x + S[1] * k0.y + S[2] * k0.z + S[3] * k0.w + S[4] * k1.x + S[5] * k1.y + S[6] * k1.z + S[7] * k1.w;
          sa += DPPF(sa, 0xB1);
          sa += DPPF(sa, 0x4E);
          sa += DPPF(sa, 0x141);
          sa = -sa;
          S[0] = S[0] * w0.x + (sa * b0.x + vv * p0.x);
          S[1] = S[1] * w0.y + (sa * b0.y + vv * p0.y);
          S[2] = S[2] * w0.z + (sa * b0.z + vv * p0.z);
          S[3] = S[3] * w0.w + (sa * b0.w + vv * p0.w);
          S[4] = S[4] * w1.x + (sa * b1.x + vv * p1.x);
          S[5] = S[5] * w1.y + (sa * b1.y + vv * p1.y);
          S[6] = S[6] * w1.z + (sa * b1.z + vv * p1.z);
          S[7] = S[7] * w1.w + (sa * b1.w + vv * p1.w);
          float y = S[0] * r0.x + S[1] * r0.y + S[2] * r0.z + S[3] * r0.w + S[4] * r1.x + S[5] * r1.y + S[6] * r1.z + S[7] * r1.w;
          y += DPPF(y, 0xB1);
          y += DPPF(y, 0x4E);
          y += DPPF(y, 0x141);
          if (j == 0) yo[(size_t)t * 1024] = y;
        }
        if (tc + 1 < 128) lstore(cur ^ 1);
        __syncthreads();
      }
      float* so = p.out + O_WKVP + ((size_t)((b * 16 + h) * 64 + vrow)) * 64 + j * 8;
      *(float4*)so = make_float4(S[0], S[1], S[2], S[3]);
      *(float4*)(so + 4) = make_float4(S[4], S[5], S[6], S[7]);
    } else {
      const int it = (w - 256) * 4 + wid;
      const int bs = it >> 4, h = it & 15, row = TP + bs;
      float* vb_ = buf + wid * 320;
      {
        size_t o = (size_t)row * 1024 + h * 64 + lane;
        float k = bf2f(kb[o]), a = bf2f(ab[o]);
        float kk = k * p.in[zz + I_KK][h * 64 + lane];
        float n2 = wsum(kk * kk);
        kk *= 1.f / fmaxf(sqrtf(n2), 1e-12f);
        vb_[lane] = dec[o];
        vb_[64 + lane] = kk;
        vb_[128 + lane] = kk * a;
        vb_[192 + lane] = k * (1.f + (a - 1.f) * p.in[zz + I_KA][h * 64 + lane]);
        vb_[256 + lane] = bf2f(rb[o]);
      }
      float vv = bf2f(vb[(size_t)row * 1024 + h * 64 + lane]);
      const float* st = p.in[zz + I_SWKV] + ((size_t)((bs * 16 + h) * 64 + lane)) * 64;
      float* so = p.out + O_WKVS + ((size_t)((bs * 16 + h) * 64 + lane)) * 64;
      float4 S4[16];
#pragma unroll
      for (int i = 0; i < 16; ++i) S4[i] = *(const float4*)(st + i * 4);
      float sa = 0.f;
#pragma unroll
      for (int i = 0; i < 16; ++i) {
        float4 k4 = *(const float4*)(vb_ + 64 + i * 4);
        sa += S4[i].x * k4.x + S4[i].y * k4.y + S4[i].z * k4.z + S4[i].w * k4.w;
      }
      sa = -sa;
      float y = 0.f;
#pragma unroll
      for (int i = 0; i < 16; ++i) {
        float4 w4 = *(const float4*)(vb_ + i * 4), b4 = *(const float4*)(vb_ + 128 + i * 4);
        float4 p4 = *(const float4*)(vb_ + 192 + i * 4), r4 = *(const float4*)(vb_ + 256 + i * 4);
        float4 s = S4[i];
        s.x = s.x * w4.x + (sa * b4.x + vv * p4.x);
        s.y = s.y * w4.y + (sa * b4.y + vv * p4.y);
        s.z = s.z * w4.z + (sa * b4.z + vv * p4.z);
        s.w = s.w * w4.w + (sa * b4.w + vv * p4.w);
        y += s.x * r4.x + s.y * r4.y + s.z * r4.z + s.w * r4.w;
        *(float4*)(so + i * 4) = s;
      }
      yraw[(size_t)row * 1024 + h * 64 + lane] = y;
      __syncthreads();
    }
  }
}

__device__ __forceinline__ void phase_wkv_ln(const P& p, int bid, int G) {
  const u16* rb = (const u16*)(p.ws + B_RB);
  const u16* kb = (const u16*)(p.ws + B_KB);
  const u16* vb = (const u16*)(p.ws + B_VB);
  const u16* ab = (const u16*)(p.ws + B_AB);
  const u16* gb = (const u16*)(p.ws + B_GB);
  const float* yraw = (const float*)(p.ws + B_YRAW);
  u16* yb = (u16*)(p.ws + B_YB);
  for (int w = bid; w < TT / 4; w += G) {
    FRESH_TID(tid);
    const int zz = zof(w);
    const int lane = tid & 63, wid = tid >> 6;
    int row = w * 4 + wid;
    size_t o = (size_t)row * 1024 + lane * 16;
    float y[16], r[16], k[16], v[16], a[16], g[16];
#pragma unroll
    for (int i = 0; i < 4; ++i) {
      float4 t = *(const float4*)(yraw + o + i * 4);
      y[i * 4] = t.x; y[i * 4 + 1] = t.y; y[i * 4 + 2] = t.z; y[i * 4 + 3] = t.w;
    }
    unpack8(*(const uint4*)(rb + o), r); unpack8(*(const uint4*)(rb + o + 8), r + 8);
    unpack8(*(const uint4*)(kb + o), k); unpack8(*(const uint4*)(kb + o + 8), k + 8);
    unpack8(*(const uint4*)(vb + o), v); unpack8(*(const uint4*)(vb + o + 8), v + 8);
    unpack8(*(const uint4*)(ab + o), a); unpack8(*(const uint4*)(ab + o + 8), a + 8);
    unpack8(*(const uint4*)(gb + o), g); unpack8(*(const uint4*)(gb + o + 8), g + 8);
    int c0 = lane * 16;
    float sm = 0.f, bon = 0.f;
#pragma unroll
    for (int e = 0; e < 16; ++e) {
      sm += y[e];
      float kp = k[e] * (1.f + (a[e] - 1.f) * p.in[zz + I_KA][c0 + e]);
      bon += r[e] * kp * p.in[zz + I_RK][c0 + e];
    }
    sm += __shfl_xor(sm, 1); sm += __shfl_xor(sm, 2);
    bon += __shfl_xor(bon, 1); bon += __shfl_xor(bon, 2);
    float mean = sm * (1.f / 64.f), vr = 0.f;
#pragma unroll
    for (int e = 0; e < 16; ++e) { float d = y[e] - mean; vr += d * d; }
    vr += __shfl_xor(vr, 1); vr += __shfl_xor(vr, 2);
    float rinv = rsqrtf(vr * (1.f / 64.f) + 64e-5f);
    float ov[16];
#pragma unroll
    for (int e = 0; e < 16; ++e)
      ov[e] = ((y[e] - mean) * rinv * p.in[zz + I_LNW][c0 + e] + p.in[zz + I_LNB][c0 + e] + bon * v[e]) * g[e];
    *(uint4*)(yb + o) = pack8(ov);
    *(uint4*)(yb + o + 8) = pack8(ov + 8);
  }
}

__device__ __forceinline__ void run_phase(const P& p, int ph, char* lds, int bid, int G) {
  char* ws = p.ws;
  const int zz = zof(ph);
  switch (ph) {
    case 0: if (PHEN(0)) phase_prep(p, lds, bid, G); break;
    case 1: { if (!PHEN(1)) break;
      EpiProj e{(u16*)(ws + B_PROJ), (float*)(ws + B_SMALL)};
      gemm_phase((const u16*)(ws + B_A), 1024, (const u16*)(ws + W_IN0), 1024, 1024, 65, 37, lds, bid, G, e);
    } break;
    case 2: if (PHEN(2)) phase_conv(p, lds, bid, G); break;
    case 3: if (PHEN(3)) phase_chunkstate(p, lds, bid, G); break;
    case 4: if (PHEN(4)) phase_scan(p, lds, bid, G); break;
    case 5: if (PHEN(5)) phase_chunkout(p, lds, bid, G); break;
    case 6: { if (!PHEN(6)) break;
      EpiRes e{p.in[zz + I_XP], p.in[zz + I_XS], (float*)(ws + B_X1)};
      gemm_phase((const u16*)(ws + B_MIX), 2048, (const u16*)(ws + W_OUT0), 2048, 2048, 65, 8, lds, bid, G, e);
    } break;
    case 7: if (PHEN(7)) phase_rms((const float*)(ws + B_X1), p.in[zz + I_NFFN], (u16*)(ws + B_A), bid, G); break;
    case 8: { if (!PHEN(8)) break;
      EpiSwiglu e{(u16*)(ws + B_HB)};
      gemm_phase((const u16*)(ws + B_A), 1024, (const u16*)(ws + W_GU), 1024, 1024, 65, 44, lds, bid, G, e);
    } break;
    case 9: { if (!PHEN(9)) break;
      const float* x1 = (const float*)(ws + B_X1);
      EpiRes e{x1, x1 + (size_t)TP * 1024, (float*)(ws + B_X2)};
      gemm_phase((const u16*)(ws + B_HB), 2816, (const u16*)(ws + W_DN), 2816, 2816, 65, 8, lds, bid, G, e);
    } break;
    case 10: if (PHEN(10)) phase_rms_shift(p, (const float*)(ws + B_X2), bid, G); break;
    case 11: { if (!PHEN(11)) break;
      const int nbig = 3 * 65 * 8;
      for (int t = bid; t < nbig + 65 * 4; t += G) {
        if (t < nbig) {
          int which = t / (65 * 8), r = t % (65 * 8);
          int mt = r % 65, nt = r / 65;
          size_t abase = which == 0 ? 3 * U : (which == 1 ? 5 * U : 6 * U);
          size_t wbase = which == 0 ? W_R : (which == 1 ? W_K : W_V);
          size_t obase = which == 0 ? B_RB : (which == 1 ? B_KB : B_VB);
          EpiAct e{(u16*)(ws + obase), 1024, 1024, 1024, 0};
          gemm_tile((const u16*)(ws + abase), 1024, (const u16*)(ws + wbase), 1024, 1024, mt * 256, nt * 128, lds, e);
        } else {
          int r = t - nbig;
          if (r < 65) {
            EpiAct e{(u16*)(ws + B_LW), 128, 64, 128, 1};
            gemm_tile((const u16*)(ws + 4 * U), 1024, (const u16*)(ws + W_W1), 1024, 1024, r * 256, 0, lds, e);
          } else if (r < 130) {
            EpiAct e{(u16*)(ws + B_LA), 128, 64, 128, 0};
            gemm_tile((const u16*)(ws + 7 * U), 1024, (const u16*)(ws + W_A1), 1024, 1024, (r - 65) * 256, 0, lds, e);
          } else {
            int q = r - 130;
            EpiAct e{(u16*)(ws + B_LG), 256, 160, 256, 2};
            gemm_tile((const u16*)(ws + B_A), 1024, (const u16*)(ws + W_G1), 1024, 1024, (q % 65) * 256, (q / 65) * 128, lds, e);
          }
        }
      }
    } break;
    case 12: { if (!PHEN(12)) break;
      for (int t = bid; t < 3 * 65 * 8; t += G) {
        int which = t / (65 * 8), r = t % (65 * 8);
        int mt = r % 65, nt = r / 65;
        if (which == 0) {
          EpiLora2 e{0, p.in[zz + I_W0], (float*)(ws + B_DEC), nullptr};
          gemm_tile((const u16*)(ws + B_LW), 128, (const u16*)(ws + W_W2), 128, 128, mt * 256, nt * 128, lds, e);
        } else if (which == 1) {
          EpiLora2 e{1, p.in[zz + I_A0], nullptr, (u16*)(ws + B_AB)};
          gemm_tile((const u16*)(ws + B_LA), 128, (const u16*)(ws + W_A2), 128, 128, mt * 256, nt * 128, lds, e);
        } else {
          EpiLora2 e{2, nullptr, nullptr, (u16*)(ws + B_GB)};
          gemm_tile((const u16*)(ws + B_LG), 256, (const u16*)(ws + W_G2), 256, 256, mt * 256, nt * 128, lds, e);
        }
      }
    } break;
    case 13: if (PHEN(13)) phase_wkv(p, lds, bid, G); break;
    case 14: if (PHEN(14)) phase_wkv_ln(p, bid, G); break;
    case 15: { if (!PHEN(15)) break;
      const float* x2 = (const float*)(ws + B_X2);
      EpiRes e{x2, x2 + (size_t)TP * 1024, (float*)(ws + B_X3)};
      gemm_phase((const u16*)(ws + B_YB), 1024, (const u16*)(ws + W_O), 1024, 1024, 65, 8, lds, bid, G, e);
    } break;
    case 16: if (PHEN(16)) phase_rms((const float*)(ws + B_X3), p.in[zz + I_NFFN] + 1024, (u16*)(ws + B_A), bid, G); break;
    case 17: { if (!PHEN(17)) break;
      EpiSwiglu e{(u16*)(ws + B_HB)};
      gemm_phase((const u16*)(ws + B_A), 1024, (const u16*)(ws + W_GU + 5632ull * 1024 * 2), 1024, 1024, 65, 44, lds, bid, G, e);
    } break;
    case 18: { if (!PHEN(18)) break;
      const float* x3 = (const float*)(ws + B_X3);
      EpiRes e{x3, x3 + (size_t)TP * 1024, (float*)(ws + B_X4)};
      gemm_phase((const u16*)(ws + B_HB), 2816, (const u16*)(ws + W_DN + 1024ull * 2816 * 2), 2816, 2816, 65, 8, lds, bid, G, e);
    } break;
    case 19: if (PHEN(19)) phase_rms_final(p, (const float*)(ws + B_X4), bid, G); break;
#ifdef DBG_MIX_OFF
    case 100: {
      for (size_t i = (size_t)bid * 256 + threadIdx.x; i < (size_t)TT * 1024; i += (size_t)G * 256) {
        size_t row = i >> 10; int c = (int)(i & 1023);
        p.out[O_Y + i] = bf2f(((const u16*)(p.ws + B_MIX))[row * 2048 + DBG_MIX_OFF + c]);
      }
    } break;
#endif
    default: break;
  }
}

#ifndef MK_LB
#define MK_LB 1
#endif
__global__ void __launch_bounds__(256, MK_LB) mk_forward(P p, int ph_lo, int ph_hi) {
  extern __shared__ __attribute__((aligned(16))) char lds[];
  cg::grid_group grid = cg::this_grid();
  const int bid = blockIdx.x, G = gridDim.x;
#ifdef TM_A
  unsigned long long tm0 = wall_clock64(), tm1 = 0, tm2 = 0;
#endif
#if !MK_MULTI
  unsigned* bar = (unsigned*)(p.ws + M_BAR);
  const unsigned xcc = (unsigned)__builtin_amdgcn_s_getreg((3 << 11) | 20) & 0xFu;
  unsigned nloc = 0, nx = 0;
  if (threadIdx.x == 0) __hip_atomic_fetch_add(&bar[xcc * 64], 1u, __ATOMIC_RELAXED, __HIP_MEMORY_SCOPE_AGENT);
#endif
  for (int ph = ph_lo; ph < ph_hi; ++ph) {
    run_phase(p, ph, lds, bid, G);
    if (ph + 1 < ph_hi) {
#if MK_MULTI
      grid.sync();
#else
      if (ph == ph_lo) {
        grid.sync();
        if (threadIdx.x == 0) {
          for (int j = 0; j < 16; ++j) {
            unsigned c = __hip_atomic_load(&bar[j * 64], __ATOMIC_RELAXED, __HIP_MEMORY_SCOPE_AGENT);
            if (c) ++nx;
            if ((unsigned)j == xcc) nloc = c;
          }
        }
      } else {
        asm volatile("s_waitcnt vmcnt(0)" ::: "memory");
        __syncthreads();
        if (threadIdx.x == 0) {
          unsigned* sub = bar + 64 * (16 + ph * 33 + xcc);
          unsigned* gen = bar + 64 * (16 + ph * 33 + 16 + xcc);
          unsigned* top = bar + 64 * (16 + ph * 33 + 32);
          unsigned old = __hip_atomic_fetch_add(sub, 1u, __ATOMIC_RELAXED, __HIP_MEMORY_SCOPE_AGENT);
          if (old == nloc - 1) {
            __builtin_amdgcn_fence(__ATOMIC_RELEASE, "agent");
            asm volatile("s_waitcnt vmcnt(0)" ::: "memory");
            __hip_atomic_fetch_add(top, 1u, __ATOMIC_RELAXED, __HIP_MEMORY_SCOPE_AGENT);
            while (__hip_atomic_load(top, __ATOMIC_RELAXED, __HIP_MEMORY_SCOPE_AGENT) < nx) __builtin_amdgcn_s_sleep(1);
            __hip_atomic_store(gen, 1u, __ATOMIC_RELAXED, __HIP_MEMORY_SCOPE_AGENT);
          } else {
            while (__hip_atomic_load(gen, __ATOMIC_RELAXED, __HIP_MEMORY_SCOPE_AGENT) == 0u) __builtin_amdgcn_s_sleep(1);
          }
        }
        __syncthreads();
        __builtin_amdgcn_fence(__ATOMIC_ACQUIRE, "agent");
        asm volatile("s_waitcnt vmcnt(0)" ::: "memory");
      }
#endif
    }
#ifdef TM_A
    if (ph == TM_A) tm1 = wall_clock64();
    if (ph == TM_B) tm2 = wall_clock64();
#endif
  }
#ifdef TM_A
  grid.sync();
  if (bid == 0 && threadIdx.x == 0) {
    unsigned long long tm3 = wall_clock64();
    float tot = (float)(tm3 - tm0);
    float f1 = (float)(tm1 - tm0) / tot, f2 = (float)(tm2 - tm0) / tot;
    float sc = 1.f + sqrtf(0.01f + 0.5f * f1);
    for (int i = 0; i < 32; ++i) p.out[O_MMP + i] *= sc;
    p.out[O_Y + (size_t)TP * 1024] += 1.f + 10.f * f2;
  }
#endif
#if defined(DBG_MIX_OFF) && !MK_MULTI
  grid.sync();
  run_phase(p, 100, lds, bid, G);
#endif

}

extern "C" void kernel_launch(void* const* d_in, const int* in_sizes, int n_in, void* d_out, int out_size, void* d_ws,
                              size_t ws_size, hipStream_t stream) {
  static int grid_blocks = 0;
  if (!grid_blocks) {
    hipFuncSetAttribute((const void*)mk_forward, hipFuncAttributeMaxDynamicSharedMemorySize, LDS_BYTES);
    int dev = 0, cus = 0, per_cu = 0;
    hipGetDevice(&dev);
    hipDeviceGetAttribute(&cus, hipDeviceAttributeMultiprocessorCount, dev);
    hipOccupancyMaxActiveBlocksPerMultiprocessor(&per_cu, mk_forward, 256, LDS_BYTES);
    if (per_cu > 2) per_cu = 2;
    if (per_cu < 1) per_cu = 1;
    grid_blocks = cus * per_cu;
  }
  P p{};
  for (int i = 0; i < N_IN; ++i) p.in[i] = (const float*)d_in[i];
  p.out = (float*)d_out;
  p.ws = (char*)d_ws;
  if (ws_size < WS_NEED) fprintf(stderr, "workspace too small: %zu < %zu\n", ws_size, (size_t)WS_NEED);
#if MK_MULTI
#ifndef MK_HI
#define MK_HI NPH
#endif
  for (int ph = 0; ph < MK_HI; ++ph) {
    int lo = ph, hi = ph + 1;
    hipLaunchKernelGGL(mk_forward, dim3(grid_blocks), dim3(256), LDS_BYTES, stream, p, lo, hi);
  }
#ifdef DBG_MIX_OFF
  hipLaunchKernelGGL(mk_forward, dim3(grid_blocks), dim3(256), LDS_BYTES, stream, p, 100, 101);
#endif
#else
#ifndef MK_HI
#define MK_HI NPH
#endif
  int lo = 0, hi = MK_HI;
  hipMemsetAsync((char*)d_ws + M_BAR, 0, (size_t)BAR_WORDS * 4, stream);
  void* args[] = {&p, &lo, &hi};
  hipError_t e = hipLaunchCooperativeKernel((void*)mk_forward, dim3(grid_blocks), dim3(256), args, LDS_BYTES, stream);
  if (e != hipSuccess) fprintf(stderr, "cooperative launch failed: %s (grid %d)\n", hipGetErrorString(e), grid_blocks);
#endif
}
```

```cpp
#include <hip/hip_runtime.h>
#include <hip/hip_cooperative_groups.h>
#include <cstdio>
namespace cg = cooperative_groups;

#ifndef DBG_DPN
#define DBG_DPN 4
#endif
#ifndef DBG_NORM_IT
#define DBG_NORM_IT 16
#endif
#ifndef MK_MULTI
#define MK_MULTI 0
#endif
#ifdef ONLY_PH
#define PHEN(n) ((n) == ONLY_PH)
#else
#define PHEN(n) true
#endif

#define SB() __builtin_amdgcn_sched_barrier(0)
typedef unsigned short u16;
typedef __attribute__((ext_vector_type(8))) short bf16x8;
typedef __attribute__((ext_vector_type(16))) float f32x16;

constexpr int TP = 16384, TS = 128, TT = 16512, DM = 1024;
constexpr int PJ = 4608;
constexpr int NPH = 20;
constexpr float EPS = 1e-5f;

enum { I_XP = 0, I_XS, I_SCONV, I_SSSM, I_SMC, I_SMN, I_SMM, I_SSHIFT, I_SWKV, I_NMIX, I_NFFN, I_NFIN, I_WIN0,
       I_CONVW, I_CONVB, I_DTB, I_ALOG, I_SSDD, I_SSDN, I_WQ, I_WK, I_WV, I_IB, I_FB, I_MLN, I_MLS, I_WOUT0,
       I_MU, I_WR, I_WKK, I_WVV, I_WO, I_W0, I_W1, I_W2, I_A0, I_A1, I_A2, I_G1, I_G2, I_KK, I_KA, I_RK,
       I_LNW, I_LNB, I_GU, I_DN, N_IN };

constexpr size_t O_Y = 0;
constexpr size_t O_CONVP = O_Y + (size_t)TT * 1024;
constexpr size_t O_CONVS = O_CONVP + 8 * 3 * 2560;
constexpr size_t O_SSMP = O_CONVS + 128 * 3 * 2560;
constexpr size_t O_SSMS = O_SSMP + 8ull * 16 * 64 * 128;
constexpr size_t O_MCP = O_SSMS + 128ull * 16 * 64 * 128;
constexpr size_t O_MCS = O_MCP + 8ull * 4 * 256 * 256;
constexpr size_t O_MNP = O_MCS + 128ull * 4 * 256 * 256;
constexpr size_t O_MNS = O_MNP + 8 * 4 * 256;
constexpr size_t O_MMP = O_MNS + 128 * 4 * 256;
constexpr size_t O_MMS = O_MMP + 32;
constexpr size_t O_SHP = O_MMS + 512;
constexpr size_t O_SHS = O_SHP + 8 * 1024;
constexpr size_t O_WKVP = O_SHS + 128 * 1024;
constexpr size_t O_WKVS = O_WKVP + 8ull * 16 * 64 * 64;

constexpr size_t U = 33ull << 20;
constexpr size_t W_IN0 = 0;
constexpr size_t W_OUT0 = W_IN0 + 4736ull * 1024 * 2;
constexpr size_t W_GU = W_OUT0 + 1024ull * 2048 * 2;
constexpr size_t W_DN = W_GU + 2ull * 5632 * 1024 * 2;
constexpr size_t W_R = W_DN + 2ull * 1024 * 2816 * 2;
constexpr size_t W_K = W_R + 1024ull * 1024 * 2;
constexpr size_t W_V = W_K + 1024ull * 1024 * 2;
constexpr size_t W_O = W_V + 1024ull * 1024 * 2;
constexpr size_t W_W1 = W_O + 1024ull * 1024 * 2;
constexpr size_t W_A1 = W_W1 + 128ull * 1024 * 2;
constexpr size_t W_G1 = W_A1 + 128ull * 1024 * 2;
constexpr size_t W_W2 = W_G1 + 256ull * 1024 * 2;
constexpr size_t W_A2 = W_W2 + 1024ull * 128 * 2;
constexpr size_t W_G2 = W_A2 + 1024ull * 128 * 2;
constexpr size_t W_END = W_G2 + 1024ull * 256 * 2;
static_assert(W_END <= 2 * U, "weights");
constexpr size_t B_A = 2 * U;
constexpr size_t B_PROJ = 3 * U;
constexpr size_t B_SMALL = 8 * U;
constexpr size_t B_BM = B_SMALL + (size_t)TT * 32 * 4;
constexpr size_t B_CM = B_BM + (size_t)TT * 256 * 2;
constexpr size_t B_XM = 9 * U;
constexpr size_t B_SSDST = 10 * U;
constexpr size_t B_MLST = 11 * U;
constexpr size_t B_MIX = 13 * U;
constexpr size_t B_MISC = 15 * U;
constexpr size_t M_GSUM = B_MISC;
constexpr size_t M_BCUM = M_GSUM + 8 * 4 * 16 * 2 * 4;
constexpr size_t M_LI = M_BCUM + (size_t)TT * 4 * 4;
constexpr size_t M_DT = M_LI + (size_t)TT * 4 * 4;
constexpr size_t M_ACUM = M_DT + (size_t)TT * 16 * 4;
constexpr size_t M_MLN = M_ACUM + (size_t)TT * 16 * 4;
constexpr size_t M_END = M_MLN + 8ull * 4 * 16 * 256 * 4;
constexpr size_t WS_NEED = 15 * U + (8ull << 20);
constexpr size_t M_BAR = M_END;
constexpr int BAR_WORDS = 64 * (16 + 24 * 33);
static_assert(M_BAR + (size_t)BAR_WORDS * 4 <= WS_NEED, "bar");
static_assert(M_END <= WS_NEED, "misc");
static_assert(B_CM + (size_t)TT * 256 * 2 <= 9 * U, "bm/cm");
constexpr size_t B_X1 = 3 * U, B_HB = 5 * U, B_X2 = 8 * U;
constexpr size_t B_RB = 10 * U, B_KB = 11 * U, B_VB = 12 * U;
constexpr size_t B_LW = 13 * U, B_LA = B_LW + (size_t)TT * 128 * 2, B_LG = B_LA + (size_t)TT * 128 * 2;
constexpr size_t B_DEC = 3 * U, B_AB = 5 * U, B_GB = 6 * U, B_YB = 7 * U;
constexpr size_t B_YRAW = 13 * U;
constexpr size_t B_X3 = 3 * U, B_X4 = 8 * U;

constexpr int LDS_BYTES = 98304;

struct P {
  const float* in[N_IN];
  float* out;
  char* ws;
};

__device__ __forceinline__ u16 f2bf(float f) {
  unsigned u = __float_as_uint(f);
  u += 0x7fffu + ((u >> 16) & 1u);
  return (u16)(u >> 16);
}
__device__ __forceinline__ float bf2f(u16 h) { return __uint_as_float(((unsigned)h) << 16); }
__device__ __forceinline__ unsigned pk2(float a, float b) { return (unsigned)f2bf(a) | ((unsigned)f2bf(b) << 16); }
__device__ __forceinline__ float lo2f(unsigned u) { return __uint_as_float(u << 16); }
__device__ __forceinline__ float hi2f(unsigned u) { return __uint_as_float(u & 0xffff0000u); }
__device__ __forceinline__ void unpack8(const uint4& q, float* f) {
  f[0] = lo2f(q.x); f[1] = hi2f(q.x); f[2] = lo2f(q.y); f[3] = hi2f(q.y);
  f[4] = lo2f(q.z); f[5] = hi2f(q.z); f[6] = lo2f(q.w); f[7] = hi2f(q.w);
}
__device__ __forceinline__ uint4 pack8(const float* f) {
  uint4 q; q.x = pk2(f[0], f[1]); q.y = pk2(f[2], f[3]); q.z = pk2(f[4], f[5]); q.w = pk2(f[6], f[7]);
  return q;
}
__device__ __forceinline__ float softplusf(float x) { return x > 20.f ? x : log1pf(__expf(x)); }
__device__ __forceinline__ float sigmoidf(float x) { return 1.f / (1.f + __expf(-x)); }
__device__ __forceinline__ float wsum(float v) {
#pragma unroll
  for (int m = 32; m >= 1; m >>= 1) v += __shfl_xor(v, m);
  return v;
}
__device__ __forceinline__ float wmax(float v) {
#pragma unroll
  for (int m = 32; m >= 1; m >>= 1) v = fmaxf(v, __shfl_xor(v, m));
  return v;
}
__device__ __forceinline__ float wscan(float v, int lane) {
#pragma unroll
  for (int o = 1; o < 64; o <<= 1) {
    float t = __shfl_up(v, o);
    if (lane >= o) v += t;
  }
  return v;
}
__device__ __forceinline__ float bsum(float v, float* scr) {
  v = wsum(v);
  __syncthreads();
  if ((threadIdx.x & 63) == 0) scr[threadIdx.x >> 6] = v;
  __syncthreads();
  return scr[0] + scr[1] + scr[2] + scr[3];
}
__device__ __forceinline__ float dpp_f(float v, const int ctrl);
#define DPPF(v, ctrl) __int_as_float(__builtin_amdgcn_update_dpp(0, __float_as_int(v), ctrl, 0xF, 0xF, true))

__device__ __forceinline__ int img_off(int row, int kk  ) {
  return row * 128 + ((((kk >> 3) ^ ((row >> 1) & 7))) << 4) + ((kk & 7) << 1);
}

template <int MI, int NI>
__device__ __forceinline__ void mma_panel(f32x16 (&acc)[MI][NI], const char* Ap, int ar0, const char* Bp, int br0, int lane) {
  const int r = lane & 31, h = lane >> 5;
  bf16x8 a[2][MI], b[2][NI];
  const char* ap[MI];
  const char* bp[NI];
  int asw[MI], bsw[NI];
#pragma unroll
  for (int mi = 0; mi < MI; ++mi) { int row = ar0 + mi * 32 + r; ap[mi] = Ap + row * 128; asw[mi] = (row >> 1) & 7; }
#pragma unroll
  for (int ni = 0; ni < NI; ++ni) { int row = br0 + ni * 32 + r; bp[ni] = Bp + row * 128; bsw[ni] = (row >> 1) & 7; }
#pragma unroll
  for (int mi = 0; mi < MI; ++mi) a[0][mi] = *(const bf16x8*)(ap[mi] + ((h ^ asw[mi]) << 4));
#pragma unroll
  for (int ni = 0; ni < NI; ++ni) b[0][ni] = *(const bf16x8*)(bp[ni] + ((h ^ bsw[ni]) << 4));
#pragma unroll
  for (int ks = 0; ks < 4; ++ks) {
    const int cur = ks & 1, nxt = cur ^ 1;
    if (ks < 3) {
      const int ch = (ks + 1) * 2 + h;
#pragma unroll
      for (int mi = 0; mi < MI; ++mi) a[nxt][mi] = *(const bf16x8*)(ap[mi] + ((ch ^ asw[mi]) << 4));
#pragma unroll
      for (int ni = 0; ni < NI; ++ni) b[nxt][ni] = *(const bf16x8*)(bp[ni] + ((ch ^ bsw[ni]) << 4));
    }
    SB();
#pragma unroll
    for (int mi = 0; mi < MI; ++mi)
#pragma unroll
      for (int ni = 0; ni < NI; ++ni)
        acc[mi][ni] = __builtin_amdgcn_mfma_f32_32x32x16_bf16(a[cur][mi], b[cur][ni], acc[mi][ni], 0, 0, 0);
    SB();
  }
}
template <int MI, int NI>
__device__ __forceinline__ void mma_panel_s(f32x16 (&acc)[MI][NI], const char* Ap, int ar0, const char* Bp, int br0, int lane) {
  const int r = lane & 31, h = lane >> 5;
#pragma unroll
  for (int ks = 0; ks < 4; ++ks) {
    const int ch = ks * 2 + h;
    bf16x8 a[MI], b[NI];
#pragma unroll
    for (int mi = 0; mi < MI; ++mi) { int row = ar0 + mi * 32 + r; a[mi] = *(const bf16x8*)(Ap + row * 128 + ((ch ^ ((row >> 1) & 7)) << 4)); }
#pragma unroll
    for (int ni = 0; ni < NI; ++ni) { int row = br0 + ni * 32 + r; b[ni] = *(const bf16x8*)(Bp + row * 128 + ((ch ^ ((row >> 1) & 7)) << 4)); }
    SB();
#pragma unroll
    for (int mi = 0; mi < MI; ++mi)
#pragma unroll
      for (int ni = 0; ni < NI; ++ni)
        acc[mi][ni] = __builtin_amdgcn_mfma_f32_32x32x16_bf16(a[mi], b[ni], acc[mi][ni], 0, 0, 0);
    SB();
  }
}
template <int MI, int NI>
__device__ __forceinline__ void zero_acc(f32x16 (&acc)[MI][NI]) {
#pragma unroll
  for (int mi = 0; mi < MI; ++mi)
#pragma unroll
    for (int ni = 0; ni < NI; ++ni)
#pragma unroll
      for (int i = 0; i < 16; ++i) acc[mi][ni][i] = 0.f;
}
#define FRESH_TID(tid) int tid = threadIdx.x; asm volatile("" : "+v"(tid))
__device__ __forceinline__ int zof(int w) { int z; asm("s_mov_b32 %0, 0" : "=s"(z) : "s"(w)); return z; }
#define ACC_ROW(i, lane) (((i) & 3) + 8 * ((i) >> 2) + 4 * ((lane) >> 5))

template <class Epi>
__device__ __forceinline__ void gemm_tile(const u16* __restrict__ A, int lda, const u16* __restrict__ B, int ldb, int K,
                                          int m0, int n0, char* lds, const Epi& epi) {
  FRESH_TID(tid);
  const int lane = tid & 63, wid = tid >> 6, wr = wid & 1, wc = wid >> 1;
  f32x16 acc[4][2];
  epi.init(acc, m0 + wr * 128, n0 + wc * 64, lane);
  const int lrow = tid >> 3, lch = tid & 7;
  const u16* Bp = B + (size_t)(n0 + lrow) * ldb + lch * 8;
  const int soff = lrow * 128 + ((lch ^ ((lrow >> 1) & 7)) << 4);
  int aoff[8];
#pragma unroll
  for (int i = 0; i < 8; ++i) {
    int r = m0 + lrow + 32 * i;
    r = r < TT ? r : TT - 1;
    aoff[i] = (r - m0) * lda;
  }
  const u16* Ab = A + (size_t)m0 * lda + lch * 8;
  uint4 ra0, ra1, ra2, ra3, ra4, ra5, ra6, ra7, rb0, rb1, rb2, rb3, rc0, rc1, rc2, rc3, rc4, rc5, rc6, rc7, rd0, rd1, rd2, rd3;
  const int nk = K >> 6;
  {
    ra0 = *(const uint4*)(Ab + aoff[0] + 0);
    ra1 = *(const uint4*)(Ab + aoff[1] + 0);
    ra2 = *(const uint4*)(Ab + aoff[2] + 0);
    ra3 = *(const uint4*)(Ab + aoff[3] + 0);
    ra4 = *(const uint4*)(Ab + aoff[4] + 0);
    ra5 = *(const uint4*)(Ab + aoff[5] + 0);
    ra6 = *(const uint4*)(Ab + aoff[6] + 0);
    ra7 = *(const uint4*)(Ab + aoff[7] + 0);
    rb0 = *(const uint4*)(Bp + (size_t)(0) * ldb + 0);
    rb1 = *(const uint4*)(Bp + (size_t)(32) * ldb + 0);
    rb2 = *(const uint4*)(Bp + (size_t)(64) * ldb + 0);
    rb3 = *(const uint4*)(Bp + (size_t)(96) * ldb + 0);
    rc0 = *(const uint4*)(Ab + aoff[0] + 64);
    rc1 = *(const uint4*)(Ab + aoff[1] + 64);
    rc2 = *(const uint4*)(Ab + aoff[2] + 64);
    rc3 = *(const uint4*)(Ab + aoff[3] + 64);
    rc4 = *(const uint4*)(Ab + aoff[4] + 64);
    rc5 = *(const uint4*)(Ab + aoff[5] + 64);
    rc6 = *(const uint4*)(Ab + aoff[6] + 64);
    rc7 = *(const uint4*)(Ab + aoff[7] + 64);
    rd0 = *(const uint4*)(Bp + (size_t)(0) * ldb + 64);
    rd1 = *(const uint4*)(Bp + (size_t)(32) * ldb + 64);
    rd2 = *(const uint4*)(Bp + (size_t)(64) * ldb + 64);
    rd3 = *(const uint4*)(Bp + (size_t)(96) * ldb + 64);
    *(uint4*)(lds + 0 + soff + 0) = ra0;
    *(uint4*)(lds + 0 + soff + 4096) = ra1;
    *(uint4*)(lds + 0 + soff + 8192) = ra2;
    *(uint4*)(lds + 0 + soff + 12288) = ra3;
    *(uint4*)(lds + 0 + soff + 16384) = ra4;
    *(uint4*)(lds + 0 + soff + 20480) = ra5;
    *(uint4*)(lds + 0 + soff + 24576) = ra6;
    *(uint4*)(lds + 0 + soff + 28672) = ra7;
    *(uint4*)(lds + 0 + 32768 + soff + 0) = rb0;
    *(uint4*)(lds + 0 + 32768 + soff + 4096) = rb1;
    *(uint4*)(lds + 0 + 32768 + soff + 8192) = rb2;
    *(uint4*)(lds + 0 + 32768 + soff + 12288) = rb3;
  }
  __syncthreads();
  const int r_ = lane & 31, h_ = lane >> 5;
  int arow[4], asw[4], brow[2], bsw[2];
#pragma unroll
  for (int mi = 0; mi < 4; ++mi) { int row = wr * 128 + mi * 32 + r_; arow[mi] = row * 128; asw[mi] = (row >> 1) & 7; }
#pragma unroll
  for (int ni = 0; ni < 2; ++ni) { int row = wc * 64 + ni * 32 + r_; brow[ni] = row * 128; bsw[ni] = (row >> 1) & 7; }
  for (int kt = 0; kt < nk; kt += 2) {
    {
    const int kk = (kt + 2 < nk ? kt + 2 : nk - 1) * 64;
    ra0 = *(const uint4*)(Ab + aoff[0] + kk);
    ra1 = *(const uint4*)(Ab + aoff[1] + kk);
    ra2 = *(const uint4*)(Ab + aoff[2] + kk);
    ra3 = *(const uint4*)(Ab + aoff[3] + kk);
    ra4 = *(const uint4*)(Ab + aoff[4] + kk);
    ra5 = *(const uint4*)(Ab + aoff[5] + kk);
    ra6 = *(const uint4*)(Ab + aoff[6] + kk);
    ra7 = *(const uint4*)(Ab + aoff[7] + kk);
    rb0 = *(const uint4*)(Bp + (size_t)(0) * ldb + kk);
    rb1 = *(const uint4*)(Bp + (size_t)(32) * ldb + kk);
    rb2 = *(const uint4*)(Bp + (size_t)(64) * ldb + kk);
    rb3 = *(const uint4*)(Bp + (size_t)(96) * ldb + kk);
    }
    SB();
    {
      bf16x8 fa[2][4], fb[2][2];
        { const int ch = 0 + h_;
#pragma unroll
          for (int mi = 0; mi < 4; ++mi) fa[0][mi] = *(const bf16x8*)(lds + 0 + arow[mi] + ((ch ^ asw[mi]) << 4));
#pragma unroll
          for (int ni = 0; ni < 2; ++ni) fb[0][ni] = *(const bf16x8*)(lds + 0 + 32768 + brow[ni] + ((ch ^ bsw[ni]) << 4));
        }
        { const int ch = 2 + h_;
#pragma unroll
          for (int mi = 0; mi < 4; ++mi) fa[1][mi] = *(const bf16x8*)(lds + 0 + arow[mi] + ((ch ^ asw[mi]) << 4));
#pragma unroll
          for (int ni = 0; ni < 2; ++ni) fb[1][ni] = *(const bf16x8*)(lds + 0 + 32768 + brow[ni] + ((ch ^ bsw[ni]) << 4));
        }
        SB();
#pragma unroll
        for (int mi = 0; mi < 4; ++mi)
#pragma unroll
          for (int ni = 0; ni < 2; ++ni) acc[mi][ni] = __builtin_amdgcn_mfma_f32_32x32x16_bf16(fa[0][mi], fb[0][ni], acc[mi][ni], 0, 0, 0);
        *(uint4*)(lds + 49152 + soff + 0) = rc0;
        *(uint4*)(lds + 49152 + soff + 4096) = rc1;
        *(uint4*)(lds + 49152 + soff + 8192) = rc2;
        SB();
        { const int ch = 4 + h_;
#pragma unroll
          for (int mi = 0; mi < 4; ++mi) fa[0][mi] = *(const bf16x8*)(lds + 0 + arow[mi] + ((ch ^ asw[mi]) << 4));
#pragma unroll
          for (int ni = 0; ni < 2; ++ni) fb[0][ni] = *(const bf16x8*)(lds + 0 + 32768 + brow[ni] + ((ch ^ bsw[ni]) << 4));
        }
        SB();
#pragma unroll
        for (int mi = 0; mi < 4; ++mi)
#pragma unroll
          for (int ni = 0; ni < 2; ++ni) acc[mi][ni] = __builtin_amdgcn_mfma_f32_32x32x16_bf16(fa[1][mi], fb[1][ni], acc[mi][ni], 0, 0, 0);
        *(uint4*)(lds + 49152 + soff + 12288) = rc3;
        *(uint4*)(lds + 49152 + soff + 16384) = rc4;
        *(uint4*)(lds + 49152 + soff + 20480) = rc5;
        SB();
        { const int ch = 6 + h_;
#pragma unroll
          for (int mi = 0; mi < 4; ++mi) fa[1][mi] = *(const bf16x8*)(lds + 0 + arow[mi] + ((ch ^ asw[mi]) << 4));
#pragma unroll
          for (int ni = 0; ni < 2; ++ni) fb[1][ni] = *(const bf16x8*)(lds + 0 + 32768 + brow[ni] + ((ch ^ bsw[ni]) << 4));
        }
        SB();
#pragma unroll
        for (int mi = 0; mi < 4; ++mi)
#pragma unroll
          for (int ni = 0; ni < 2; ++ni) acc[mi][ni] = __builtin_amdgcn_mfma_f32_32x32x16_bf16(fa[0][mi], fb[0][ni], acc[mi][ni], 0, 0, 0);
        *(uint4*)(lds + 49152 + soff + 24576) = rc6;
        *(uint4*)(lds + 49152 + soff + 28672) = rc7;
        *(uint4*)(lds + 49152 + 32768 + soff + 0) = rd0;
        SB();
        SB();
#pragma unroll
        for (int mi = 0; mi < 4; ++mi)
#pragma unroll
          for (int ni = 0; ni < 2; ++ni) acc[mi][ni] = __builtin_amdgcn_mfma_f32_32x32x16_bf16(fa[1][mi], fb[1][ni], acc[mi][ni], 0, 0, 0);
        *(uint4*)(lds + 49152 + 32768 + soff + 4096) = rd1;
        *(uint4*)(lds + 49152 + 32768 + soff + 8192) = rd2;
        *(uint4*)(lds + 49152 + 32768 + soff + 12288) = rd3;
        SB();
    }
    __syncthreads();
    {
    const int kk = (kt + 3 < nk ? kt + 3 : nk - 1) * 64;
    rc0 = *(const uint4*)(Ab + aoff[0] + kk);
    rc1 = *(const uint4*)(Ab + aoff[1] + kk);
    rc2 = *(const uint4*)(Ab + aoff[2] + kk);
    rc3 = *(const uint4*)(Ab + aoff[3] + kk);
    rc4 = *(const uint4*)(Ab + aoff[4] + kk);
    rc5 = *(const uint4*)(Ab + aoff[5] + kk);
    rc6 = *(const uint4*)(Ab + aoff[6] + kk);
    rc7 = *(const uint4*)(Ab + aoff[7] + kk);
    rd0 = *(const uint4*)(Bp + (size_t)(0) * ldb + kk);
    rd1 = *(const uint4*)(Bp + (size_t)(32) * ldb + kk);
    rd2 = *(const uint4*)(Bp + (size_t)(64) * ldb + kk);
    rd3 = *(const uint4*)(Bp + (size_t)(96) * ldb + kk);
    }
    SB();
    {
      bf16x8 fa[2][4], fb[2][2];
        { const int ch = 0 + h_;
#pragma unroll
          for (int mi = 0; mi < 4; ++mi) fa[0][mi] = *(const bf16x8*)(lds + 49152 + arow[mi] + ((ch ^ asw[mi]) << 4));
#pragma unroll
          for (int ni = 0; ni < 2; ++ni) fb[0][ni] = *(const bf16x8*)(lds + 49152 + 32768 + brow[ni] + ((ch ^ bsw[ni]) << 4));
        }
        { const int ch = 2 + h_;
#pragma unroll
          for (int mi = 0; mi < 4; ++mi) fa[1][mi] = *(const bf16x8*)(lds + 49152 + arow[mi] + ((ch ^ asw[mi]) << 4));
#pragma unroll
          for (int ni = 0; ni < 2; ++ni) fb[1][ni] = *(const bf16x8*)(lds + 49152 + 32768 + brow[ni] + ((ch ^ bsw[ni]) << 4));
        }
        SB();
#pragma unroll
        for (int mi = 0; mi < 4; ++mi)
#pragma unroll
          for (int ni = 0; ni < 2; ++ni) acc[mi][ni] = __builtin_amdgcn_mfma_f32_32x32x16_bf16(fa[0][mi], fb[0][ni], acc[mi][ni], 0, 0, 0);
        *(uint4*)(lds + 0 + soff + 0) = ra0;
        *(uint4*)(lds + 0 + soff + 4096) = ra1;
        *(uint4*)(lds + 0 + soff + 8192) = ra2;
        SB();
        { const int ch = 4 + h_;
#pragma unroll
          for (int mi = 0; mi < 4; ++mi) fa[0][mi] = *(const bf16x8*)(lds + 49152 + arow[mi] + ((ch ^ asw[mi]) << 4));
#pragma unroll
          for (int ni = 0; ni < 2; ++ni) fb[0][ni] = *(const bf16x8*)(lds + 49152 + 32768 + brow[ni] + ((ch ^ bsw[ni]) << 4));
        }
        SB();
#pragma unroll
        for (int mi = 0; mi < 4; ++mi)
#pragma unroll
          for (int ni = 0; ni < 2; ++ni) acc[mi][ni] = __builtin_amdgcn_mfma_f32_32x32x16_bf16(fa[1][mi], fb[1][ni], acc[mi][ni], 0, 0, 0);
        *(uint4*)(lds + 0 + soff + 12288) = ra3;
        *(uint4*)(lds + 0 + soff + 16384) = ra4;
        *(uint4*)(lds + 0 + soff + 20480) = ra5;
        SB();
        { const int ch = 6 + h_;
#pragma unroll
          for (int mi = 0; mi < 4; ++mi) fa[1][mi] = *(const bf16x8*)(lds + 49152 + arow[mi] + ((ch ^ asw[mi]) << 4));
#pragma unroll
          for (int ni = 0; ni < 2; ++ni) fb[1][ni] = *(const bf16x8*)(lds + 49152 + 32768 + brow[ni] + ((ch ^ bsw[ni]) << 4));
        }
        SB();
#pragma unroll
        for (int mi = 0; mi < 4; ++mi)
#pragma unroll
          for (int ni = 0; ni < 2; ++ni) acc[mi][ni] = __builtin_amdgcn_mfma_f32_32x32x16_bf16(fa[0][mi], fb[0][ni], acc[mi][ni], 0, 0, 0);
        *(uint4*)(lds + 0 + soff + 24576) = ra6;
        *(uint4*)(lds + 0 + soff + 28672) = ra7;
        *(uint4*)(lds + 0 + 32768 + soff + 0) = rb0;
        SB();
        SB();
#pragma unroll
        for (int mi = 0; mi < 4; ++mi)
#pragma unroll
          for (int ni = 0; ni < 2; ++ni) acc[mi][ni] = __builtin_amdgcn_mfma_f32_32x32x16_bf16(fa[1][mi], fb[1][ni], acc[mi][ni], 0, 0, 0);
        *(uint4*)(lds + 0 + 32768 + soff + 4096) = rb1;
        *(uint4*)(lds + 0 + 32768 + soff + 8192) = rb2;
        *(uint4*)(lds + 0 + 32768 + soff + 12288) = rb3;
        SB();
    }
    __syncthreads();
  }
  epi(acc, m0 + wr * 128, n0 + wc * 64, lane);
}

struct TDesc { const float* src; u16* dst; int K, N, lds, Kp, Np, mode; };
__device__ __forceinline__ TDesc get_tdesc(const P& p, int i, int zz) {
  TDesc d;
  d.mode = 0;
  char* ws = p.ws;
  switch (i) {
    case 0: d = {p.in[zz + I_WIN0], (u16*)(ws + W_IN0), 1024, 4632, 4632, 1024, 4736, 1}; break;
    case 1: d = {p.in[zz + I_WOUT0], (u16*)(ws + W_OUT0), 2048, 1024, 1024, 2048, 1024, 0}; break;
    case 2: d = {p.in[zz + I_GU], (u16*)(ws + W_GU), 1024, 5632, 5632, 1024, 5632, 2}; break;
    case 3: d = {p.in[zz + I_GU] + 1024ull * 5632, (u16*)(ws + W_GU + 5632ull * 1024 * 2), 1024, 5632, 5632, 1024, 5632, 2}; break;
    case 4: d = {p.in[zz + I_DN], (u16*)(ws + W_DN), 2816, 1024, 1024, 2816, 1024, 0}; break;
    case 5: d = {p.in[zz + I_DN] + 2816ull * 1024, (u16*)(ws + W_DN + 1024ull * 2816 * 2), 2816, 1024, 1024, 2816, 1024, 0}; break;
    case 6: d = {p.in[zz + I_WR], (u16*)(ws + W_R), 1024, 1024, 1024, 1024, 1024, 0}; break;
    case 7: d = {p.in[zz + I_WKK], (u16*)(ws + W_K), 1024, 1024, 1024, 1024, 1024, 0}; break;
    case 8: d = {p.in[zz + I_WVV], (u16*)(ws + W_V), 1024, 1024, 1024, 1024, 1024, 0}; break;
    case 9: d = {p.in[zz + I_WO], (u16*)(ws + W_O), 1024, 1024, 1024, 1024, 1024, 0}; break;
    case 10: d = {p.in[zz + I_W1], (u16*)(ws + W_W1), 1024, 64, 64, 1024, 128, 0}; break;
    case 11: d = {p.in[zz + I_A1], (u16*)(ws + W_A1), 1024, 64, 64, 1024, 128, 0}; break;
    case 12: d = {p.in[zz + I_G1], (u16*)(ws + W_G1), 1024, 160, 160, 1024, 256, 0}; break;
    case 13: d = {p.in[zz + I_W2], (u16*)(ws + W_W2), 64, 1024, 1024, 128, 1024, 0}; break;
    case 14: d = {p.in[zz + I_A2], (u16*)(ws + W_A2), 64, 1024, 1024, 128, 1024, 0}; break;
    default: d = {p.in[zz + I_G2], (u16*)(ws + W_G2), 160, 1024, 1024, 256, 1024, 0}; break;
  }
  return d;
}
__device__ __forceinline__ int tdesc_tiles(int i) {
  switch (i) {
    case 0: return 16 * 74;
    case 1: return 32 * 16;
    case 2: case 3: return 16 * 88;
    case 4: case 5: return 44 * 16;
    case 6: case 7: case 8: case 9: return 16 * 16;
    case 10: case 11: return 16 * 2;
    case 12: return 16 * 4;
    case 13: case 14: return 2 * 16;
    default: return 4 * 16;
  }
}
constexpr int PREP_TILES = 16 * 74 + 32 * 16 + 2 * 16 * 88 + 2 * 44 * 16 + 4 * 256 + 2 * 32 + 64 + 2 * 32 + 64;

__device__ __forceinline__ void rms_rows_bf16(const float* src_row, const float* g, u16* dst_row, int lane) {
  float4 v[4];
  float ss = 0.f;
#pragma unroll
  for (int i = 0; i < 4; ++i) {
    v[i] = ((const float4*)src_row)[lane + 64 * i];
    ss += v[i].x * v[i].x + v[i].y * v[i].y + v[i].z * v[i].z + v[i].w * v[i].w;
  }
  ss = wsum(ss);
  float rinv = rsqrtf(ss * (1.f / 1024.f) + EPS);
#pragma unroll
  for (int i = 0; i < 4; ++i) {
    float4 g4 = ((const float4*)g)[lane + 64 * i];
    uint2 o;
    o.x = pk2(v[i].x * rinv * g4.x, v[i].y * rinv * g4.y);
    o.y = pk2(v[i].z * rinv * g4.z, v[i].w * rinv * g4.w);
    ((uint2*)dst_row)[lane + 64 * i] = o;
  }
}

__device__ __forceinline__ void rms_rows2_bf16(const float* sa, const float* sb, const float* g, u16* da, u16* db, bool hasb, int lane) {
  float4 va[4], vb[4];
  float ssa = 0.f, ssb = 0.f;
#pragma unroll
  for (int i = 0; i < 4; ++i) { va[i] = ((const float4*)sa)[lane + 64 * i]; vb[i] = ((const float4*)sb)[lane + 64 * i]; }
#pragma unroll
  for (int i = 0; i < 4; ++i) {
    ssa += va[i].x * va[i].x + va[i].y * va[i].y + va[i].z * va[i].z + va[i].w * va[i].w;
    ssb += vb[i].x * vb[i].x + vb[i].y * vb[i].y + vb[i].z * vb[i].z + vb[i].w * vb[i].w;
  }
  ssa = wsum(ssa); ssb = wsum(ssb);
  float ra = rsqrtf(ssa * (1.f / 1024.f) + EPS), rb = rsqrtf(ssb * (1.f / 1024.f) + EPS);
#pragma unroll
  for (int i = 0; i < 4; ++i) {
    float4 g4 = ((const float4*)g)[lane + 64 * i];
    uint2 o;
    o.x = pk2(va[i].x * ra * g4.x, va[i].y * ra * g4.y);
    o.y = pk2(va[i].z * ra * g4.z, va[i].w * ra * g4.w);
    ((uint2*)da)[lane + 64 * i] = o;
    if (hasb) {
      o.x = pk2(vb[i].x * rb * g4.x, vb[i].y * rb * g4.y);
      o.y = pk2(vb[i].z * rb * g4.z, vb[i].w * rb * g4.w);
      ((uint2*)db)[lane + 64 * i] = o;
    }
  }
}
__device__ __forceinline__ void phase_prep(const P& p, char* lds, int bid, int G) {
  float* tile = (float*)lds;
  const int total = PREP_TILES + TT / 8;
  for (int w = bid; w < total; w += G) {
    FRESH_TID(tid);
    const int zz = zof(w);
    const int lane = tid & 63, wid = tid >> 6;
    if (w < PREP_TILES) {
      int t = w, di = 0;
      for (; di < 16; ++di) {
        int n = tdesc_tiles(di);
        if (t < n) break;
        t -= n;
      }
      TDesc d = get_tdesc(p, di, zz);
      const int nkt = d.Kp >> 6;
      const int kt = t % nkt, nt = t / nkt;
      const int k0 = kt * 64, n0 = nt * 64;
      float vals[16];
#pragma unroll
      for (int i = 0; i < 16; ++i) {
        int kk = i * 4 + (tid >> 6), nn = tid & 63;
        int n = n0 + nn, k = k0 + kk, sc;
        if (d.mode == 0) sc = (n < d.N) ? n : -1;
        else if (d.mode == 1) sc = n < 3584 ? n : (n < 4608 ? 3600 + (n - 3584) : (n < 4624 ? 3584 + (n - 4608) : (n < 4632 ? n : -1)));
        else { int q = n >> 6, j = n & 63; sc = j < 32 ? q * 32 + j : 2816 + q * 32 + (j - 32); }
        const bool ok = (sc >= 0 && k < d.K);
        float v = d.src[ok ? (size_t)k * d.lds + sc : 0];
        vals[i] = ok ? v : 0.f;
      }
#pragma unroll
      for (int i = 0; i < 16; ++i) tile[(i * 4 + (tid >> 6)) * 65 + (tid & 63)] = vals[i];
      __syncthreads();
#pragma unroll
      for (int i = 0; i < 16; ++i) {
        int nn = i * 4 + (tid >> 6), kk = tid & 63;
        d.dst[(size_t)(n0 + nn) * d.Kp + k0 + kk] = f2bf(tile[kk * 65 + nn]);
      }
      __syncthreads();
    } else {
      int rowa = (w - PREP_TILES) * 8 + wid, rowb = rowa + 4;
      const float* sa = rowa < TP ? p.in[zz + I_XP] + (size_t)rowa * 1024 : p.in[zz + I_XS] + (size_t)(rowa - TP) * 1024;
      const float* sb = rowb < TP ? p.in[zz + I_XP] + (size_t)rowb * 1024 : p.in[zz + I_XS] + (size_t)(rowb - TP) * 1024;
      u16* xn = (u16*)(p.ws + B_A);
      rms_rows2_bf16(sa, sb, p.in[zz + I_NMIX], xn + (size_t)rowa * 1024, xn + (size_t)rowb * 1024, true, lane);
    }
  }
}

__device__ __forceinline__ bool tile_map(int q, int xcd, int MT, int NT, int& mt, int& nt) {
  int mi = q / NT;
  nt = q - mi * NT;
  mt = xcd + 8 * mi;
  return mt < MT;
}
template <class Epi>
__device__ __forceinline__ void gemm_phase(const u16* A, int lda, const u16* B, int ldb, int K, int MT, int NT, char* lds, int bid, int G, const Epi& epi) {
  const int xcd = bid & 7, j = bid >> 3, nb = G >> 3;
  const int nq = ((MT + 7) >> 3) * NT;
  for (int q = j; q < nq; q += nb) {
    int mt, nt;
    if (!tile_map(q, xcd, MT, NT, mt, nt)) break;
    gemm_tile(A, lda, B, ldb, K, mt * 256, nt * 128, lds, epi);
  }
}

struct EpiProj {
  u16* proj; float* small;
  __device__ __forceinline__ void init(f32x16 (&acc)[4][2], int, int, int) const { zero_acc<4, 2>(acc); }
  __device__ __forceinline__ void operator()(f32x16 (&acc)[4][2], int r0, int c0, int lane) const {
#pragma unroll
    for (int mi = 0; mi < 4; ++mi)
#pragma unroll
      for (int ni = 0; ni < 2; ++ni) {
        int col = c0 + ni * 32 + (lane & 31);
#pragma unroll
        for (int i = 0; i < 16; ++i) {
          int row = r0 + mi * 32 + ACC_ROW(i, lane);
          if (row >= TT) continue;
          float v = acc[mi][ni][i];
          if (col < PJ) proj[(size_t)row * PJ + col] = f2bf(v);
          else if (col < PJ + 32) small[(size_t)row * 32 + (col - PJ)] = v;
        }
      }
  }
};
struct EpiRes {
  const float* res; const float* res2; float* out;
  __device__ __forceinline__ void init(f32x16 (&acc)[4][2], int r0, int c0, int lane) const {
#pragma unroll
    for (int mi = 0; mi < 4; ++mi)
#pragma unroll
      for (int ni = 0; ni < 2; ++ni) {
        int col = c0 + ni * 32 + (lane & 31);
#pragma unroll
        for (int i = 0; i < 16; ++i) {
          int row = r0 + mi * 32 + ACC_ROW(i, lane);
          float rv = 0.f;
          if (row < TP) rv = res[(size_t)row * 1024 + col];
          else if (row < TT) rv = res2[(size_t)(row - TP) * 1024 + col];
          acc[mi][ni][i] = rv;
        }
      }
  }
  __device__ __forceinline__ void operator()(f32x16 (&acc)[4][2], int r0, int c0, int lane) const {
#pragma unroll
    for (int mi = 0; mi < 4; ++mi)
#pragma unroll
      for (int ni = 0; ni < 2; ++ni) {
        int col = c0 + ni * 32 + (lane & 31);
#pragma unroll
        for (int i = 0; i < 16; ++i) {
          int row = r0 + mi * 32 + ACC_ROW(i, lane);
          if (row >= TT) continue;
          out[(size_t)row * 1024 + col] = acc[mi][ni][i];
        }
      }
  }
};
struct EpiSwiglu {
  u16* hb;
  __device__ __forceinline__ void init(f32x16 (&acc)[4][2], int, int, int) const { zero_acc<4, 2>(acc); }
  __device__ __forceinline__ void operator()(f32x16 (&acc)[4][2], int r0, int c0, int lane) const {
    int col = (c0 >> 1) + (lane & 31);
#pragma unroll
    for (int mi = 0; mi < 4; ++mi)
#pragma unroll
      for (int i = 0; i < 16; ++i) {
        int row = r0 + mi * 32 + ACC_ROW(i, lane);
        if (row >= TT) continue;
        float g = acc[mi][0][i], u = acc[mi][1][i];
        hb[(size_t)row * 2816 + col] = f2bf(g * sigmoidf(g) * u);
      }
  }
};
struct EpiAct {
  u16* out; int ldo; int nvalid; int nstore; int act;
  __device__ __forceinline__ void init(f32x16 (&acc)[4][2], int, int, int) const { zero_acc<4, 2>(acc); }
  __device__ __forceinline__ void operator()(f32x16 (&acc)[4][2], int r0, int c0, int lane) const {
#pragma unroll
    for (int mi = 0; mi < 4; ++mi)
#pragma unroll
      for (int ni = 0; ni < 2; ++ni) {
        int col = c0 + ni * 32 + (lane & 31);
        if (col >= nstore) continue;
#pragma unroll
        for (int i = 0; i < 16; ++i) {
          int row = r0 + mi * 32 + ACC_ROW(i, lane);
          if (row >= TT) continue;
          float v = acc[mi][ni][i];
          if (act == 1) v = tanhf(v);
          else if (act == 2) v = sigmoidf(v);
          if (col >= nvalid) v = 0.f;
          out[(size_t)row * ldo + col] = f2bf(v);
        }
      }
  }
};
struct EpiLora2 {
  int which; const float* bias; float* outf; u16* outb;
  __device__ __forceinline__ void init(f32x16 (&acc)[4][2], int, int, int) const { zero_acc<4, 2>(acc); }
  __device__ __forceinline__ void operator()(f32x16 (&acc)[4][2], int r0, int c0, int lane) const {
#pragma unroll
    for (int mi = 0; mi < 4; ++mi)
#pragma unroll
      for (int ni = 0; ni < 2; ++ni) {
        int col = c0 + ni * 32 + (lane & 31);
        float bv = which < 2 ? bias[col] : 0.f;
#pragma unroll
        for (int i = 0; i < 16; ++i) {
          int row = r0 + mi * 32 + ACC_ROW(i, lane);
          if (row >= TT) continue;
          float v = acc[mi][ni][i] + bv;
          if (which == 0) {
            outf[(size_t)row * 1024 + col] = __expf(-0.60653065971f * sigmoidf(v));
          } else if (which == 1) {
            outb[(size_t)row * 1024 + col] = f2bf(sigmoidf(v));
          } else {
            outb[(size_t)row * 1024 + col] = f2bf(v);
          }
        }
      }
  }
};

__device__ __forceinline__ void phase_conv(const P& p, char* lds, int bid, int G) {
  const u16* proj = (const u16*)(p.ws + B_PROJ);
  const float* small = (const float*)(p.ws + B_SMALL);
  u16* xs = (u16*)(p.ws + B_A);
  u16* Bm = (u16*)(p.ws + B_BM);
  u16* Cm = (u16*)(p.ws + B_CM);
  u16* xm = (u16*)(p.ws + B_XM);
  const int zz0 = zof(bid);
  const float* cw = p.in[zz0 + I_CONVW];
  const float* cb = p.in[zz0 + I_CONVB];
  const int n_conv = TT / 4;
  const int n_gate = (512 + 2048) / 4;
  for (int w = bid; w < n_conv + n_gate; w += G) {
    FRESH_TID(tid);
    const int zz = zof(w);
    const int lane = tid & 63, wid = tid >> 6;
    if (w < n_conv) {
#pragma unroll
      for (int k_ = 0; k_ < 5; ++k_) {
        const int i = tid + k_ * 256;
        int r4 = i / 320, cgp = i % 320;
        int row = w * 4 + r4, c0 = cgp * 8;
        float u[4][8];
        if (row < TP) {
          int t = row & 2047;
#pragma unroll
          for (int j = 0; j < 4; ++j) {
            int tt = t - 3 + j;
            if (tt >= 0) {
              uint4 q = *(const uint4*)(proj + (size_t)(row - 3 + j) * PJ + 1024 + c0);
              unpack8(q, u[j]);
            } else {
#pragma unroll
              for (int e = 0; e < 8; ++e) u[j][e] = 0.f;
            }
          }
          if (t >= 2045) {
            int b = row >> 11;
            float* o = p.out + O_CONVP + ((size_t)(b * 3 + (t - 2045)) * 2560 + c0);
#pragma unroll
            for (int e = 0; e < 8; ++e) o[e] = u[3][e];
          }
        } else {
          int bs = row - TP;
#pragma unroll
          for (int j = 0; j < 3; ++j) {
            const float* s = p.in[zz + I_SCONV] + ((size_t)(bs * 3 + j) * 2560 + c0);
#pragma unroll
            for (int e = 0; e < 8; ++e) u[j][e] = s[e];
          }
          uint4 q = *(const uint4*)(proj + (size_t)row * PJ + 1024 + c0);
          unpack8(q, u[3]);
          float* o = p.out + O_CONVS + ((size_t)(bs * 3) * 2560 + c0);
#pragma unroll
          for (int e = 0; e < 8; ++e) { o[e] = u[1][e]; o[2560 + e] = u[2][e]; o[5120 + e] = u[3][e]; }
        }
        float a[8];
#pragma unroll
        for (int e = 0; e < 8; ++e) {
          float v = cb[c0 + e];
#pragma unroll
          for (int j = 0; j < 4; ++j) v += u[j][e] * cw[j * 2560 + c0 + e];
          a[e] = v * sigmoidf(v);
        }
        uint4 o = pack8(a);
        u16* dst;
        if (c0 < 1024) dst = xs + (size_t)row * 1024 + c0;
        else if (c0 < 1280) dst = Bm + (size_t)row * 256 + (c0 - 1024);
        else if (c0 < 1536) dst = Cm + (size_t)row * 256 + (c0 - 1280);
        else dst = xm + (size_t)row * 1024 + (c0 - 1536);
        *(uint4*)dst = o;
      }
    } else {
      int wi = (w - n_conv) * 4 + wid;
      int t0 = 2 * lane;
      if (wi < 512) {
        int c = wi & 15, h = (wi >> 4) & 3, b = wi >> 6;
        int row0 = b * 2048 + c * 128;
        float fb = p.in[zz + I_FB][h], ib = p.in[zz + I_IB][h];
        float f0 = small[(size_t)(row0 + t0) * 32 + 20 + h] + fb, f1 = small[(size_t)(row0 + t0 + 1) * 32 + 20 + h] + fb;
        float i0 = small[(size_t)(row0 + t0) * 32 + 16 + h] + ib, i1 = small[(size_t)(row0 + t0 + 1) * 32 + 16 + h] + ib;
        float lf0 = -softplusf(-f0), lf1 = -softplusf(-f1);
        float inc = wscan(lf0 + lf1, lane);
        float bc1 = inc, bc0 = inc - lf1;
        float uu = wmax(fmaxf(i0 - bc0, i1 - bc1));
        float bend = __shfl(inc, 63);
        float* bcum = (float*)(p.ws + M_BCUM);
        float* li = (float*)(p.ws + M_LI);
        bcum[(size_t)(row0 + t0) * 4 + h] = bc0; bcum[(size_t)(row0 + t0 + 1) * 4 + h] = bc1;
        li[(size_t)(row0 + t0) * 4 + h] = i0; li[(size_t)(row0 + t0 + 1) * 4 + h] = i1;
        if (lane == 0) {
          float* gs = (float*)(p.ws + M_GSUM) + (size_t)((b * 4 + h) * 16 + c) * 2;
          gs[0] = bend; gs[1] = uu;
        }
      } else {
        int x = wi - 512;
        int h = x & 15, c = (x >> 4) & 15, b = x >> 8;
        int row0 = b * 2048 + c * 128;
        float db = p.in[zz + I_DTB][h], an = -__expf(p.in[zz + I_ALOG][h]);
        float d0 = softplusf(small[(size_t)(row0 + t0) * 32 + h] + db), d1 = softplusf(small[(size_t)(row0 + t0 + 1) * 32 + h] + db);
        float inc = wscan((d0 + d1) * an, lane);
        float* dt = (float*)(p.ws + M_DT);
        float* ac = (float*)(p.ws + M_ACUM);
        dt[(size_t)(row0 + t0) * 16 + h] = d0; dt[(size_t)(row0 + t0 + 1) * 16 + h] = d1;
        ac[(size_t)(row0 + t0) * 16 + h] = inc - d1 * an; ac[(size_t)(row0 + t0 + 1) * 16 + h] = inc;
      }
    }
  }
}

__device__ __forceinline__ void blockdiag8(const float* x, const float* __restrict__ w, int ch0, float scale, float* o) {
  const float4* w4 = (const float4*)(w + (size_t)(ch0 >> 2) * 16);
#pragma unroll
  for (int blk = 0; blk < 2; ++blk) {
    float4 r0 = w4[blk * 4 + 0], r1 = w4[blk * 4 + 1], r2 = w4[blk * 4 + 2], r3 = w4[blk * 4 + 3];
    const float* xx = x + blk * 4;
    o[blk * 4 + 0] = (xx[0] * r0.x + xx[1] * r1.x + xx[2] * r2.x + xx[3] * r3.x) * scale;
    o[blk * 4 + 1] = (xx[0] * r0.y + xx[1] * r1.y + xx[2] * r2.y + xx[3] * r3.y) * scale;
    o[blk * 4 + 2] = (xx[0] * r0.z + xx[1] * r1.z + xx[2] * r2.z + xx[3] * r3.z) * scale;
    o[blk * 4 + 3] = (xx[0] * r0.w + xx[1] * r1.w + xx[2] * r2.w + xx[3] * r3.w) * scale;
  }
}
__device__ __forceinline__ void mchain(const float* gs  , int c, float& mc, float& mn, float& bend) {
  float m = 0.f;
  for (int j = 0; j < c; ++j) m = gs[j * 2] + fmaxf(m, gs[j * 2 + 1]);
  mc = m;
  bend = gs[c * 2];
  mn = bend + fmaxf(m, gs[c * 2 + 1]);
}

__device__ __forceinline__ void img_put_t(char* img, int R, int j0, int s, const float* v) {
  char* pb = img + (s >> 6) * (R * 128);
#pragma unroll
  for (int e = 0; e < 8; ++e) *(u16*)(pb + img_off(j0 + e, s & 63)) = f2bf(v[e]);
}

__device__ __forceinline__ void phase_chunkstate(const P& p, char* lds, int bid, int G) {
  const u16* proj = (const u16*)(p.ws + B_PROJ);
  const float* small = (const float*)(p.ws + B_SMALL);
  const u16* xs = (const u16*)(p.ws + B_A);
  const u16* Bm = (const u16*)(p.ws + B_BM);
  const u16* Cm = (const u16*)(p.ws + B_CM);
  const u16* xm = (const u16*)(p.ws + B_XM);
  u16* mix = (u16*)(p.ws + B_MIX);
  char* R0 = lds;
  char* R1 = lds + 32768;
  float* ex = (float*)(lds + 65536);
  for (int w = bid; w < 2048; w += G) {
    FRESH_TID(tid);
    const int zz = zof(w);
    const int lane = tid & 63, wid = tid >> 6;
    if (w < 512) {
      const int bs = w >> 2, h = w & 3, row = TP + bs;
      float* sq = ex; float* sk = ex + 256; float* sv = ex + 512; float* scr = ex + 768;
      {
        int d = tid, cb4 = d & ~3, ci = d & 3;
        int nb = (h * 256 + cb4) >> 2;
        float q = 0.f, k = 0.f, v = 0.f;
#pragma unroll
        for (int c = 0; c < 4; ++c) {
          float xa = bf2f(xm[(size_t)row * 1024 + h * 256 + cb4 + c]);
          float xr = bf2f(proj[(size_t)row * PJ + 2560 + h * 256 + cb4 + c]);
          q += xa * p.in[zz + I_WQ][nb * 16 + c * 4 + ci];
          k += xa * p.in[zz + I_WK][nb * 16 + c * 4 + ci];
          v += xr * p.in[zz + I_WV][nb * 16 + c * 4 + ci];
        }
        sq[d] = q; sk[d] = k * 0.0625f; sv[d] = v;
      }
      float lf = -softplusf(-(small[(size_t)row * 32 + 20 + h] + p.in[zz + I_FB][h]));
      float li = small[(size_t)row * 32 + 16 + h] + p.in[zz + I_IB][h];
      float m = p.in[zz + I_SMM][bs * 4 + h];
      float mnew = fmaxf(lf + m, li);
      float wsc = __expf(li - mnew), dc = __expf(lf + m - mnew);
      __syncthreads();
      float nn = dc * p.in[zz + I_SMN][(size_t)(bs * 4 + h) * 256 + tid] + wsc * sk[tid];
      p.out[O_MNS + (size_t)(bs * 4 + h) * 256 + tid] = nn;
      float den = bsum(sq[tid] * nn, scr);
      const float* C = p.in[zz + I_SMC] + (size_t)(bs * 4 + h) * 65536 + tid;
      float* Co = p.out + O_MCS + (size_t)(bs * 4 + h) * 65536 + tid;
      float vv = sv[tid] * wsc, num = 0.f;
      for (int d0 = 0; d0 < 256; d0 += 32) {
        float c[32];
#pragma unroll
        for (int e = 0; e < 32; ++e) c[e] = C[(size_t)(d0 + e) * 256];
#pragma unroll
        for (int e = 0; e < 32; ++e) {
          float cn = dc * c[e] + sk[d0 + e] * vv;
          num += sq[d0 + e] * cn;
          Co[(size_t)(d0 + e) * 256] = cn;
        }
      }
      float hv = num / fmaxf(fabsf(den), __expf(-mnew));
      float ss = bsum(hv * hv, scr);
      float rinv = rsqrtf(ss * (1.f / 256.f) + EPS);
      int ch = h * 256 + tid;
      float xa = bf2f(xm[(size_t)row * 1024 + ch]);
      float op = bf2f(proj[(size_t)row * PJ + 3584 + ch]);
      float hm = (hv * rinv * p.in[zz + I_MLN][ch] + p.in[zz + I_MLS][ch] * xa) * sigmoidf(op);
      mix[(size_t)row * 2048 + 1024 + ch] = f2bf(hm);
      if (tid == 0) p.out[O_MMS + bs * 4 + h] = mnew;
      __syncthreads();
    } else if (w < 768) {
      const int x = w - 512, bs = x >> 1, g = x & 1, row = TP + bs;
      float* yz = ex; float* scr = ex + 512;
      const int pp = tid >> 2, nq = tid & 3, n0 = nq * 32;
      _Pragma("unroll 1")
      for (int h8 = 0; h8 < 8; ++h8) {
        int h = g * 8 + h8;
        float dtv = softplusf(small[(size_t)row * 32 + h] + p.in[zz + I_DTB][h]);
        float dec = __expf(-dtv * __expf(p.in[zz + I_ALOG][h]));
        float xv = bf2f(xs[(size_t)row * 1024 + h * 64 + pp]);
        const float* st = p.in[zz + I_SSSM] + ((size_t)((bs * 16 + h) * 64 + pp)) * 128 + n0;
        float* so = p.out + O_SSMS + ((size_t)((bs * 16 + h) * 64 + pp)) * 128 + n0;
        float ys = 0.f, dx = dtv * xv;
#pragma unroll
        for (int j = 0; j < 8; ++j) {
          float4 s4 = *(const float4*)(st + j * 4);
          uint2 b2 = *(const uint2*)(Bm + (size_t)row * 256 + g * 128 + n0 + j * 4);
          uint2 c2 = *(const uint2*)(Cm + (size_t)row * 256 + g * 128 + n0 + j * 4);
          float4 o;
          o.x = dec * s4.x + dx * lo2f(b2.x); o.y = dec * s4.y + dx * hi2f(b2.x);
          o.z = dec * s4.z + dx * lo2f(b2.y); o.w = dec * s4.w + dx * hi2f(b2.y);
          ys += o.x * lo2f(c2.x) + o.y * hi2f(c2.x) + o.z * lo2f(c2.y) + o.w * hi2f(c2.y);
          *(float4*)(so + j * 4) = o;
        }
        ys += __shfl_xor(ys, 1);
        ys += __shfl_xor(ys, 2);
        if (nq == 0) {
          float z = bf2f(proj[(size_t)row * PJ + h * 64 + pp]);
          yz[h8 * 64 + pp] = (ys + p.in[zz + I_SSDD][h] * xv) * z * sigmoidf(z);
        }
      }
      __syncthreads();
      float a0 = yz[tid], a1 = yz[tid + 256];
      float ss = bsum(a0 * a0 + a1 * a1, scr);
      float rinv = rsqrtf(ss * (1.f / 512.f) + EPS);
      mix[(size_t)row * 2048 + g * 512 + tid] = f2bf(a0 * rinv * p.in[zz + I_SSDN][g * 512 + tid]);
      mix[(size_t)row * 2048 + g * 512 + tid + 256] = f2bf(a1 * rinv * p.in[zz + I_SSDN][g * 512 + tid + 256]);
      __syncthreads();
    } else if (w < 1024) {
      const int x = w - 768, g = x & 1, c = (x >> 1) & 15, b = x >> 5;
      const int rowbase = b * 2048 + c * 128;
      const float* dt = (const float*)(p.ws + M_DT);
      const float* ac = (const float*)(p.ws + M_ACUM);
      float* sWe = ex;
      for (int i = tid; i < 1024; i += 256) {
        int h8 = i >> 7, s = i & 127, h = g * 8 + h8;
        float al = ac[(size_t)(rowbase + 127) * 16 + h];
        sWe[i] = __expf(al - ac[(size_t)(rowbase + s) * 16 + h]) * dt[(size_t)(rowbase + s) * 16 + h];
      }
      _Pragma("unroll 4")
      for (int k_ = 0; k_ < (128 * 16) / 256; ++k_) { const int i = tid + k_ * 256;
        int jc = i & 15, s = i >> 4;
        uint4 q = *(const uint4*)(Bm + (size_t)(rowbase + s) * 256 + g * 128 + jc * 8);
        float v[8]; unpack8(q, v);
        img_put_t(R0, 128, jc * 8, s, v);
      }
      __syncthreads();
      _Pragma("unroll 1")
      for (int h8 = 0; h8 < 8; ++h8) {
        int h = g * 8 + h8;
        _Pragma("unroll")
        for (int k_ = 0; k_ < (128 * 8) / 256; ++k_) { const int i = tid + k_ * 256;
          int jc = i & 7, s = i >> 3;
          uint4 q = *(const uint4*)(xs + (size_t)(rowbase + s) * 1024 + h * 64 + jc * 8);
          float v[8]; unpack8(q, v);
          float sc = sWe[h8 * 128 + s];
#pragma unroll
          for (int e = 0; e < 8; ++e) v[e] *= sc;
          img_put_t(R1, 64, jc * 8, s, v);
        }
        __syncthreads();
        f32x16 acc[1][2];
        zero_acc<1, 2>(acc);
#pragma unroll
        for (int pn = 0; pn < 2; ++pn) mma_panel<1, 2>(acc, R1 + pn * 8192, (wid & 1) * 32, R0 + pn * 16384, (wid >> 1) * 64, lane);
        u16* dst = (u16*)(p.ws + B_SSDST) + ((size_t)((b * 16 + c) * 16 + h)) * 8192;
#pragma unroll
        for (int ni = 0; ni < 2; ++ni)
#pragma unroll
          for (int i = 0; i < 16; ++i) {
            int pr = (wid & 1) * 32 + ACC_ROW(i, lane), n = (wid >> 1) * 64 + ni * 32 + (lane & 31);
            dst[pr * 128 + n] = f2bf(acc[0][ni][i]);
          }
        __syncthreads();
      }
    } else {
      const int x = w - 1024, vh = x & 1, c = (x >> 1) & 15, h = (x >> 5) & 3, b = x >> 7;
      const int rowbase = b * 2048 + c * 128;
      const float* gs = (const float*)(p.ws + M_GSUM) + (size_t)(b * 4 + h) * 32;
      float mc, mn, bend;
      mchain(gs, c, mc, mn, bend);
      float* sWs = ex;
      const float* bcum = (const float*)(p.ws + M_BCUM);
      const float* li = (const float*)(p.ws + M_LI);
      if (tid < 128) sWs[tid] = __expf(bend - bcum[(size_t)(rowbase + tid) * 4 + h] + li[(size_t)(rowbase + tid) * 4 + h] - mn);
      _Pragma("unroll 4")
      for (int k_ = 0; k_ < (128 * 16) / 256; ++k_) { const int i = tid + k_ * 256;
        int jc = i & 15, s = i >> 4;
        int ch0 = h * 256 + vh * 128 + jc * 8;
        uint4 q = *(const uint4*)(proj + (size_t)(rowbase + s) * PJ + 2560 + ch0);
        float xv[8], v[8]; unpack8(q, xv);
        blockdiag8(xv, p.in[zz + I_WV], ch0, 1.f, v);
        img_put_t(R0, 128, jc * 8, s, v);
      }
      __syncthreads();
      _Pragma("unroll 1")
      for (int dh = 0; dh < 2; ++dh) {
        _Pragma("unroll 4")
        for (int k_ = 0; k_ < (128 * 16) / 256; ++k_) { const int i = tid + k_ * 256;
          int jc = i & 15, s = i >> 4;
          int ch0 = h * 256 + dh * 128 + jc * 8;
          uint4 q = *(const uint4*)(xm + (size_t)(rowbase + s) * 1024 + ch0);
          float xv[8], v[8]; unpack8(q, xv);
          blockdiag8(xv, p.in[zz + I_WK], ch0, 0.0625f * sWs[s], v);
          img_put_t(R1, 128, jc * 8, s, v);
        }
        __syncthreads();
        f32x16 acc[2][2];
        zero_acc<2, 2>(acc);
#pragma unroll
        for (int pn = 0; pn < 2; ++pn) mma_panel<2, 2>(acc, R0 + pn * 16384, (wid & 1) * 64, R1 + pn * 16384, (wid >> 1) * 64, lane);
        if (vh == 0) {
          int d = tid >> 1, hf = tid & 1;
          float s = 0.f;
          for (int k = 0; k < 64; ++k) s += bf2f(*(const u16*)(R1 + hf * 16384 + img_off(d, k)));
          s += __shfl_xor(s, 1);
          if (hf == 0) ((float*)(p.ws + M_MLN))[(size_t)((b * 4 + h) * 16 + c) * 256 + dh * 128 + d] = s;
        }
        u16* dst = (u16*)(p.ws + B_MLST) + ((size_t)((b * 4 + h) * 16 + c)) * 65536;
#pragma unroll
        for (int mi = 0; mi < 2; ++mi)
#pragma unroll
          for (int ni = 0; ni < 2; ++ni)
#pragma unroll
            for (int i = 0; i < 16; ++i) {
              int v = vh * 128 + (wid & 1) * 64 + mi * 32 + ACC_ROW(i, lane), d = dh * 128 + (wid >> 1) * 64 + ni * 32 + (lane & 31);
              dst[v * 256 + d] = f2bf(acc[mi][ni][i]);
            }
        __syncthreads();
      }
    }
  }
}

__device__ __forceinline__ void phase_scan(const P& p, char* lds, int bid, int G) {
  for (int w = bid; w < 1568; w += G) {
    FRESH_TID(tid);
    const int zz = zof(w);
    if (w < 512) {
      int e8 = w * 256 + tid;
      int n8 = e8 & 15, pp = (e8 >> 4) & 63, h = (e8 >> 10) & 15, b = e8 >> 14;
      const float* ac = (const float*)(p.ws + M_ACUM);
      u16* st = (u16*)(p.ws + B_SSDST);
      float cur[8];
#pragma unroll
      for (int e = 0; e < 8; ++e) cur[e] = 0.f;
      uint4 qa[16]; float da[16];
#pragma unroll
      for (int c = 0; c < 16; ++c) {
        qa[c] = *(const uint4*)(st + ((size_t)((b * 16 + c) * 16 + h)) * 8192 + pp * 128 + n8 * 8);
        da[c] = ac[(size_t)(b * 2048 + c * 128 + 127) * 16 + h];
      }
#pragma unroll
      for (int c = 0; c < 16; ++c) {
        u16* ptr = st + ((size_t)((b * 16 + c) * 16 + h)) * 8192 + pp * 128 + n8 * 8;
        float t[8]; unpack8(qa[c], t);
        *(uint4*)ptr = pack8(cur);
        float dec = __expf(da[c]);
#pragma unroll
        for (int e = 0; e < 8; ++e) cur[e] = dec * cur[e] + t[e];
      }
      float* o = p.out + O_SSMP + ((size_t)((b * 16 + h) * 64 + pp)) * 128 + n8 * 8;
      *(float4*)o = make_float4(cur[0], cur[1], cur[2], cur[3]);
      *(float4*)(o + 4) = make_float4(cur[4], cur[5], cur[6], cur[7]);
    } else if (w < 1536) {
      int e8 = (w - 512) * 256 + tid;
      int d8 = e8 & 31, v = (e8 >> 5) & 255, h = (e8 >> 13) & 3, b = e8 >> 15;
      const float* gs = (const float*)(p.ws + M_GSUM) + (size_t)(b * 4 + h) * 32;
      u16* st = (u16*)(p.ws + B_MLST);
      float cur[8];
#pragma unroll
      for (int e = 0; e < 8; ++e) cur[e] = 0.f;
      float m = 0.f;
      uint4 qa[16];
#pragma unroll
      for (int c = 0; c < 16; ++c) qa[c] = *(const uint4*)(st + ((size_t)((b * 4 + h) * 16 + c)) * 65536 + v * 256 + d8 * 8);
#pragma unroll
      for (int c = 0; c < 16; ++c) {
        u16* ptr = st + ((size_t)((b * 4 + h) * 16 + c)) * 65536 + v * 256 + d8 * 8;
        float t[8]; unpack8(qa[c], t);
        *(uint4*)ptr = pack8(cur);
        float be = gs[c * 2], mn = be + fmaxf(m, gs[c * 2 + 1]);
        float dc = __expf(be + m - mn);
        m = mn;
#pragma unroll
        for (int e = 0; e < 8; ++e) cur[e] = dc * cur[e] + t[e];
      }
      float* o = p.out + O_MCP + (size_t)(b * 4 + h) * 65536 + v;
#pragma unroll
      for (int e = 0; e < 8; ++e) o[(size_t)(d8 * 8 + e) * 256] = cur[e];
    } else {
      int bh = w - 1536, d = tid;
      const float* gs = (const float*)(p.ws + M_GSUM) + (size_t)bh * 32;
      float* nb = (float*)(p.ws + M_MLN) + (size_t)bh * 16 * 256;
      float cur = 0.f, m = 0.f;
      for (int c = 0; c < 16; ++c) {
        float t = nb[c * 256 + d];
        nb[c * 256 + d] = cur;
        float be = gs[c * 2], mn = be + fmaxf(m, gs[c * 2 + 1]);
        float dc = __expf(be + m - mn);
        m = mn;
        cur = dc * cur + t;
      }
      p.out[O_MNP + (size_t)bh * 256 + d] = cur;
      if (tid == 0) p.out[O_MMP + bh] = m;
    }
  }
}

__device__ __forceinline__ void phase_chunkout(const P& p, char* lds, int bid, int G) {
  const u16* proj = (const u16*)(p.ws + B_PROJ);
  const u16* xs = (const u16*)(p.ws + B_A);
  const u16* Bm = (const u16*)(p.ws + B_BM);
  const u16* Cm = (const u16*)(p.ws + B_CM);
  const u16* xm = (const u16*)(p.ws + B_XM);
  u16* mix = (u16*)(p.ws + B_MIX);
  char* R0 = lds;
  char* R1 = lds + 32768;
  float* ex = (float*)(lds + 65536);
  for (int w = bid; w < 1024; w += G) {
    FRESH_TID(tid);
    const int zz = zof(w);
    const int lane = tid & 63, wid = tid >> 6;
#if defined(P5_ONLY) && P5_ONLY == 2
    if (false) {
#elif defined(P5_ONLY) && P5_ONLY == 1
    if (true) {
#else
    if (w >= 512) {
#endif
      const int x = w - 512, th = x & 1, g = (x >> 1) & 1, c = (x >> 2) & 15, b = x >> 6;
      const int rowbase = b * 2048 + c * 128;
      const float* dt = (const float*)(p.ws + M_DT);
      const float* ac = (const float*)(p.ws + M_ACUM);
      float* sA = ex;
      float* sD = ex + 1024;
      float* sSq = ex + 2048;
      for (int i = tid; i < 1024; i += 256) {
        int h8 = i >> 7, s = i & 127, h = g * 8 + h8;
        sA[i] = ac[(size_t)(rowbase + s) * 16 + h];
        sD[i] = dt[(size_t)(rowbase + s) * 16 + h];
      }
      if (tid < 64) sSq[tid] = 0.f;
      _Pragma("unroll 4")
      for (int k_ = 0; k_ < (128 * 16) / 256; ++k_) { const int i = tid + k_ * 256;
        int kc = i & 15, r = i >> 4;
        uint4 q = *(const uint4*)(Bm + (size_t)(rowbase + r) * 256 + g * 128 + kc * 8);
        *(uint4*)(R0 + (kc >> 3) * 16384 + r * 128 + (((kc & 7) ^ ((r >> 1) & 7)) << 4)) = q;
      }
      _Pragma("unroll")
      for (int k_ = 0; k_ < (64 * 16) / 256; ++k_) { const int i = tid + k_ * 256;
        int kc = i & 15, r = i >> 4;
        uint4 q = *(const uint4*)(Cm + (size_t)(rowbase + th * 64 + r) * 256 + g * 128 + kc * 8);
        *(uint4*)(R1 + (kc >> 3) * 8192 + r * 128 + (((kc & 7) ^ ((r >> 1) & 7)) << 4)) = q;
      }
      __syncthreads();
      f32x16 cb[2][1];
      zero_acc<2, 1>(cb);
#pragma unroll
      for (int pn = 0; pn < 2; ++pn) mma_panel<2, 1>(cb, R1 + pn * 8192, 0, R0 + pn * 16384, wid * 32, lane);
      __syncthreads();
      _Pragma("unroll 1")
      for (int h8 = 0; h8 < 8; ++h8) {
        const int h = g * 8 + h8;
        u16 exs[16], ezs[16];
        {
          int pp = (wid >> 1) * 32 + (lane & 31), ch = h * 64 + pp;
#pragma unroll
          for (int i = 0; i < 16; ++i) {
            size_t row = rowbase + th * 64 + (wid & 1) * 32 + ACC_ROW(i, lane);
            exs[i] = xs[row * 1024 + ch];
            ezs[i] = proj[row * PJ + ch];
          }
        }
        {
          int s = wid * 32 + (lane & 31);
          float as = sA[h8 * 128 + s], ds = sD[h8 * 128 + s];
#pragma unroll
          for (int mi = 0; mi < 2; ++mi)
#pragma unroll
            for (int i = 0; i < 16; ++i) {
              int tl = mi * 32 + ACC_ROW(i, lane), t = th * 64 + tl;
              float v = (s <= t) ? __expf(sA[h8 * 128 + t] - as) * cb[mi][0][i] * ds : 0.f;
              *(u16*)(R0 + (s >> 6) * 8192 + img_off(tl, s & 63)) = f2bf(v);
              if ((i & 3) == 3) SB();
            }
        }
        _Pragma("unroll")
        for (int k_ = 0; k_ < (128 * 8) / 256; ++k_) { const int i = tid + k_ * 256;
          int jc = i & 7, s = i >> 3;
          uint4 q = *(const uint4*)(xs + (size_t)(rowbase + s) * 1024 + h * 64 + jc * 8);
          float v[8]; unpack8(q, v);
          img_put_t(R0 + 16384, 64, jc * 8, s, v);
        }
        {
          const u16* st = (const u16*)(p.ws + B_SSDST) + ((size_t)((b * 16 + c) * 16 + h)) * 8192;
          _Pragma("unroll")
          for (int k_ = 0; k_ < (64 * 16) / 256; ++k_) { const int i = tid + k_ * 256;
            int kc = i & 15, r = i >> 4;
            uint4 q = *(const uint4*)(st + r * 128 + kc * 8);
            *(uint4*)(R1 + 16384 + (kc >> 3) * 8192 + r * 128 + (((kc & 7) ^ ((r >> 1) & 7)) << 4)) = q;
          }
        }
        __syncthreads();
        f32x16 a1[1][1], a2[1][1];
        zero_acc<1, 1>(a1);
        zero_acc<1, 1>(a2);
#pragma unroll
        for (int pn = 0; pn < 2; ++pn) {
          mma_panel<1, 1>(a1, R0 + pn * 8192, (wid & 1) * 32, R0 + 16384 + pn * 8192, (wid >> 1) * 32, lane);
          mma_panel<1, 1>(a2, R1 + pn * 8192, (wid & 1) * 32, R1 + 16384 + pn * 8192, (wid >> 1) * 32, lane);
        }
        {
          int pp = (wid >> 1) * 32 + (lane & 31), ch = h * 64 + pp;
          float Dh = p.in[zz + I_SSDD][h];
#pragma unroll
          for (int i = 0; i < 16; ++i) {
            int tl = (wid & 1) * 32 + ACC_ROW(i, lane), t = th * 64 + tl;
            size_t row = rowbase + t;
            float y = a1[0][0][i] + __expf(sA[h8 * 128 + t]) * a2[0][0][i];
            float xv = bf2f(exs[i]);
            float z = bf2f(ezs[i]);
            float v = (y + Dh * xv) * z * sigmoidf(z);
            mix[row * 2048 + ch] = f2bf(v);
            if ((i & 3) == 3) SB();
          }
        }
        __syncthreads();
      }
      asm volatile("s_waitcnt vmcnt(0)" ::: "memory");
      __threadfence_block();
      __syncthreads();
      _Pragma("unroll 4")
      for (int tl = wid * 16; tl < wid * 16 + 16; ++tl) {
        size_t row = rowbase + th * 64 + tl;
        u16* ptr = mix + row * 2048 + g * 512 + lane * 8;
        float v[8]; unpack8(*(const uint4*)ptr, v);
        float sq = 0.f;
#pragma unroll
        for (int e = 0; e < 8; ++e) sq += v[e] * v[e];
        sq = wsum(sq);
        float rinv = rsqrtf(sq * (1.f / 512.f) + EPS);
        const float* gn = p.in[zz + I_SSDN] + g * 512 + lane * 8;
#pragma unroll
        for (int e = 0; e < 8; ++e) v[e] *= rinv * gn[e];
        *(uint4*)ptr = pack8(v);
      }
      __syncthreads();
    } else {
      const int c = w & 15, h = (w >> 4) & 3, b = w >> 6;
      const int rowbase = b * 2048 + c * 128;
      const float* gs = (const float*)(p.ws + M_GSUM) + (size_t)(b * 4 + h) * 32;
      float mc, mn, bend;
      mchain(gs, c, mc, mn, bend);
      float* sBc = ex;
      float* sLb = ex + 128;
      float* sMt = ex + 256;
      float* sWi = ex + 384;
      float* sDen = ex + 512;
      float* sQn = ex + 640;
      float* sSq = ex + 768;
      float* sN = ex + 896;
      const float* bcum = (const float*)(p.ws + M_BCUM);
      const float* li = (const float*)(p.ws + M_LI);
      if (tid < 128) {
        float bc = bcum[(size_t)(rowbase + tid) * 4 + h];
        sBc[tid] = bc;
        sLb[tid] = li[(size_t)(rowbase + tid) * 4 + h] - bc;
        sDen[tid] = 0.f; sQn[tid] = 0.f; sSq[tid] = 0.f;
      }
      sN[tid] = ((const float*)(p.ws + M_MLN))[(size_t)((b * 4 + h) * 16 + c) * 256 + tid];
      __syncthreads();
      if (tid < 128) {
        float pm = -INFINITY;
        for (int s = 0; s <= tid; ++s) pm = fmaxf(pm, sLb[s]);
        float inter = sBc[tid] + mc;
        float mt = fmaxf(inter, sBc[tid] + pm);
        sMt[tid] = mt;
        sWi[tid] = __expf(inter - mt);
      }
      __syncthreads();
      if (tid < 128) sBc[tid] -= sMt[tid];
      __syncthreads();
      f32x16 sa[2][2];
      zero_acc<2, 2>(sa);
      _Pragma("unroll 1")
      for (int dp = 0; dp < 4; ++dp) {
        _Pragma("unroll")
        for (int k_ = 0; k_ < (128 * 8) / 256; ++k_) { const int i = tid + k_ * 256;
          int kc = i & 7, r = i >> 3;
          int ch0 = h * 256 + dp * 64 + kc * 8;
          uint4 q = *(const uint4*)(xm + (size_t)(rowbase + r) * 1024 + ch0);
          float xv[8], qv[8], kv[8]; unpack8(q, xv);
          int so = r * 128 + ((kc ^ ((r >> 1) & 7)) << 4);
          blockdiag8(xv, p.in[zz + I_WK], ch0, 0.0625f, kv);
          *(uint4*)(R1 + 16384 + so) = pack8(kv);
          SB();
          blockdiag8(xv, p.in[zz + I_WQ], ch0, 1.f, qv);
          *(uint4*)(R1 + so) = pack8(qv);
          float qn = 0.f;
#pragma unroll
          for (int e = 0; e < 8; ++e) qn += qv[e] * sN[dp * 64 + kc * 8 + e];
          qn += __shfl_xor(qn, 1); qn += __shfl_xor(qn, 2); qn += __shfl_xor(qn, 4);
          if (kc == 0) sQn[r] += qn;
          SB();
        }
        __syncthreads();
        mma_panel<2, 2>(sa, R1, (wid & 1) * 64, R1 + 16384, (wid >> 1) * 64, lane);
        __syncthreads();
      }
#pragma unroll
      for (int mi = 0; mi < 2; ++mi)
#pragma unroll
        for (int ni = 0; ni < 2; ++ni) {
          int s = (wid >> 1) * 64 + ni * 32 + (lane & 31);
          float lb = sLb[s];
#pragma unroll
          for (int i = 0; i < 16; ++i) {
            int t = (wid & 1) * 64 + mi * 32 + ACC_ROW(i, lane);
            float v = (s <= t) ? sa[mi][ni][i] * __expf(sBc[t] + lb) : 0.f;
            *(u16*)(R0 + (s >> 6) * 16384 + img_off(t, s & 63)) = f2bf(v);
            if ((i & 3) == 3) SB();
          }
        }
      __syncthreads();
      if (tid < 128) {
        float sm = 0.f;
        _Pragma("unroll 4")
        for (int kc = 0; kc < 16; ++kc) {
          float v[8];
          unpack8(*(const uint4*)(R0 + (kc >> 3) * 16384 + tid * 128 + (((kc & 7) ^ ((tid >> 1) & 7)) << 4)), v);
#pragma unroll
          for (int e = 0; e < 8; ++e) sm += v[e];
        }
        float den = sm + sWi[tid] * sQn[tid];
#ifdef DBG_DEN1
        sDen[tid] = 1.f + 0.f * den;
#else
        sDen[tid] = 1.f / fmaxf(fabsf(den), __expf(-sMt[tid]));
#endif
      }
      __syncthreads();
      _Pragma("unroll 1")
      for (int vh = 0; vh < 2; ++vh) {
        f32x16 oa[2][2];
        zero_acc<2, 2>(oa);
        _Pragma("unroll 4")
        for (int k_ = 0; k_ < (128 * 16) / 256; ++k_) { const int i = tid + k_ * 256;
          int jc = i & 15, s = i >> 4;
          int ch0 = h * 256 + vh * 128 + jc * 8;
          uint4 q = *(const uint4*)(proj + (size_t)(rowbase + s) * PJ + 2560 + ch0);
          float xv[8], v[8]; unpack8(q, xv);
          blockdiag8(xv, p.in[zz + I_WV], ch0, 1.f, v);
          img_put_t(R1, 128, jc * 8, s, v);
        }
        __syncthreads();
#pragma unroll
        for (int pn = 0; pn < 2; ++pn) mma_panel<2, 2>(oa, R0 + pn * 16384, (wid & 1) * 64, R1 + pn * 16384, (wid >> 1) * 64, lane);
        __syncthreads();
        const u16* st = (const u16*)(p.ws + B_MLST) + ((size_t)((b * 4 + h) * 16 + c)) * 65536;
        _Pragma("unroll 1")
        for (int dp = 0; dp < DBG_DPN; ++dp) {
          _Pragma("unroll")
          for (int k_ = 0; k_ < (128 * 8) / 256; ++k_) { const int i = tid + k_ * 256;
            int kc = i & 7, r = i >> 3;
            int ch0 = h * 256 + dp * 64 + kc * 8;
            uint4 q = *(const uint4*)(xm + (size_t)(rowbase + r) * 1024 + ch0);
            float xv[8], qv[8]; unpack8(q, xv);
            blockdiag8(xv, p.in[zz + I_WQ], ch0, sWi[r], qv);
            int so = r * 128 + ((kc ^ ((r >> 1) & 7)) << 4);
            *(uint4*)(R1 + so) = pack8(qv);
            uint4 cq = *(const uint4*)(st + (size_t)(vh * 128 + r) * 256 + dp * 64 + kc * 8);
            *(uint4*)(R1 + 16384 + so) = cq;
          }
          __syncthreads();
          mma_panel<2, 2>(oa, R1, (wid & 1) * 64, R1 + 16384, (wid >> 1) * 64, lane);
          __syncthreads();
        }
#pragma unroll
        for (int mi = 0; mi < 2; ++mi)
#pragma unroll
          for (int ni = 0; ni < 2; ++ni) {
            int v = vh * 128 + (wid >> 1) * 64 + ni * 32 + (lane & 31);
#pragma unroll
            for (int i = 0; i < 16; ++i) {
              int t = (wid & 1) * 64 + mi * 32 + ACC_ROW(i, lane);
              float hv = oa[mi][ni][i] * sDen[t];
              mix[(size_t)(rowbase + t) * 2048 + 1024 + h * 256 + v] = f2bf(hv);
              if ((i & 3) == 3) SB();
            }
          }
      }
      asm volatile("s_waitcnt vmcnt(0)" ::: "memory");
      __threadfence_block();
      __syncthreads();
      _Pragma("unroll 4")
      for (int it = 0; it < DBG_NORM_IT; ++it) {
        int t = wid * 32 + it * 2 + (lane >> 5), cc = lane & 31;
        size_t row = rowbase + t;
        int ch = h * 256 + cc * 8;
        u16* ptr = mix + row * 2048 + 1024 + ch;
        float v[8], xa[8], op[8];
        unpack8(*(const uint4*)ptr, v);
        float sq = 0.f;
#pragma unroll
        for (int e = 0; e < 8; ++e) sq += v[e] * v[e];
#pragma unroll
        for (int m = 16; m >= 1; m >>= 1) sq += __shfl_xor(sq, m);
        float rinv = rsqrtf(sq * (1.f / 256.f) + EPS);
        unpack8(*(const uint4*)(xm + row * 1024 + ch), xa);
        unpack8(*(const uint4*)(proj + row * PJ + 3584 + ch), op);
#pragma unroll
        for (int e = 0; e < 8; ++e) v[e] = (v[e] * rinv * p.in[zz + I_MLN][ch + e] + p.in[zz + I_MLS][ch + e] * xa[e]) * sigmoidf(op[e]);
        *(uint4*)ptr = pack8(v);
      }
      __syncthreads();
    }
  }
}

__device__ __forceinline__ void phase_rms(const float* x, const float* g, u16* dst, int bid, int G) {
  for (int w = bid; w < TT / 4; w += 2 * G) {
    FRESH_TID(tid);
    const int lane = tid & 63, wid = tid >> 6;
    int rowa = w * 4 + wid;
    bool hasb = (w + G) < TT / 4;
    int rowb = hasb ? (w + G) * 4 + wid : rowa;
    rms_rows2_bf16(x + (size_t)rowa * 1024, x + (size_t)rowb * 1024, g, dst + (size_t)rowa * 1024, dst + (size_t)rowb * 1024, hasb, lane);
  }
}
__device__ __forceinline__ void phase_rms_final(const P& p, const float* x, int bid, int G) {
  const float* g = p.in[zof(bid) + I_NFIN];
  for (int w = bid; w < TT / 8; w += G) {
    FRESH_TID(tid);
    const int lane = tid & 63, wid = tid >> 6;
    int rowa = w * 8 + wid, rowb = rowa + 4;
    const float* sa = x + (size_t)rowa * 1024;
    const float* sb = x + (size_t)rowb * 1024;
    float4 va[4], vb[4];
    float ssa = 0.f, ssb = 0.f;
#pragma unroll
    for (int i = 0; i < 4; ++i) { va[i] = ((const float4*)sa)[lane + 64 * i]; vb[i] = ((const float4*)sb)[lane + 64 * i]; }
#pragma unroll
    for (int i = 0; i < 4; ++i) {
      ssa += va[i].x * va[i].x + va[i].y * va[i].y + va[i].z * va[i].z + va[i].w * va[i].w;
      ssb += vb[i].x * vb[i].x + vb[i].y * vb[i].y + vb[i].z * vb[i].z + vb[i].w * vb[i].w;
    }
    ssa = wsum(ssa); ssb = wsum(ssb);
    float ra = rsqrtf(ssa * (1.f / 1024.f) + EPS), rb = rsqrtf(ssb * (1.f / 1024.f) + EPS);
    float* oa = p.out + O_Y + (size_t)rowa * 1024;
    float* ob = p.out + O_Y + (size_t)rowb * 1024;
#pragma unroll
    for (int i = 0; i < 4; ++i) {
      float4 g4 = ((const float4*)g)[lane + 64 * i];
      ((float4*)oa)[lane + 64 * i] = make_float4(va[i].x * ra * g4.x, va[i].y * ra * g4.y, va[i].z * ra * g4.z, va[i].w * ra * g4.w);
      ((float4*)ob)[lane + 64 * i] = make_float4(vb[i].x * rb * g4.x, vb[i].y * rb * g4.y, vb[i].z * rb * g4.z, vb[i].w * rb * g4.w);
    }
  }
}
struct ShiftRow { float4 v[4], pv[4]; int mode; };
__device__ __forceinline__ void shift_load(ShiftRow& d, const P& p, int zz0, const float* x, int row, int lane) {
  const float* src = x + (size_t)row * 1024;
  const float* psrc;
  if (row < TP) { d.mode = ((row & 2047) == 0) ? 1 : 0; psrc = d.mode ? src : src - 1024; }
  else { d.mode = 2; psrc = p.in[zz0 + I_SSHIFT] + (size_t)(row - TP) * 1024; }
#pragma unroll
  for (int i = 0; i < 4; ++i) {
    d.v[i] = ((const float4*)src)[lane + 64 * i];
    d.pv[i] = ((const float4*)psrc)[lane + 64 * i];
  }
}
__device__ __forceinline__ void shift_finish(ShiftRow& d, const P& p, const float* g, const float* mu, int row, int lane) {
  float ss = 0.f, ps = 0.f;
#pragma unroll
  for (int i = 0; i < 4; ++i) {
    if (d.mode == 1) d.pv[i] = make_float4(0.f, 0.f, 0.f, 0.f);
    ss += d.v[i].x * d.v[i].x + d.v[i].y * d.v[i].y + d.v[i].z * d.v[i].z + d.v[i].w * d.v[i].w;
    ps += d.pv[i].x * d.pv[i].x + d.pv[i].y * d.pv[i].y + d.pv[i].z * d.pv[i].z + d.pv[i].w * d.pv[i].w;
  }
  ss = wsum(ss); ps = wsum(ps);
  float rinv = rsqrtf(ss * (1.f / 1024.f) + EPS);
  float pinv = rsqrtf(ps * (1.f / 1024.f) + EPS);
#pragma unroll
  for (int i = 0; i < 4; ++i) {
    float4 g4 = ((const float4*)g)[lane + 64 * i];
    float xn[4] = {d.v[i].x * rinv * g4.x, d.v[i].y * rinv * g4.y, d.v[i].z * rinv * g4.z, d.v[i].w * rinv * g4.w};
    float xp[4];
    if (d.mode == 0) { xp[0] = d.pv[i].x * pinv * g4.x; xp[1] = d.pv[i].y * pinv * g4.y; xp[2] = d.pv[i].z * pinv * g4.z; xp[3] = d.pv[i].w * pinv * g4.w; }
    else { xp[0] = d.pv[i].x; xp[1] = d.pv[i].y; xp[2] = d.pv[i].z; xp[3] = d.pv[i].w; }
    int col = (lane + 64 * i) * 4;
    if (row >= TP) *(float4*)(p.out + O_SHS + (size_t)(row - TP) * 1024 + col) = make_float4(xn[0], xn[1], xn[2], xn[3]);
    else if ((row & 2047) == 2047) *(float4*)(p.out + O_SHP + (size_t)(row >> 11) * 1024 + col) = make_float4(xn[0], xn[1], xn[2], xn[3]);
#pragma unroll
    for (int c = 0; c < 6; ++c) {
      float4 m4 = *(const float4*)(mu + c * 1024 + col);
      uint2 o;
      o.x = pk2(xn[0] + (xp[0] - xn[0]) * m4.x, xn[1] + (xp[1] - xn[1]) * m4.y);
      o.y = pk2(xn[2] + (xp[2] - xn[2]) * m4.z, xn[3] + (xp[3] - xn[3]) * m4.w);
      size_t base = (c < 5) ? (3 * U + (size_t)c * U) : B_A;
      *(uint2*)((u16*)(p.ws + base) + (size_t)row * 1024 + col) = o;
    }
  }
}
__device__ __forceinline__ void phase_rms_shift(const P& p, const float* x, int bid, int G) {
  const int zz0 = zof(bid);
  const float* g = p.in[zz0 + I_NMIX] + 1024;
  const float* mu = p.in[zz0 + I_MU];
  for (int w = bid; w < TT / 8; w += G) {
    FRESH_TID(tid);
    const int lane = tid & 63, wid = tid >> 6;
    int rowa = w * 8 + wid, rowb = rowa + 4;
    ShiftRow da, db;
    shift_load(da, p, zz0, x, rowa, lane);
    shift_load(db, p, zz0, x, rowb, lane);
    shift_finish(da, p, g, mu, rowa, lane);
    shift_finish(db, p, g, mu, rowb, lane);
  }
}

__device__ __forceinline__ void phase_wkv(const P& p, char* lds, int bid, int G) {
  const u16* rb = (const u16*)(p.ws + B_RB);
  const u16* kb = (const u16*)(p.ws + B_KB);
  const u16* vb = (const u16*)(p.ws + B_VB);
  const u16* ab = (const u16*)(p.ws + B_AB);
  const float* dec = (const float*)(p.ws + B_DEC);
  float* yraw = (float*)(p.ws + B_YRAW);
  float* buf = (float*)lds;
  for (int w = bid; w < 768; w += G) {
#ifdef DBG_SKIP_PROMPT
    if (w < 256) continue;
#endif
    FRESH_TID(tid);
    const int zz = zof(w);
    const int lane = tid & 63, wid = tid >> 6;
    if (w < 256) {
      const int half = w & 1, h = (w >> 1) & 15, b = w >> 5;
      const int j = lane & 7, vrow = half * 32 + wid * 8 + (lane >> 3);
      const int tl = tid >> 4, sub = tid & 15, ch = h * 64 + sub * 4;
      float S[8];
#pragma unroll
      for (int i = 0; i < 8; ++i) S[i] = 0.f;
      float kkw[4], kaw[4];
#pragma unroll
      for (int e = 0; e < 4; ++e) { kkw[e] = p.in[zz + I_KK][ch + e]; kaw[e] = p.in[zz + I_KA][ch + e]; }
      uint2 lr, lk, lv, la; float4 lw;
      auto gload = [&](int tc) {
        size_t o = (size_t)(b * 2048 + tc * 16 + tl) * 1024 + ch;
#ifdef DBG_SYNTH
        { const float* xp = p.in[zz + I_XP] + o; float4 t4 = *(const float4*)xp;
          lr.x = pk2(t4.x, t4.y); lr.y = pk2(t4.z, t4.w); lk = lr; lv = lr; la.x = pk2(0.5f, 0.4f); la.y = pk2(0.6f, 0.5f);
          lw = make_float4(0.9f, 0.95f, 0.99f, 0.8f); }
#else
        lr = *(const uint2*)(rb + o); lk = *(const uint2*)(kb + o); lv = *(const uint2*)(vb + o); la = *(const uint2*)(ab + o);
        lw = *(const float4*)(dec + o);
#endif
      };
      auto lstore = [&](int bi) {
        float* tb = buf + bi * 6144 + tl * 384 + sub * 4;
        float k[4] = {lo2f(lk.x), hi2f(lk.x), lo2f(lk.y), hi2f(lk.y)};
        float a[4] = {lo2f(la.x), hi2f(la.x), lo2f(la.y), hi2f(la.y)};
        float kk[4], n2 = 0.f;
#pragma unroll
        for (int e = 0; e < 4; ++e) { kk[e] = k[e] * kkw[e]; n2 += kk[e] * kk[e]; }
        n2 += __shfl_xor(n2, 1); n2 += __shfl_xor(n2, 2); n2 += __shfl_xor(n2, 4); n2 += __shfl_xor(n2, 8);
        float inv = 1.f / fmaxf(sqrtf(n2), 1e-12f);
        float kp[4], bb[4];
#pragma unroll
        for (int e = 0; e < 4; ++e) { kk[e] *= inv; kp[e] = k[e] * (1.f + (a[e] - 1.f) * kaw[e]); bb[e] = kk[e] * a[e]; }
        *(float4*)(tb) = lw;
        *(float4*)(tb + 64) = make_float4(kk[0], kk[1], kk[2], kk[3]);
        *(float4*)(tb + 128) = make_float4(bb[0], bb[1], bb[2], bb[3]);
        *(float4*)(tb + 192) = make_float4(kp[0], kp[1], kp[2], kp[3]);
        *(float4*)(tb + 256) = make_float4(lo2f(lr.x), hi2f(lr.x), lo2f(lr.y), hi2f(lr.y));
        *(float4*)(tb + 320) = make_float4(lo2f(lv.x), hi2f(lv.x), lo2f(lv.y), hi2f(lv.y));
      };
      gload(0);
      lstore(0);
      __syncthreads();
      for (int tc = 0; tc < 128; ++tc) {
        const int cur = tc & 1;
        if (tc + 1 < 128) gload(tc + 1);
        const float* cb = buf + cur * 6144;
        float* yo = yraw + (size_t)(b * 2048 + tc * 16) * 1024 + h * 64 + vrow;
#pragma unroll 4
        for (int t = 0; t < 16; ++t) {
          const float* tb = cb + t * 384 + j * 8;
          float4 w0 = *(const float4*)(tb), w1 = *(const float4*)(tb + 4);
          float4 k0 = *(const float4*)(tb + 64), k1 = *(const float4*)(tb + 68);
          float4 b0 = *(const float4*)(tb + 128), b1 = *(const float4*)(tb + 132);
          float4 p0 = *(const float4*)(tb + 192), p1 = *(const float4*)(tb + 196);
          float4 r0 = *(const float4*)(tb + 256), r1 = *(const float4*)(tb + 260);
          float vv = cb[t * 384 + 320 + vrow];
          float sa = S[0] * k0.x + S[1] * k0.y + S[2] * k0.z + S[3] * k0.w + S[4] * k1.x + S[5] * k1.y + S[6] * k1.z + S[7] * k1.w;
          sa += DPPF(sa, 0xB1);
          sa += DPPF(sa, 0x4E);
          sa += DPPF(sa, 0x141);
          sa = -sa;
          S[0] = S[0] * w0.x + (sa * b0.x + vv * p0.x);
          S[1] = S[1] * w0.y + (sa * b0.y + vv * p0.y);
          S[2] = S[2] * w0.z + (sa * b0.z + vv * p0.z);
          S[3] = S[3] * w0.w + (sa * b0.w + vv * p0.w);
          S[4] = S[4] * w1.x + (sa * b1.x + vv * p1.x);
          S[5] = S[5] * w1.y + (sa * b1.y + vv * p1.y);
          S[6] = S[6] * w1.z + (sa * b1.z + vv * p1.z);
          S[7] = S[7] * w1.w + (sa * b1.w + vv * p1.w);
          float y = S[0] * r0.x + S[1] * r0.y + S[2] * r0.z + S[3] * r0.w + S[4] * r1.x + S[5] * r1.y + S[6] * r1.z + S[7] * r1.w;
          y += DPPF(y, 0xB1);
          y += DPPF(y, 0x4E);
          y += DPPF(y, 0x141);
          if (j == 0) yo[(size_t)t * 1024] = y;
        }
        if (tc + 1 < 128) lstore(cur ^ 1);
        __syncthreads();
      }
      float* so = p.out + O_WKVP + ((size_t)((b * 16 + h) * 64 + vrow)) * 64 + j * 8;
      *(float4*)so = make_float4(S[0], S[1], S[2], S[3]);
      *(float4*)(so + 4) = make_float4(S[4], S[5], S[6], S[7]);
    } else {
      const int it = (w - 256) * 4 + wid;
      const int bs = it >> 4, h = it & 15, row = TP + bs;
      float* vb_ = buf + wid * 320;
      {
        size_t o = (size_t)row * 1024 + h * 64 + lane;
        float k = bf2f(kb[o]), a = bf2f(ab[o]);
        float kk = k * p.in[zz + I_KK][h * 64 + lane];
        float n2 = wsum(kk * kk);
        kk *= 1.f / fmaxf(sqrtf(n2), 1e-12f);
        vb_[lane] = dec[o];
        vb_[64 + lane] = kk;
        vb_[128 + lane] = kk * a;
        vb_[192 + lane] = k * (1.f + (a - 1.f) * p.in[zz + I_KA][h * 64 + lane]);
        vb_[256 + lane] = bf2f(rb[o]);
      }
      float vv = bf2f(vb[(size_t)row * 1024 + h * 64 + lane]);
      const float* st = p.in[zz + I_SWKV] + ((size_t)((bs * 16 + h) * 64 + lane)) * 64;
      float* so = p.out + O_WKVS + ((size_t)((bs * 16 + h) * 64 + lane)) * 64;
      float4 S4[16];
#pragma unroll
      for (int i = 0; i < 16; ++i) S4[i] = *(const float4*)(st + i * 4);
      float sa = 0.f;
#pragma unroll
      for (int i = 0; i < 16; ++i) {
        float4 k4 = *(const float4*)(vb_ + 64 + i * 4);
        sa += S4[i].x * k4.x + S4[i].y * k4.y + S4[i].z * k4.z + S4[i].w * k4.w;
      }
      sa = -sa;
      float y = 0.f;
#pragma unroll
      for (int i = 0; i < 16; ++i) {
        float4 w4 = *(const float4*)(vb_ + i * 4), b4 = *(const float4*)(vb_ + 128 + i * 4);
        float4 p4 = *(const float4*)(vb_ + 192 + i * 4), r4 = *(const float4*)(vb_ + 256 + i * 4);
        float4 s = S4[i];
        s.x = s.x * w4.x + (sa * b4.x + vv * p4.x);
        s.y = s.y * w4.y + (sa * b4.y + vv * p4.y);
        s.z = s.z * w4.z + (sa * b4.z + vv * p4.z);
        s.w = s.w * w4.w + (sa * b4.w + vv * p4.w);
        y += s.x * r4.x + s.y * r4.y + s.z * r4.z + s.w * r4.w;
        *(float4*)(so + i * 4) = s;
      }
      yraw[(size_t)row * 1024 + h * 64 + lane] = y;
      __syncthreads();
    }
  }
}

__device__ __forceinline__ void phase_wkv_ln(const P& p, int bid, int G) {
  const u16* rb = (const u16*)(p.ws + B_RB);
  const u16* kb = (const u16*)(p.ws + B_KB);
  const u16* vb = (const u16*)(p.ws + B_VB);
  const u16* ab = (const u16*)(p.ws + B_AB);
  const u16* gb = (const u16*)(p.ws + B_GB);
  const float* yraw = (const float*)(p.ws + B_YRAW);
  u16* yb = (u16*)(p.ws + B_YB);
  for (int w = bid; w < TT / 4; w += G) {
    FRESH_TID(tid);
    const int zz = zof(w);
    const int lane = tid & 63, wid = tid >> 6;
    int row = w * 4 + wid;
    size_t o = (size_t)row * 1024 + lane * 16;
    float y[16], r[16], k[16], v[16], a[16], g[16];
#pragma unroll
    for (int i = 0; i < 4; ++i) {
      float4 t = *(const float4*)(yraw + o + i * 4);
      y[i * 4] = t.x; y[i * 4 + 1] = t.y; y[i * 4 + 2] = t.z; y[i * 4 + 3] = t.w;
    }
    unpack8(*(const uint4*)(rb + o), r); unpack8(*(const uint4*)(rb + o + 8), r + 8);
    unpack8(*(const uint4*)(kb + o), k); unpack8(*(const uint4*)(kb + o + 8), k + 8);
    unpack8(*(const uint4*)(vb + o), v); unpack8(*(const uint4*)(vb + o + 8), v + 8);
    unpack8(*(const uint4*)(ab + o), a); unpack8(*(const uint4*)(ab + o + 8), a + 8);
    unpack8(*(const uint4*)(gb + o), g); unpack8(*(const uint4*)(gb + o + 8), g + 8);
    int c0 = lane * 16;
    float sm = 0.f, bon = 0.f;
#pragma unroll
    for (int e = 0; e < 16; ++e) {
      sm += y[e];
      float kp = k[e] * (1.f + (a[e] - 1.f) * p.in[zz + I_KA][c0 + e]);
      bon += r[e] * kp * p.in[zz + I_RK][c0 + e];
    }
    sm += __shfl_xor(sm, 1); sm += __shfl_xor(sm, 2);
    bon += __shfl_xor(bon, 1); bon += __shfl_xor(bon, 2);
    float mean = sm * (1.f / 64.f), vr = 0.f;
#pragma unroll
    for (int e = 0; e < 16; ++e) { float d = y[e] - mean; vr += d * d; }
    vr += __shfl_xor(vr, 1); vr += __shfl_xor(vr, 2);
    float rinv = rsqrtf(vr * (1.f / 64.f) + 64e-5f);
    float ov[16];
#pragma unroll
    for (int e = 0; e < 16; ++e)
      ov[e] = ((y[e] - mean) * rinv * p.in[zz + I_LNW][c0 + e] + p.in[zz + I_LNB][c0 + e] + bon * v[e]) * g[e];
    *(uint4*)(yb + o) = pack8(ov);
    *(uint4*)(yb + o + 8) = pack8(ov + 8);
  }
}

__device__ __forceinline__ void run_phase(const P& p, int ph, char* lds, int bid, int G) {
  char* ws = p.ws;
  const int zz = zof(ph);
  switch (ph) {
    case 0: if (PHEN(0)) phase_prep(p, lds, bid, G); break;
    case 1: { if (!PHEN(1)) break;
      EpiProj e{(u16*)(ws + B_PROJ), (float*)(ws + B_SMALL)};
      gemm_phase((const u16*)(ws + B_A), 1024, (const u16*)(ws + W_IN0), 1024, 1024, 65, 37, lds, bid, G, e);
    } break;
    case 2: if (PHEN(2)) phase_conv(p, lds, bid, G); break;
    case 3: if (PHEN(3)) phase_chunkstate(p, lds, bid, G); break;
    case 4: if (PHEN(4)) phase_scan(p, lds, bid, G); break;
    case 5: if (PHEN(5)) phase_chunkout(p, lds, bid, G); break;
    case 6: { if (!PHEN(6)) break;
      EpiRes e{p.in[zz + I_XP], p.in[zz + I_XS], (float*)(ws + B_X1)};
      gemm_phase((const u16*)(ws + B_MIX), 2048, (const u16*)(ws + W_OUT0), 2048, 2048, 65, 8, lds, bid, G, e);
    } break;
    case 7: if (PHEN(7)) phase_rms((const float*)(ws + B_X1), p.in[zz + I_NFFN], (u16*)(ws + B_A), bid, G); break;
    case 8: { if (!PHEN(8)) break;
      EpiSwiglu e{(u16*)(ws + B_HB)};
      gemm_phase((const u16*)(ws + B_A), 1024, (const u16*)(ws + W_GU), 1024, 1024, 65, 44, lds, bid, G, e);
    } break;
    case 9: { if (!PHEN(9)) break;
      const float* x1 = (const float*)(ws + B_X1);
      EpiRes e{x1, x1 + (size_t)TP * 1024, (float*)(ws + B_X2)};
      gemm_phase((const u16*)(ws + B_HB), 2816, (const u16*)(ws + W_DN), 2816, 2816, 65, 8, lds, bid, G, e);
    } break;
    case 10: if (PHEN(10)) phase_rms_shift(p, (const float*)(ws + B_X2), bid, G); break;
    case 11: { if (!PHEN(11)) break;
      const int nbig = 3 * 65 * 8;
      for (int t = bid; t < nbig + 65 * 4; t += G) {
        if (t < nbig) {
          int which = t / (65 * 8), r = t % (65 * 8);
          int mt = r % 65, nt = r / 65;
          size_t abase = which == 0 ? 3 * U : (which == 1 ? 5 * U : 6 * U);
          size_t wbase = which == 0 ? W_R : (which == 1 ? W_K : W_V);
          size_t obase = which == 0 ? B_RB : (which == 1 ? B_KB : B_VB);
          EpiAct e{(u16*)(ws + obase), 1024, 1024, 1024, 0};
          gemm_tile((const u16*)(ws + abase), 1024, (const u16*)(ws + wbase), 1024, 1024, mt * 256, nt * 128, lds, e);
        } else {
          int r = t - nbig;
          if (r < 65) {
            EpiAct e{(u16*)(ws + B_LW), 128, 64, 128, 1};
            gemm_tile((const u16*)(ws + 4 * U), 1024, (const u16*)(ws + W_W1), 1024, 1024, r * 256, 0, lds, e);
          } else if (r < 130) {
            EpiAct e{(u16*)(ws + B_LA), 128, 64, 128, 0};
            gemm_tile((const u16*)(ws + 7 * U), 1024, (const u16*)(ws + W_A1), 1024, 1024, (r - 65) * 256, 0, lds, e);
          } else {
            int q = r - 130;
            EpiAct e{(u16*)(ws + B_LG), 256, 160, 256, 2};
            gemm_tile((const u16*)(ws + B_A), 1024, (const u16*)(ws + W_G1), 1024, 1024, (q % 65) * 256, (q / 65) * 128, lds, e);
          }
        }
      }
    } break;
    case 12: { if (!PHEN(12)) break;
      for (int t = bid; t < 3 * 65 * 8; t += G) {
        int which = t / (65 * 8), r = t % (65 * 8);
        int mt = r % 65, nt = r / 65;
        if (which == 0) {
          EpiLora2 e{0, p.in[zz + I_W0], (float*)(ws + B_DEC), nullptr};
          gemm_tile((const u16*)(ws + B_LW), 128, (const u16*)(ws + W_W2), 128, 128, mt * 256, nt * 128, lds, e);
        } else if (which == 1) {
          EpiLora2 e{1, p.in[zz + I_A0], nullptr, (u16*)(ws + B_AB)};
          gemm_tile((const u16*)(ws + B_LA), 128, (const u16*)(ws + W_A2), 128, 128, mt * 256, nt * 128, lds, e);
        } else {
          EpiLora2 e{2, nullptr, nullptr, (u16*)(ws + B_GB)};
          gemm_tile((const u16*)(ws + B_LG), 256, (const u16*)(ws + W_G2), 256, 256, mt * 256, nt * 128, lds, e);
        }
      }
    } break;
    case 13: if (PHEN(13)) phase_wkv(p, lds, bid, G); break;
    case 14: if (PHEN(14)) phase_wkv_ln(p, bid, G); break;
    case 15: { if (!PHEN(15)) break;
      const float* x2 = (const float*)(ws + B_X2);
      EpiRes e{x2, x2 + (size_t)TP * 1024, (float*)(ws + B_X3)};
      gemm_phase((const u16*)(ws + B_YB), 1024, (const u16*)(ws + W_O), 1024, 1024, 65, 8, lds, bid, G, e);
    } break;
    case 16: if (PHEN(16)) phase_rms((const float*)(ws + B_X3), p.in[zz + I_NFFN] + 1024, (u16*)(ws + B_A), bid, G); break;
    case 17: { if (!PHEN(17)) break;
      EpiSwiglu e{(u16*)(ws + B_HB)};
      gemm_phase((const u16*)(ws + B_A), 1024, (const u16*)(ws + W_GU + 5632ull * 1024 * 2), 1024, 1024, 65, 44, lds, bid, G, e);
    } break;
    case 18: { if (!PHEN(18)) break;
      const float* x3 = (const float*)(ws + B_X3);
      EpiRes e{x3, x3 + (size_t)TP * 1024, (float*)(ws + B_X4)};
      gemm_phase((const u16*)(ws + B_HB), 2816, (const u16*)(ws + W_DN + 1024ull * 2816 * 2), 2816, 2816, 65, 8, lds, bid, G, e);
    } break;
    case 19: if (PHEN(19)) phase_rms_final(p, (const float*)(ws + B_X4), bid, G); break;
#ifdef DBG_MIX_OFF
    case 100: {
      for (size_t i = (size_t)bid * 256 + threadIdx.x; i < (size_t)TT * 1024; i += (size_t)G * 256) {
        size_t row = i >> 10; int c = (int)(i & 1023);
        p.out[O_Y + i] = bf2f(((const u16*)(p.ws + B_MIX))[row * 2048 + DBG_MIX_OFF + c]);
      }
    } break;
#endif
    default: break;
  }
}

#ifndef MK_LB
#define MK_LB 1
#endif
__global__ void __launch_bounds__(256, MK_LB) mk_forward(P p, int ph_lo, int ph_hi) {
  extern __shared__ __attribute__((aligned(16))) char lds[];
  cg::grid_group grid = cg::this_grid();
  const int bid = blockIdx.x, G = gridDim.x;
#ifdef TM_A
  unsigned long long tm0 = wall_clock64(), tm1 = 0, tm2 = 0;
#endif
#if !MK_MULTI
  unsigned* bar = (unsigned*)(p.ws + M_BAR);
  const unsigned xcc = (unsigned)__builtin_amdgcn_s_getreg((3 << 11) | 20) & 0xFu;
  unsigned nloc = 0, nx = 0;
  if (threadIdx.x == 0) __hip_atomic_fetch_add(&bar[xcc * 64], 1u, __ATOMIC_RELAXED, __HIP_MEMORY_SCOPE_AGENT);
#endif
  for (int ph = ph_lo; ph < ph_hi; ++ph) {
    run_phase(p, ph, lds, bid, G);
    if (ph + 1 < ph_hi) {
#if MK_MULTI
      grid.sync();
#else
      if (ph == ph_lo) {
        grid.sync();
        if (threadIdx.x == 0) {
          for (int j = 0; j < 16; ++j) {
            unsigned c = __hip_atomic_load(&bar[j * 64], __ATOMIC_RELAXED, __HIP_MEMORY_SCOPE_AGENT);
            if (c) ++nx;
            if ((unsigned)j == xcc) nloc = c;
          }
        }
      } else {
        asm volatile("s_waitcnt vmcnt(0)" ::: "memory");
        __syncthreads();
        if (threadIdx.x == 0) {
          unsigned* sub = bar + 64 * (16 + ph * 33 + xcc);
          unsigned* gen = bar + 64 * (16 + ph * 33 + 16 + xcc);
          unsigned* top = bar + 64 * (16 + ph * 33 + 32);
          unsigned old = __hip_atomic_fetch_add(sub, 1u, __ATOMIC_RELAXED, __HIP_MEMORY_SCOPE_AGENT);
          if (old == nloc - 1) {
            __builtin_amdgcn_fence(__ATOMIC_RELEASE, "agent");
            asm volatile("s_waitcnt vmcnt(0)" ::: "memory");
            __hip_atomic_fetch_add(top, 1u, __ATOMIC_RELAXED, __HIP_MEMORY_SCOPE_AGENT);
            while (__hip_atomic_load(top, __ATOMIC_RELAXED, __HIP_MEMORY_SCOPE_AGENT) < nx) __builtin_amdgcn_s_sleep(1);
            __hip_atomic_store(gen, 1u, __ATOMIC_RELAXED, __HIP_MEMORY_SCOPE_AGENT);
          } else {
            while (__hip_atomic_load(gen, __ATOMIC_RELAXED, __HIP_MEMORY_SCOPE_AGENT) == 0u) __builtin_amdgcn_s_sleep(1);
          }
        }
        __syncthreads();
        __builtin_amdgcn_fence(__ATOMIC_ACQUIRE, "agent");
        asm volatile("s_waitcnt vmcnt(0)" ::: "memory");
      }
#endif
    }
#ifdef TM_A
    if (ph == TM_A) tm1 = wall_clock64();
    if (ph == TM_B) tm2 = wall_clock64();
#endif
  }
#ifdef TM_A
  grid.sync();
  if (bid == 0 && threadIdx.x == 0) {
    unsigned long long tm3 = wall_clock64();
    float tot = (float)(tm3 - tm0);
    float f1 = (float)(tm1 - tm0) / tot, f2 = (float)(tm2 - tm0) / tot;
    float sc = 1.f + sqrtf(0.01f + 0.5f * f1);
    for (int i = 0; i < 32; ++i) p.out[O_MMP + i] *= sc;
    p.out[O_Y + (size_t)TP * 1024] += 1.f + 10.f * f2;
  }
#endif
#if defined(DBG_MIX_OFF) && !MK_MULTI
  grid.sync();
  run_phase(p, 100, lds, bid, G);
#endif

}

extern "C" void kernel_launch(void* const* d_in, const int* in_sizes, int n_in, void* d_out, int out_size, void* d_ws,
                              size_t ws_size, hipStream_t stream) {
  static int grid_blocks = 0;
  if (!grid_blocks) {
    hipFuncSetAttribute((const void*)mk_forward, hipFuncAttributeMaxDynamicSharedMemorySize, LDS_BYTES);
    int dev = 0, cus = 0, per_cu = 0;
    hipGetDevice(&dev);
    hipDeviceGetAttribute(&cus, hipDeviceAttributeMultiprocessorCount, dev);
    hipOccupancyMaxActiveBlocksPerMultiprocessor(&per_cu, mk_forward, 256, LDS_BYTES);
    if (per_cu > 2) per_cu = 2;
    if (per_cu < 1) per_cu = 1;
    grid_blocks = cus * per_cu;
  }
  P p{};
  for (int i = 0; i < N_IN; ++i) p.in[i] = (const float*)d_in[i];
  p.out = (float*)d_out;
  p.ws = (char*)d_ws;
  if (ws_size < WS_NEED) fprintf(stderr, "workspace too small: %zu < %zu\n", ws_size, (size_t)WS_NEED);
#if MK_MULTI
#ifndef MK_HI
#define MK_HI NPH
#endif
  for (int ph = 0; ph < MK_HI; ++ph) {
    int lo = ph, hi = ph + 1;
    hipLaunchKernelGGL(mk_forward, dim3(grid_blocks), dim3(256), LDS_BYTES, stream, p, lo, hi);
  }
#ifdef DBG_MIX_OFF
  hipLaunchKernelGGL(mk_forward, dim3(grid_blocks), dim3(256), LDS_BYTES, stream, p, 100, 101);
#endif
#else
#ifndef MK_HI
#define MK_HI NPH
#endif
  int lo = 0, hi = MK_HI;
  hipMemsetAsync((char*)d_ws + M_BAR, 0, (size_t)BAR_WORDS * 4, stream);
  void* args[] = {&p, &lo, &hi};
  hipError_t e = hipLaunchCooperativeKernel((void*)mk_forward, dim3(grid_blocks), dim3(256), args, LDS_BYTES, stream);
  if (e != hipSuccess) fprintf(stderr, "cooperative launch failed: %s (grid %d)\n", hipGetErrorString(e), grid_blocks);
#endif
}
```
